# Optimizing an MI355X kernel written in HIP

```python
import math
import jax
import jax.numpy as jnp
from jax import lax
import numpy as np

D_MODEL = 1024
BATCH = 8
SEQ = 2048
DEPTH = 4

GRID_W = 64
CTX_LEN = 256
N_MIXERS = 4
MIX_DIFF_ATTN = 0
MIX_HYENA = 1
MIX_RETENTION = 2
MIX_SHORTCONV = 3
CTX_READING_MIXERS = (MIX_DIFF_ATTN, MIX_RETENTION)
N_MOD = 9
D_FF = 2816
LN_EPS = 1e-5
ROPE_BASE = 10000.0
DA_HEAD_DIM = 64
DA_HEADS = D_MODEL // (2 * DA_HEAD_DIM)
DA_V_DIM = 2 * DA_HEAD_DIM
Q_BLOCK = 128
HY_EMB = 33
HY_FH = 64
HY_TARGET = 1e-2
HY_FAST_PCT = 0.3
HY_SLOW_PCT = 1.5
RT_HEADS = 4
RT_QK_DIM = D_MODEL // RT_HEADS
RT_V_DIM = 2 * D_MODEL // RT_HEADS
RT_CHUNK = 128

kernel_name = 'hybrid_interleaved_flow_backbone'


def layer_norm(x, g, b):
    xf = x.astype(jnp.float32)
    mu = jnp.mean(xf, -1, keepdims=True)
    var = jnp.mean(jnp.square(xf - mu), -1, keepdims=True)
    y = (xf - mu) * lax.rsqrt(var + LN_EPS) * g.astype(jnp.float32) + b.astype(jnp.float32)
    return y.astype(x.dtype)


def modulation(cond, w, b):
    m = jax.nn.silu(cond) @ w + b
    return jnp.split(m[..., None, :], N_MOD, axis=-1)


def modulate(x, shift, scale):
    return x * (1.0 + scale) + shift


def swiglu(h, wi, wo):
    a, u = jnp.split(h @ wi, 2, axis=-1)
    return (jax.nn.silu(a) * u) @ wo


def half_ffn(x, shift, scale, gate, wi, wo, g, b, alpha):
    y = swiglu(modulate(x, shift, scale), wi, wo)
    return layer_norm(alpha * x + 0.5 * gate * y, g, b)


def axial_rope(n_tokens, dim):
    rows = n_tokens // GRID_W
    row = jnp.repeat(jnp.arange(rows), GRID_W).astype(jnp.float32)
    col = jnp.tile(jnp.arange(GRID_W), rows).astype(jnp.float32)
    n_freq = dim // 4
    inv = ROPE_BASE ** (-jnp.arange(n_freq, dtype=jnp.float32) / n_freq)
    ang = jnp.concatenate([row[:, None] * inv, col[:, None] * inv], axis=-1)
    return jnp.cos(ang), jnp.sin(ang)


def apply_rope(x, cos, sin):
    shape = (x.shape[1],) + (1,) * (x.ndim - 3) + (cos.shape[-1],)
    cos = cos.reshape(shape).astype(x.dtype)
    sin = sin.reshape(shape).astype(x.dtype)
    x1, x2 = jnp.split(x, 2, axis=-1)
    return jnp.concatenate([x1 * cos - x2 * sin, x1 * sin + x2 * cos], axis=-1)


def dwconv3(u, w):
    up = jnp.pad(u, ((0, 0), (1, 1), (0, 0)))
    return up[:, :-2] * w[0] + up[:, 1:-1] * w[1] + up[:, 2:] * w[2]


def diff_attention(h_lat, h_ctx, ctx_out, w_qkv, w_o, lam, subln_g, lam_init):
    def project(h):
        b, n, _ = h.shape
        q, k, v = jnp.split(h @ w_qkv, 3, axis=-1)
        q = q.reshape(b, n, DA_HEADS, 2, DA_HEAD_DIM) * DA_HEAD_DIM ** -0.5
        k = k.reshape(b, n, DA_HEADS, 2, DA_HEAD_DIM)
        v = v.reshape(b, n, DA_HEADS, DA_V_DIM)
        return q, k, v

    lam = lam.astype(jnp.float32)
    lam_full = jnp.exp(jnp.sum(lam[0] * lam[1])) - jnp.exp(jnp.sum(lam[2] * lam[3])) + lam_init

    def attend(q, k, v):
        s = jnp.einsum('bqhmd,bkhmd->bhmqk', q, k).astype(jnp.float32)
        p = jax.nn.softmax(s, axis=-1)
        a = (p[:, :, 0] - lam_full * p[:, :, 1]).astype(v.dtype)
        return jnp.einsum('bhqk,bkhe->bqhe', a, v)

    def finish(o):
        b, n = o.shape[:2]
        of = o.astype(jnp.float32)
        of = of * lax.rsqrt(jnp.mean(of * of, -1, keepdims=True) + LN_EPS)
        of = of * subln_g.astype(jnp.float32) * (1.0 - lam_init)
        return of.astype(o.dtype).reshape(b, n, DA_HEADS * DA_V_DIM) @ w_o

    B, L = h_lat.shape[:2]
    qc, kc, vc = project(h_ctx)
    ql, kl, vl = project(h_lat)
    cos, sin = axial_rope(L, DA_HEAD_DIM)
    ql = apply_rope(ql, cos, sin)
    kl = apply_rope(kl, cos, sin)
    k_all = jnp.concatenate([kc, kl], axis=1)
    v_all = jnp.concatenate([vc, vl], axis=1)
    nb = L // Q_BLOCK
    q_blocks = jnp.moveaxis(ql.reshape(B, nb, Q_BLOCK, DA_HEADS, 2, DA_HEAD_DIM), 1, 0)
    o = lax.map(lambda qb: attend(qb, k_all, v_all), q_blocks)
    o = jnp.moveaxis(o, 0, 1).reshape(B, L, DA_HEADS, DA_V_DIM)
    y_lat = finish(o)
    y_ctx = finish(attend(qc, kc, vc)) if ctx_out else None
    return y_lat, y_ctx


def hyena_filters(n, w1, b1, f1, w2, b2, f2, w3):
    f32 = jnp.float32
    t = jnp.linspace(0.0, 1.0, n, dtype=f32)[:, None]
    bands = (HY_EMB - 1) // 2
    fr = jnp.linspace(1e-4, bands - 1, bands, dtype=f32)[None, :]
    w = 2.0 * math.pi * jnp.arange(n, dtype=f32)[:, None] / n
    z = jnp.concatenate([t, jnp.cos(fr * w), -jnp.sin(fr * w)], axis=-1)
    h = jnp.sin(f1.astype(f32) * (z @ w1.astype(f32) + b1.astype(f32)))
    h = jnp.sin(f2.astype(f32) * (h @ w2.astype(f32) + b2.astype(f32)))
    h = h @ w3.astype(f32)
    max_decay = math.log(HY_TARGET) / HY_FAST_PCT
    min_decay = math.log(HY_TARGET) / HY_SLOW_PCT
    deltas = jnp.abs(jnp.linspace(min_decay, max_decay, D_MODEL, dtype=f32))
    h = h * jnp.exp(-t * jnp.tile(deltas, 2)[None, :])
    return h[:, :D_MODEL], h[:, D_MODEL:]


def bidir_long_conv(u, h_f, h_b, d_skip):
    L = u.shape[1]
    n = 2 * L
    h_full = jnp.concatenate([h_f, jnp.zeros((1, h_f.shape[1]), h_f.dtype), h_b[1:][::-1]], axis=0)
    uf = jnp.fft.rfft(u.astype(jnp.float32), n=n, axis=1)
    hf = jnp.fft.rfft(h_full, n=n, axis=0)
    y = jnp.fft.irfft(uf * hf[None], n=n, axis=1)[:, :L]
    return (y + u.astype(jnp.float32) * d_skip.astype(jnp.float32)).astype(u.dtype)


def hyena(h_lat, h_ctx, ctx_out, w_in, conv_w, conv_b, fw1, fb1, ff1, fw2, fb2, ff2, fw3, d_skip, w_o):
    def run(h):
        n = h.shape[1]
        h_f, h_b = hyena_filters(n, fw1, fb1, ff1, fw2, fb2, ff2, fw3)
        u = dwconv3(h @ w_in, conv_w) + conv_b
        x0, x1, v = jnp.split(u, 3, axis=-1)
        return (x0 * bidir_long_conv(x1 * v, h_f, h_b, d_skip)) @ w_o
    return run(h_lat), (run(h_ctx) if ctx_out else None)


def retention_chunkwise(q, k, v, gamma, state):
    f32 = jnp.float32
    b, n, h, _ = q.shape
    dv = v.shape[-1]
    nc = n // RT_CHUNK
    log_g = jnp.log(gamma)
    pos = jnp.arange(RT_CHUNK, dtype=f32)
    lag = pos[:, None] - pos[None, :]
    d_intra = jnp.where(lag >= 0, jnp.exp(jnp.maximum(lag, 0.0)[None] * log_g[:, None, None]), 0.0)
    d_read = jnp.exp((pos[:, None] + 1.0) * log_g[None, :])[None, :, :, None]
    d_write = jnp.exp((RT_CHUNK - 1.0 - pos[:, None]) * log_g[None, :])[None, :, :, None]
    d_chunk = jnp.exp(RT_CHUNK * log_g)[None, :, None, None]

    def chunks(a):
        return jnp.moveaxis(a.astype(f32).reshape(b, nc, RT_CHUNK, h, a.shape[-1]), 1, 0)

    def step(s, qkv):
        qc, kc, vc = qkv
        scores = jnp.einsum('bihd,bjhd->bhij', qc, kc) * d_intra
        out = jnp.einsum('bhij,bjhe->bihe', scores, vc) + jnp.einsum('bihd,bhde->bihe', qc, s) * d_read
        s = d_chunk * s + jnp.einsum('bjhd,bjhe->bhde', kc * d_write, vc)
        return s, out

    state, out = lax.scan(step, state, (chunks(q), chunks(k), chunks(v)))
    return jnp.moveaxis(out, 0, 1).reshape(b, n, h, dv), state


def retention(h_lat, h_ctx, ctx_out, w_in, decay_logit, gn_g, w_o):
    qk_w = RT_HEADS * RT_QK_DIM
    v_w = RT_HEADS * RT_V_DIM

    def project(h):
        b, n, _ = h.shape
        q, k, v, g = jnp.split(h @ w_in, [qk_w, 2 * qk_w, 2 * qk_w + v_w], axis=-1)
        q = q.reshape(b, n, RT_HEADS, RT_QK_DIM)
        k = k.reshape(b, n, RT_HEADS, RT_QK_DIM) * RT_QK_DIM ** -0.5
        v = v.reshape(b, n, RT_HEADS, RT_V_DIM)
        return q, k, v, g

    def finish(o, g):
        b, n = o.shape[:2]
        mu = jnp.mean(o, -1, keepdims=True)
        var = jnp.mean(jnp.square(o - mu), -1, keepdims=True)
        o = ((o - mu) * lax.rsqrt(var + LN_EPS)).reshape(b, n, v_w) * gn_g.astype(jnp.float32)
        return (jax.nn.silu(g) * o.astype(g.dtype)) @ w_o

    B, L = h_lat.shape[:2]
    gam = jax.nn.sigmoid(decay_logit.astype(jnp.float32))
    qc, kc, vc, gc = project(h_ctx)
    ql, kl, vl, gl = project(h_lat)
    cos, sin = axial_rope(L, RT_QK_DIM)
    ql = apply_rope(ql, cos, sin)
    kl = apply_rope(kl, cos, sin)
    zero = jnp.zeros((B, RT_HEADS, RT_QK_DIM, RT_V_DIM), jnp.float32)
    flip = lambda a: jnp.flip(a, axis=1)
    oc_f, s_f = retention_chunkwise(qc, kc, vc, gam[0], zero)
    oc_b, s_b = retention_chunkwise(flip(qc), flip(kc), flip(vc), gam[1], zero)
    ol_f, _ = retention_chunkwise(ql, kl, vl, gam[0], s_f)
    ol_b, _ = retention_chunkwise(flip(ql), flip(kl), flip(vl), gam[1], s_b)
    y_lat = finish(ol_f + flip(ol_b), gl)
    y_ctx = finish(oc_f + flip(oc_b), gc) if ctx_out else None
    return y_lat, y_ctx


def short_conv_mixer(h_lat, h_ctx, ctx_out, w_in, conv_w, w_o):
    def run(h):
        b_gate, c_gate, u = jnp.split(h @ w_in, 3, axis=-1)
        return (b_gate * dwconv3(c_gate * u, conv_w)) @ w_o
    return run(h_lat), (run(h_ctx) if ctx_out else None)


def setup_inputs(seed: int = 0) -> dict:
    key = jax.random.key(seed)
    keys = iter(jax.random.split(key, 48))

    def nrm(shape, scale):
        return scale * jax.random.normal(next(keys), shape, jnp.float32)

    d = D_MODEL
    beta = (8.0 * DEPTH) ** -0.25
    n_da = len(range(MIX_DIFF_ATTN, DEPTH, N_MIXERS))
    n_hy = len(range(MIX_HYENA, DEPTH, N_MIXERS))
    n_rt = len(range(MIX_RETENTION, DEPTH, N_MIXERS))
    n_sc = len(range(MIX_SHORTCONV, DEPTH, N_MIXERS))
    qk_w = RT_HEADS * RT_QK_DIM
    v_w = RT_HEADS * RT_V_DIM
    gamma0 = 1.0 - 2.0 ** (-5.0 - jnp.arange(RT_HEADS, dtype=jnp.float32))
    logit0 = jnp.log(gamma0) - jnp.log1p(-gamma0)
    return {
        'x': nrm((BATCH, SEQ, d), 1.0),
        'c': nrm((BATCH, d), 1.0),
        'ctx': nrm((BATCH, CTX_LEN, d), 1.0),
        'c_ctx': nrm((d,), 1.0),
        'ada_w': nrm((DEPTH, d, N_MOD * d), 0.5 * d ** -0.5),
        'ada_b': nrm((DEPTH, N_MOD * d), 0.02),
        'ln_g': 1.0 + nrm((DEPTH, 3, d), 0.02),
        'ln_b': nrm((DEPTH, 3, d), 0.02),
        'ffa_wi': nrm((DEPTH, d, 2 * D_FF), d ** -0.5),
        'ffa_wo': nrm((DEPTH, D_FF, d), beta * D_FF ** -0.5),
        'ffb_wi': nrm((DEPTH, d, 2 * D_FF), d ** -0.5),
        'ffb_wo': nrm((DEPTH, D_FF, d), beta * D_FF ** -0.5),
        'da_w_qkv': nrm((n_da, d, 3 * d), d ** -0.5),
        'da_w_o': nrm((n_da, d, d), beta * d ** -0.5),
        'da_lambda': nrm((n_da, 4, DA_HEAD_DIM), 0.1),
        'da_subln_g': 1.0 + nrm((n_da, DA_V_DIM), 0.02),
        'hy_w_in': nrm((n_hy, d, 3 * d), d ** -0.5),
        'hy_conv_w': nrm((n_hy, 3, 3 * d), 3 ** -0.5),
        'hy_conv_b': nrm((n_hy, 3 * d), 0.02),
        'hy_fw1': nrm((n_hy, HY_EMB, HY_FH), HY_EMB ** -0.5),
        'hy_fb1': nrm((n_hy, HY_FH), 0.02),
        'hy_ff1': 1.0 + nrm((n_hy, HY_FH), 0.02),
        'hy_fw2': nrm((n_hy, HY_FH, HY_FH), HY_FH ** -0.5),
        'hy_fb2': nrm((n_hy, HY_FH), 0.02),
        'hy_ff2': 1.0 + nrm((n_hy, HY_FH), 0.02),
        'hy_fw3': nrm((n_hy, HY_FH, 2 * d), HY_FH ** -0.5),
        'hy_d_skip': nrm((n_hy, d), 1.0),
        'hy_w_o': nrm((n_hy, d, d), beta * d ** -0.5),
        'rt_w_in': nrm((n_rt, d, 2 * qk_w + 2 * v_w), d ** -0.5),
        'rt_decay_logit': logit0 + nrm((n_rt, 2, RT_HEADS), 0.1),
        'rt_gn_g': 1.0 + nrm((n_rt, v_w), 0.02),
        'rt_w_o': nrm((n_rt, v_w, d), beta * v_w ** -0.5),
        'sc_w_in': nrm((n_sc, d, 3 * d), d ** -0.5),
        'sc_conv_w': nrm((n_sc, 3, d), 3 ** -0.5),
        'sc_w_o': nrm((n_sc, d, d), beta * d ** -0.5),
    }


def reference(x, c, ctx, c_ctx, ada_w, ada_b, ln_g, ln_b, ffa_wi, ffa_wo, ffb_wi, ffb_wo,
              da_w_qkv, da_w_o, da_lambda, da_subln_g,
              hy_w_in, hy_conv_w, hy_conv_b, hy_fw1, hy_fb1, hy_ff1, hy_fw2, hy_fb2, hy_ff2, hy_fw3,
              hy_d_skip, hy_w_o,
              rt_w_in, rt_decay_logit, rt_gn_g, rt_w_o,
              sc_w_in, sc_conv_w, sc_w_o):
    alpha = (2.0 * DEPTH) ** 0.25
    ctx_last = max(i for i in range(DEPTH) if i % N_MIXERS in CTX_READING_MIXERS)
    xl, xc = x, ctx
    for i in range(DEPTH):
        kind, j = i % N_MIXERS, i // N_MIXERS
        use_ctx, ctx_next = i <= ctx_last, i < ctx_last
        ml = modulation(c, ada_w[i], ada_b[i])
        mc = modulation(c_ctx, ada_w[i], ada_b[i]) if use_ctx else None

        xl = half_ffn(xl, ml[0], ml[1], ml[2], ffa_wi[i], ffa_wo[i], ln_g[i, 0], ln_b[i, 0], alpha)
        if use_ctx:
            xc = half_ffn(xc, mc[0], mc[1], mc[2], ffa_wi[i], ffa_wo[i], ln_g[i, 0], ln_b[i, 0], alpha)

        hl = modulate(xl, ml[3], ml[4])
        hc = modulate(xc, mc[3], mc[4]) if use_ctx else None
        if kind == MIX_DIFF_ATTN:
            yl, yc = diff_attention(hl, hc, ctx_next, da_w_qkv[j], da_w_o[j], da_lambda[j], da_subln_g[j],
                                    0.8 - 0.6 * math.exp(-0.3 * i))
        elif kind == MIX_HYENA:
            yl, yc = hyena(hl, hc, ctx_next, hy_w_in[j], hy_conv_w[j], hy_conv_b[j], hy_fw1[j], hy_fb1[j],
                           hy_ff1[j], hy_fw2[j], hy_fb2[j], hy_ff2[j], hy_fw3[j], hy_d_skip[j], hy_w_o[j])
        elif kind == MIX_RETENTION:
            yl, yc = retention(hl, hc, ctx_next, rt_w_in[j], rt_decay_logit[j], rt_gn_g[j], rt_w_o[j])
        else:
            yl, yc = short_conv_mixer(hl, hc, ctx_next, sc_w_in[j], sc_conv_w[j], sc_w_o[j])
        xl = layer_norm(alpha * xl + ml[5] * yl, ln_g[i, 1], ln_b[i, 1])
        if ctx_next:
            xc = layer_norm(alpha * xc + mc[5] * yc, ln_g[i, 1], ln_b[i, 1])

        xl = half_ffn(xl, ml[6], ml[7], ml[8], ffb_wi[i], ffb_wo[i], ln_g[i, 2], ln_b[i, 2], alpha)
        if ctx_next:
            xc = half_ffn(xc, mc[6], mc[7], mc[8], ffb_wi[i], ffb_wo[i], ln_g[i, 2], ln_b[i, 2], alpha)
    return xl
```

```cpp
#include <hip/hip_runtime.h>
#include <hip/hip_cooperative_groups.h>
#include <cstdio>
namespace cg = cooperative_groups;

#define LAS __attribute__((address_space(3)))
#define DI __device__ __forceinline__
typedef unsigned short bf16_t;
typedef short bf16x8 __attribute__((ext_vector_type(8)));
typedef short s16x4 __attribute__((ext_vector_type(4)));
typedef float f32x4 __attribute__((ext_vector_type(4)));
typedef float f32x2 __attribute__((ext_vector_type(2)));
typedef float f32x16 __attribute__((ext_vector_type(16)));
typedef unsigned u32x4 __attribute__((ext_vector_type(4)));
typedef unsigned u32x2 __attribute__((ext_vector_type(2)));

constexpr int ML = 16384, MC = 2048, MT = 18432, DM = 1024, DFF = 2816;
constexpr int NTHR = 512;
constexpr int LDS_BYTES = 140 * 1024;
constexpr float ALPHA = 1.681792830507429f;
constexpr float LN_EPS = 1e-5f;
constexpr float LOG2E = 1.4426950408889634f;

constexpr size_t al256(size_t x) { return (x + 255) & ~(size_t)255; }
constexpr size_t SZ_WI = (size_t)2 * DFF * DM * 2, SZ_WO = (size_t)DM * DFF * 2;
constexpr size_t LAYER_W = 2 * (SZ_WI + SZ_WO);
constexpr size_t WS_WMIX = 4 * LAYER_W;
constexpr size_t W_DA_QKV = WS_WMIX, W_DA_O = W_DA_QKV + (size_t)3072 * 1024 * 2, W_HY_IN = W_DA_O + (size_t)1024 * 1024 * 2,
                 W_HY_O = W_HY_IN + (size_t)3072 * 1024 * 2, W_RT_IN = W_HY_O + (size_t)1024 * 1024 * 2, W_RT_O = W_RT_IN + (size_t)6144 * 1024 * 2,
                 W_SC_IN = W_RT_O + (size_t)1024 * 2048 * 2, W_SC_O = W_SC_IN + (size_t)3072 * 1024 * 2, W_END = W_SC_O + (size_t)1024 * 1024 * 2;
constexpr size_t WS_MODS = al256(W_END);
constexpr size_t WS_ROPE_DA = al256(WS_MODS + (size_t)4 * 9 * 9216 * 4);
constexpr size_t WS_ROPE_RT = al256(WS_ROPE_DA + (size_t)2048 * 32 * 8);
constexpr int RL_STRIDE = 4104, RC_STRIDE = 520;
constexpr size_t WS_HYRL = al256(WS_ROPE_RT + (size_t)2048 * 128 * 8);
constexpr size_t WS_HYRC = al256(WS_HYRL + (size_t)1024 * RL_STRIDE * 2);
constexpr size_t WS_X = al256(WS_HYRC + (size_t)1024 * RC_STRIDE * 2);
constexpr size_t WS_H = al256(WS_X + (size_t)MT * DM * 4);
constexpr size_t WS_BIG = al256(WS_H + (size_t)MT * DM * 2);
constexpr size_t SZ_TOK1K = (size_t)MT * 1024 * 2;
constexpr size_t BIG_BYTES = 6 * SZ_TOK1K;
constexpr size_t WS_END = WS_BIG + BIG_BYTES;

struct WJob { const float* src; bf16_t* dst; int K, N, srcN, kind, ustart, pad; };
struct Params {
  const float* in[35];
  float* out;
  unsigned char* ws;
  WJob jobs[24];
  int nconv_units, ph_lo, ph_hi, pad;
};

DI float bf2f(bf16_t h) { return __uint_as_float(((unsigned)h) << 16); }
DI unsigned pk_bf16(float lo, float hi) { unsigned r; asm("v_cvt_pk_bf16_f32 %0, %1, %2" : "=v"(r) : "v"(lo), "v"(hi)); return r; }
DI bf16_t f2bf(float f) { return (bf16_t)(pk_bf16(f, 0.f) & 0xffffu); }
DI float fast_exp2(float x) { return __builtin_amdgcn_exp2f(x); }
DI float silu_f(float a) { return a * __builtin_amdgcn_rcpf(1.0f + __expf(-a)); }
DI float wave_sum(float v) {
#pragma unroll
  for (int o = 32; o >= 1; o >>= 1) v += __shfl_xor(v, o);
  return v;
}
DI f32x4 ld_bf4(const bf16_t* p) { u32x2 w = *(const u32x2*)p; return (f32x4){__uint_as_float(w.x << 16), __uint_as_float(w.x & 0xffff0000u), __uint_as_float(w.y << 16), __uint_as_float(w.y & 0xffff0000u)}; }
DI void st_bf4(bf16_t* p, f32x4 v) { u32x2 w; w.x = pk_bf16(v[0], v[1]); w.y = pk_bf16(v[2], v[3]); *(u32x2*)p = w; }

namespace pg8 {
constexpr int BM = 256, BK = 64, HALF = 128, HTB = HALF * BK * 2, STAGE_BYTES = 8 * HTB, NXCD = 8, WGM = 8;
DI int lds_byte(int r, int c) { const int st = (r >> 4) * 2 + (c >> 5), rr = r & 15, cc = c & 31, ob = rr * 64 + cc * 2; return st * 1024 + (ob ^ (((ob >> 9) & 1) << 5)); }
DI void stage_rc(int b, int& R, int& C) { const int st = b / 1024, sb = b % 1024, swz = sb ^ (((sb >> 9) & 1) << 5); R = (st >> 1) * 16 + swz / 64; C = (st & 1) * 32 + (swz % 64) / 2; }
struct Unit { int pm, pn; };
struct Gemm { const bf16_t* A; const bf16_t* Bt; int M, N, K; };
struct StaticOrder {
  int nM, nN, nwg, G, c;
  DI void init(int M, int N, int G_, int c_) { nM = M / BM; nN = N / BM; nwg = nM * nN; G = G_; c = c_; }
  DI bool next(int i, Unit& u) const {
    const long L = (long)i * G + c; if (L >= nwg) return false;
    int wgid = (int)L; { const int q = nwg / NXCD, r = nwg % NXCD, xcd = wgid % NXCD, off = wgid / NXCD; wgid = (xcd < r ? xcd * (q + 1) : r * (q + 1) + (xcd - r) * q) + off; }
    const int nig = WGM * nN, gid = wgid / nig, fm = gid * WGM, gsz = (nM - fm) < WGM ? (nM - fm) : WGM;
    u.pm = fm + ((wgid % nig) % gsz); u.pn = (wgid % nig) / gsz; return true;
  }
};

template <class Epi>
DI void gemm_phase(int tx, LAS unsigned char* lds, const Gemm g, const StaticOrder& S, const Epi& E) {
  const int tid = tx, wid = __builtin_amdgcn_readfirstlane(tid >> 6), lane = tid & 63, wr = wid >> 2, wc = wid & 3, fr = lane & 15, fq = lane >> 4;
  const int K = g.K, nt = K / BK;
  unsigned voffA[2];
#pragma unroll
  for (int i = 0; i < 2; ++i) { int R, C; stage_rc(tid * 16 + i * 8192, R, C); voffA[i] = (unsigned)(R * K + C) * 2u; }
  const size_t kstep = (size_t)(BK * 2);
  const size_t hstep = (size_t)HALF * K * 2;
  const size_t tstep = 2 * hstep;
  const unsigned ldsw = (unsigned)wid * 1024u;
  const int aoff = lds_byte(wr * 64 + fr, fq * 8), boff = lds_byte(wc * 32 + fr, fq * 8);
#define PG8_SA(b, h) (((b) * 2 + (h)) * HTB)
#define PG8_SB(b, h) ((4 + (b) * 2 + (h)) * HTB)
#define PG8_STAGE(bufoff, gbase) do { _Pragma("unroll") for (int _i = 0; _i < 2; ++_i) \
    __builtin_amdgcn_global_load_lds((const unsigned*)((const char*)(gbase) + voffA[_i]), (LAS unsigned*)(lds + (bufoff) + ldsw + _i * 8192), 16, 0, 0); } while (0)
#define PG8_LDA(dst, b, h) do { _Pragma("unroll") for (int m = 0; m < 4; ++m) _Pragma("unroll") for (int k = 0; k < 2; ++k) dst[m][k] = *(const LAS bf16x8*)(lds + PG8_SA(b, h) + aoff + m * 2048 + k * 1024); } while (0)
#define PG8_LDB(dst, b, h) do { _Pragma("unroll") for (int n = 0; n < 2; ++n) _Pragma("unroll") for (int k = 0; k < 2; ++k) dst[n][k] = *(const LAS bf16x8*)(lds + PG8_SB(b, h) + boff + n * 2048 + k * 1024); } while (0)
#define PG8_MMA(ai, bj, At, Bt) do { __builtin_amdgcn_s_setprio(1); _Pragma("unroll") for (int m = 0; m < 4; ++m) _Pragma("unroll") for (int n = 0; n < 2; ++n) _Pragma("unroll") for (int k = 0; k < 2; ++k) \
    acc[ai][bj][m][n] = __builtin_amdgcn_mfma_f32_16x16x32_bf16(Bt[n][k], At[m][k], acc[ai][bj][m][n], 0, 0, 0); __builtin_amdgcn_s_setprio(0); } while (0)
#define PG8_WAIT_V(n) asm volatile("s_waitcnt vmcnt(" #n ")" ::: "memory")
#define PG8_WAIT_L(n) asm volatile("s_waitcnt lgkmcnt(" #n ")" ::: "memory")
#define PG8_BAR __builtin_amdgcn_s_barrier()
#define PG8_SCHED __builtin_amdgcn_sched_barrier(0)
  Unit cur, nxt; int ui = 0;
  if (!S.next(0, cur)) return;
  f32x4 acc[2][2][4][2];
#pragma unroll
  for (int a = 0; a < 2; ++a)
#pragma unroll
    for (int b = 0; b < 2; ++b)
#pragma unroll
      for (int m = 0; m < 4; ++m)
#pragma unroll
        for (int n = 0; n < 2; ++n) acc[a][b][m][n] = (f32x4){0.f, 0.f, 0.f, 0.f};
  bf16x8 At[4][2], B0[2][2], B1[2][2];
  const char* cA = (const char*)g.A + (size_t)cur.pm * tstep; const char* cB = (const char*)g.Bt + (size_t)cur.pn * tstep;
  PG8_STAGE(PG8_SB(0, 0), cB); PG8_STAGE(PG8_SA(0, 0), cA); PG8_STAGE(PG8_SB(0, 1), cB + hstep); PG8_STAGE(PG8_SA(0, 1), cA + hstep);
  if (wr == 1) PG8_BAR;
  PG8_WAIT_V(4); PG8_BAR;
  PG8_STAGE(PG8_SB(1, 0), cB + kstep); PG8_STAGE(PG8_SA(1, 0), cA + kstep); PG8_STAGE(PG8_SB(1, 1), cB + hstep + kstep);
  PG8_WAIT_V(6); PG8_BAR;
  for (;;) {
    const bool has_next = S.next(ui + 1, nxt);
    const char* nA = has_next ? (const char*)g.A + (size_t)nxt.pm * tstep : cA; const char* nB = has_next ? (const char*)g.Bt + (size_t)nxt.pn * tstep : cB;
    for (int t = 0; t < nt; t += 2) {
      const bool last = (t == nt - 2);
      const char* a1 = cA + (size_t)(t + 1) * kstep;
      const char* a2 = last ? nA : cA + (size_t)(t + 2) * kstep; const char* b2 = last ? nB : cB + (size_t)(t + 2) * kstep;
      const char* a3 = a2 + kstep; const char* b3 = b2 + kstep;
      PG8_LDB(B0, 0, 0); PG8_SCHED; PG8_LDA(At, 0, 0); PG8_STAGE(PG8_SA(1, 1), a1 + hstep);
      PG8_WAIT_L(8); PG8_BAR; PG8_WAIT_L(0); PG8_MMA(0, 0, At, B0); PG8_BAR; PG8_SCHED;
      PG8_LDB(B1, 0, 1); PG8_STAGE(PG8_SB(0, 0), b2);
      PG8_BAR; PG8_WAIT_L(0); PG8_MMA(0, 1, At, B1); PG8_BAR;
      PG8_LDA(At, 0, 1); PG8_STAGE(PG8_SA(0, 0), a2);
      PG8_BAR; PG8_WAIT_L(0); PG8_MMA(1, 0, At, B0); PG8_BAR; PG8_SCHED;
      PG8_STAGE(PG8_SB(0, 1), b2 + hstep);
      PG8_WAIT_V(6); PG8_BAR; PG8_MMA(1, 1, At, B1); PG8_BAR;
      PG8_LDB(B0, 1, 0); PG8_SCHED; PG8_LDA(At, 1, 0); PG8_STAGE(PG8_SA(0, 1), a2 + hstep);
      PG8_WAIT_L(8); PG8_BAR; PG8_WAIT_L(0); PG8_MMA(0, 0, At, B0); PG8_BAR; PG8_SCHED;
      PG8_LDB(B1, 1, 1); PG8_STAGE(PG8_SB(1, 0), b3);
      PG8_BAR; PG8_WAIT_L(0); PG8_MMA(0, 1, At, B1); PG8_BAR;
      PG8_LDA(At, 1, 1); PG8_STAGE(PG8_SA(1, 0), a3);
      PG8_BAR; PG8_WAIT_L(0); PG8_MMA(1, 0, At, B0); PG8_BAR; PG8_SCHED;
      PG8_STAGE(PG8_SB(1, 1), b3 + hstep);
      PG8_WAIT_V(6); PG8_BAR; PG8_MMA(1, 1, At, B1); PG8_BAR;
    }
    E(acc, cur, wr, wc, fr, fq);
    if (!has_next) break;
#pragma unroll
    for (int a = 0; a < 2; ++a)
#pragma unroll
      for (int b = 0; b < 2; ++b)
#pragma unroll
        for (int m = 0; m < 4; ++m)
#pragma unroll
          for (int n = 0; n < 2; ++n) acc[a][b][m][n] = (f32x4){0.f, 0.f, 0.f, 0.f};
    cur = nxt; cA = nA; cB = nB; ++ui;
  }
  PG8_WAIT_V(0);
  if (wr == 0) PG8_BAR;
  PG8_BAR;
#undef PG8_SA
#undef PG8_SB
#undef PG8_STAGE
#undef PG8_LDA
#undef PG8_LDB
#undef PG8_MMA
#undef PG8_WAIT_V
#undef PG8_WAIT_L
#undef PG8_BAR
#undef PG8_SCHED
}
}

enum { EPI_SWIGLU = 0, EPI_RES = 1, EPI_DA = 2, EPI_HY = 3, EPI_RT = 4, EPI_SC = 5 };
struct Epi {
  int mode; float coef;
  void* p0; void* p1; void* p2; void* p3; const float* f0;
  DI void store_t(bf16_t* T, int colbase, const f32x4 (&acc)[2][2][4][2], int rowbase, int wr, int wc, int fr, int fq) const {
#pragma unroll
    for (int ai = 0; ai < 2; ++ai)
#pragma unroll
      for (int m = 0; m < 4; ++m) {
        const int row = rowbase + ai * 128 + wr * 64 + m * 16 + fr;
#pragma unroll
        for (int bj = 0; bj < 2; ++bj)
#pragma unroll
          for (int n = 0; n < 2; ++n) {
            const int col = colbase + bj * 128 + wc * 32 + n * 16 + fq * 4;
            const unsigned w0 = pk_bf16(acc[ai][bj][m][n][0], acc[ai][bj][m][n][1]), w1 = pk_bf16(acc[ai][bj][m][n][2], acc[ai][bj][m][n][3]);
            T[(size_t)(col + 0) * MT + row] = (bf16_t)(w0 & 0xffffu); T[(size_t)(col + 1) * MT + row] = (bf16_t)(w0 >> 16);
            T[(size_t)(col + 2) * MT + row] = (bf16_t)(w1 & 0xffffu); T[(size_t)(col + 3) * MT + row] = (bf16_t)(w1 >> 16);
          }
      }
  }
  DI void operator()(const f32x4 (&acc)[2][2][4][2], const pg8::Unit& u, int wr, int wc, int fr, int fq) const {
    const int rowbase = u.pm * 256;
    if (mode == EPI_SWIGLU) {
      bf16_t* O = (bf16_t*)p0;
#pragma unroll
      for (int ai = 0; ai < 2; ++ai)
#pragma unroll
        for (int m = 0; m < 4; ++m) {
          bf16_t* rowp = O + (size_t)(rowbase + ai * 128 + wr * 64 + m * 16 + fr) * DFF + u.pn * 128 + wc * 32 + 4 * fq;
#pragma unroll
          for (int n = 0; n < 2; ++n) {
            const f32x4 a = acc[ai][0][m][n], g = acc[ai][1][m][n]; f32x4 v;
#pragma unroll
            for (int j = 0; j < 4; ++j) v[j] = silu_f(a[j]) * g[j];
            st_bf4(rowp + n * 16, v);
          }
        }
    } else if (mode == EPI_RES) {
      float* X = (float*)p0; const int mb = u.pm < 64 ? (u.pm >> 3) : 8;
      const int col0 = u.pn * 256 + wc * 32 + 4 * fq;
      f32x4 gv[2][2];
#pragma unroll
      for (int bj = 0; bj < 2; ++bj)
#pragma unroll
        for (int n = 0; n < 2; ++n) gv[bj][n] = *(const f32x4*)(f0 + (size_t)mb * 9216 + col0 + bj * 128 + n * 16) * coef;
#pragma unroll
      for (int ai = 0; ai < 2; ++ai)
#pragma unroll
        for (int m = 0; m < 4; ++m) {
          float* rowp = X + (size_t)(rowbase + ai * 128 + wr * 64 + m * 16 + fr) * DM + col0;
#pragma unroll
          for (int bj = 0; bj < 2; ++bj)
#pragma unroll
            for (int n = 0; n < 2; ++n) { float* q = rowp + bj * 128 + n * 16; const f32x4 x = *(const f32x4*)q; *(f32x4*)q = x * ALPHA + gv[bj][n] * acc[ai][bj][m][n]; }
        }
    } else if (mode == EPI_DA) {
      if (u.pn < 8) {
        bf16_t* base = (bf16_t*)(u.pn < 4 ? p0 : p1); const float sc = u.pn < 4 ? 0.125f * LOG2E : 1.0f; const int tcol = (u.pn & 3) * 256 + wc * 64;
        const bool lat = u.pm < 64; const f32x2* rope = (const f32x2*)f0;
#pragma unroll
        for (int ai = 0; ai < 2; ++ai)
#pragma unroll
          for (int m = 0; m < 4; ++m) {
            const int row = rowbase + ai * 128 + wr * 64 + m * 16 + fr, t = row & 2047;
#pragma unroll
            for (int n = 0; n < 2; ++n) {
              const int dd = 16 * n + 4 * fq; const f32x4 x1 = acc[ai][0][m][n], x2 = acc[ai][1][m][n]; f32x4 o1, o2;
              if (lat) {
#pragma unroll
                for (int j = 0; j < 4; ++j) { const f32x2 cs = rope[t * 32 + dd + j]; o1[j] = (x1[j] * cs.x - x2[j] * cs.y) * sc; o2[j] = (x1[j] * cs.y + x2[j] * cs.x) * sc; }
              } else { o1 = x1 * sc; o2 = x2 * sc; }
              bf16_t* q = base + (size_t)row * 1024 + tcol + dd; st_bf4(q, o1); st_bf4(q + 32, o2);
            }
          }
      } else store_t((bf16_t*)p2, (u.pn - 8) * 256, acc, rowbase, wr, wc, fr, fq);
    } else if (mode == EPI_HY) {
      store_t((bf16_t*)p0, u.pn * 256, acc, rowbase, wr, wc, fr, fq);
    } else if (mode == EPI_RT) {
      if (u.pn < 8) {
        bf16_t* base = (bf16_t*)(u.pn < 4 ? p0 : p1); const float sc = u.pn < 4 ? 1.0f : 0.0625f; const int tcol = (u.pn & 3) * 256 + wc * 32;
        const bool lat = u.pm < 64; const f32x2* rope = (const f32x2*)f0;
#pragma unroll
        for (int ai = 0; ai < 2; ++ai)
#pragma unroll
          for (int m = 0; m < 4; ++m) {
            const int row = rowbase + ai * 128 + wr * 64 + m * 16 + fr, t = row & 2047;
#pragma unroll
            for (int n = 0; n < 2; ++n) {
              const int dd = wc * 32 + 16 * n + 4 * fq; const f32x4 x1 = acc[ai][0][m][n], x2 = acc[ai][1][m][n]; f32x4 o1, o2;
              if (lat) {
#pragma unroll
                for (int j = 0; j < 4; ++j) { const f32x2 cs = rope[t * 128 + dd + j]; o1[j] = (x1[j] * cs.x - x2[j] * cs.y) * sc; o2[j] = (x1[j] * cs.y + x2[j] * cs.x) * sc; }
              } else { o1 = x1 * sc; o2 = x2 * sc; }
              bf16_t* q = base + (size_t)row * 1024 + (u.pn & 3) * 256 + 16 * n + 4 * fq + wc * 32; st_bf4(q, o1); st_bf4(q + 128, o2);
            }
          }
        (void)tcol;
      } else if (u.pn < 16) store_t((bf16_t*)p2, (u.pn - 8) * 256, acc, rowbase, wr, wc, fr, fq);
      else {
        bf16_t* G = (bf16_t*)p3;
#pragma unroll
        for (int ai = 0; ai < 2; ++ai)
#pragma unroll
          for (int m = 0; m < 4; ++m) {
            bf16_t* rowp = G + (size_t)(rowbase + ai * 128 + wr * 64 + m * 16 + fr) * 2048 + (u.pn - 16) * 256 + wc * 32 + 4 * fq;
#pragma unroll
            for (int bj = 0; bj < 2; ++bj)
#pragma unroll
              for (int n = 0; n < 2; ++n) { const f32x4 a = acc[ai][bj][m][n]; f32x4 v;
#pragma unroll
                for (int j = 0; j < 4; ++j) v[j] = silu_f(a[j]);
                st_bf4(rowp + bj * 128 + n * 16, v); }
          }
      }
    } else {
      if (u.pn < 4) {
        bf16_t* BG = (bf16_t*)p0;
#pragma unroll
        for (int ai = 0; ai < 2; ++ai)
#pragma unroll
          for (int m = 0; m < 4; ++m) {
            bf16_t* rowp = BG + (size_t)(rowbase + ai * 128 + wr * 64 + m * 16 + fr) * 1024 + u.pn * 256 + wc * 32 + 4 * fq;
#pragma unroll
            for (int bj = 0; bj < 2; ++bj)
#pragma unroll
              for (int n = 0; n < 2; ++n) st_bf4(rowp + bj * 128 + n * 16, acc[ai][bj][m][n]);
          }
      } else {
        bf16_t* CU = (bf16_t*)p1;
#pragma unroll
        for (int ai = 0; ai < 2; ++ai)
#pragma unroll
          for (int m = 0; m < 4; ++m) {
            bf16_t* rowp = CU + (size_t)(rowbase + ai * 128 + wr * 64 + m * 16 + fr) * 1024 + (u.pn - 4) * 128 + wc * 32 + 4 * fq;
#pragma unroll
            for (int n = 0; n < 2; ++n) st_bf4(rowp + n * 16, acc[ai][0][m][n] * acc[ai][1][m][n]);
          }
      }
    }
  }
};

DI int map_col(int kind, int rho) {
  if (kind == 1) { const int t = rho >> 8, r = rho & 255; return r < 128 ? 128 * t + r : DFF + 128 * t + (r - 128); }
  if (kind == 2) { if (rho >= 2048) return rho; const int base = rho & ~255, r = rho & 255; const int bj = r >> 7, hm = (r & 127) >> 5, dd = r & 31; return base + hm * 64 + bj * 32 + dd; }
  if (kind == 3) { if (rho < 1024) return rho; const int t = (rho - 1024) >> 8, r = (rho - 1024) & 255; return r < 128 ? 1024 + 128 * t + r : 2048 + 128 * t + (r - 128); }
  return rho;
}

DI void conv_unit(const Params& p, int zz, int tx, LAS unsigned char* lds, int u) {
  int j = 0;
#pragma unroll 1
  for (int k = 1; k < 24; ++k) if (u >= p.jobs[k + zz].ustart) j = k;
  const WJob jb = p.jobs[j + zz];
  const int lu = u - jb.ustart, nkb = jb.K >> 7, rb = lu / nkb, kb = lu - rb * nkb;
  const int rho0 = rb * 32, k0 = kb * 128, scol0 = map_col(jb.kind, rho0);
  LAS bf16_t* T = (LAS bf16_t*)lds;
  const int tid = tx;
  { const int kk = tid >> 3, c4 = (tid & 7) * 4;
#pragma unroll
    for (int i = 0; i < 2; ++i) {
      const f32x4 v = *(const f32x4*)(jb.src + (size_t)(k0 + kk + 64 * i) * jb.srcN + scol0 + c4);
#pragma unroll
      for (int e = 0; e < 4; ++e) T[(c4 + e) * 136 + kk + 64 * i] = f2bf(v[e]);
    } }
  __syncthreads();
  { const int r = tid >> 4, kc = (tid & 15) * 8;
    const u32x4 v = *(const LAS u32x4*)(T + r * 136 + kc);
    *(u32x4*)(jb.dst + (size_t)(rho0 + r) * jb.K + k0 + kc) = v; }
  __syncthreads();
}

DI void mods_prepare(const Params& p, int zz, int tx, LAS unsigned char* lds) {
  LAS float* sc = (LAS float*)lds;
  for (int idx = tx; idx < 9216; idx += NTHR) { const int r = idx >> 10, k = idx & 1023; const float v = r < 8 ? p.in[zz + 1][r * 1024 + k] : p.in[zz + 3][k]; sc[idx] = v / (1.0f + __expf(-v)); }
  __syncthreads();
}
DI void mods_unit(const Params& p, int zz, int tx, LAS unsigned char* lds, int u) {
  LAS float* sc = (LAS float*)lds; LAS float* part = (LAS float*)(lds + 36864);
  const int l = u / 144, cb = u - l * 144, wid = tx >> 6, lane = tx & 63, col = cb * 64 + lane;
  const float* W = p.in[zz + 4] + (size_t)l * 1024 * 9216 + col;
  float acc[9];
#pragma unroll
  for (int r = 0; r < 9; ++r) acc[r] = 0.f;
#pragma unroll 8
  for (int k = wid * 128; k < wid * 128 + 128; ++k) {
    const float w = W[(size_t)k * 9216];
#pragma unroll
    for (int r = 0; r < 9; ++r) acc[r] += sc[r * 1024 + k] * w;
  }
#pragma unroll
  for (int r = 0; r < 9; ++r) part[(wid * 9 + r) * 64 + lane] = acc[r];
  __syncthreads();
  float* mods = (float*)((p.ws + zz) + WS_MODS);
  for (int idx = tx; idx < 576; idx += NTHR) {
    const int r = idx >> 6, ln = idx & 63; float s = p.in[zz + 5][l * 9216 + cb * 64 + ln];
#pragma unroll
    for (int w = 0; w < 8; ++w) s += part[(w * 9 + r) * 64 + ln];
    mods[(size_t)(l * 9 + r) * 9216 + cb * 64 + ln] = s;
  }
  __syncthreads();
}

DI void filter_unit(const Params& p, int zz, int tx, LAS unsigned char* lds, int u) {
  const bool lat = u < 256; const int n = lat ? 2048 : 256, p0 = lat ? u * 8 : (u - 256) * 8, tid = tx;
  LAS float* z = (LAS float*)lds;
  LAS float* h1 = z + 8 * 33;
  LAS float* h2 = h1 + 8 * 64;
  const float* w1 = p.in[zz + 19]; const float* b1 = p.in[zz + 20]; const float* f1 = p.in[zz + 21]; const float* w2 = p.in[zz + 22]; const float* b2 = p.in[zz + 23]; const float* f2 = p.in[zz + 24];
  const float* w3 = p.in[zz + 25]; const float* dsk = p.in[zz + 26];
  if (tid < 8 * 33) { const int pos = tid / 33, f = tid - pos * 33; const int pp = p0 + pos; const float t = (float)pp / (float)(n - 1), w = 6.283185307179586f * (float)pp / (float)n;
    float v; if (f == 0) v = t; else { const int k = (f - 1) & 15; const float fr = 1e-4f + (float)k * ((15.0f - 1e-4f) / 15.0f); v = f <= 16 ? __cosf(fr * w) : -__sinf(fr * w); }
    z[tid] = v; }
  __syncthreads();
  { const int pos = tid >> 6, o = tid & 63; float s = b1[o];
#pragma unroll 3
    for (int f = 0; f < 33; ++f) s += z[pos * 33 + f] * w1[f * 64 + o];
    h1[tid] = __sinf(f1[o] * s); }
  __syncthreads();
  { const int pos = tid >> 6, o = tid & 63; float s = b2[o];
#pragma unroll 4
    for (int k = 0; k < 64; ++k) s += h1[pos * 64 + k] * w2[k * 64 + o];
    h2[tid] = __sinf(f2[o] * s); }
  __syncthreads();
  { const int cc = tid * 4; f32x4 a[8];
#pragma unroll
    for (int q = 0; q < 8; ++q) a[q] = (f32x4){0.f, 0.f, 0.f, 0.f};
#pragma unroll 4
    for (int k = 0; k < 64; ++k) { const f32x4 w = *(const f32x4*)(w3 + (size_t)k * 2048 + cc);
#pragma unroll
      for (int q = 0; q < 8; ++q) a[q] += w * h2[q * 64 + k]; }
    const bool bwd = cc >= 1024; const int c0 = cc & 1023;
    const float mind = -3.0701134573253944f, maxd = -15.350567286626972f;
    bf16_t* R = (bf16_t*)((p.ws + zz) + (lat ? WS_HYRL : WS_HYRC)); const int rs = lat ? RL_STRIDE : RC_STRIDE;
#pragma unroll
    for (int q = 0; q < 8; ++q) { const int pp = p0 + q; const float t = (float)pp / (float)(n - 1);
#pragma unroll
      for (int e = 0; e < 4; ++e) { const int c = c0 + e; const float dl = fabsf(mind + (maxd - mind) * ((float)c / 1023.0f));
        float v = a[q][e] * __expf(-t * dl);
        if (!bwd) { if (pp == 0) v += dsk[c]; R[(size_t)c * rs + (n - pp)] = f2bf(v); }
        else if (pp > 0) R[(size_t)c * rs + (n + pp)] = f2bf(v); } }
    if (p0 == 0) { for (int idx = tid; idx < 1024 * 9; idx += NTHR) { const int c = idx / 9, e = idx - c * 9; R[(size_t)c * rs + (e == 0 ? 0 : 2 * n + e - 1)] = 0; } }
  }
  __syncthreads();
}

DI void rope_tables(const Params& p, int zz, int tx) {
  f32x2* rd = (f32x2*)((p.ws + zz) + WS_ROPE_DA); f32x2* rr = (f32x2*)((p.ws + zz) + WS_ROPE_RT);
  const int gsz = gridDim.x * NTHR, gid = blockIdx.x * NTHR + tx;
  for (int idx = gid; idx < 2048 * 32; idx += gsz) { const int t = idx >> 5, d = idx & 31; const int k = d & 15; const float inv = exp2f(-(float)k / 16.0f * 13.287712379549449f);
    const float ang = (float)(d < 16 ? (t >> 6) : (t & 63)) * inv; rd[idx] = (f32x2){__cosf(ang), __sinf(ang)}; }
  for (int idx = gid; idx < 2048 * 128; idx += gsz) { const int t = idx >> 7, d = idx & 127; const int k = d & 63; const float inv = exp2f(-(float)k / 64.0f * 13.287712379549449f);
    const float ang = (float)(d < 64 ? (t >> 6) : (t & 63)) * inv; rr[idx] = (f32x2){__cosf(ang), __sinf(ang)}; }
}

DI void init_phase(const Params& p, int zz, int tx) {
  float* X = (float*)((p.ws + zz) + WS_X); bf16_t* H = (bf16_t*)((p.ws + zz) + WS_H); const float* mods = (const float*)((p.ws + zz) + WS_MODS);
  const int wid = tx >> 6, lane = tx & 63;
  for (int row = blockIdx.x * 8 + wid; row < MT; row += gridDim.x * 8) {
    const float* src = row < ML ? p.in[zz + 0] + (size_t)row * DM : p.in[zz + 2] + (size_t)(row - ML) * DM; const int mb = row < ML ? row >> 11 : 8;
#pragma unroll
    for (int k = 0; k < 4; ++k) { const int col = k * 256 + lane * 4; const f32x4 v = *(const f32x4*)(src + col);
      *(f32x4*)(X + (size_t)row * DM + col) = v;
      const f32x4 sh = *(const f32x4*)(mods + (size_t)mb * 9216 + col), sc = *(const f32x4*)(mods + (size_t)mb * 9216 + 1024 + col);
      st_bf4(H + (size_t)row * DM + col, v * (sc + 1.0f) + sh); }
  }
}

DI void ln_phase(const Params& p, int zz, int tx, int M, const float* g, const float* bta, const float* shift, const float* scale, bool final) {
  float* X = (float*)((p.ws + zz) + WS_X); bf16_t* H = (bf16_t*)((p.ws + zz) + WS_H);
  const int wid = tx >> 6, lane = tx & 63;
  for (int row = blockIdx.x * 8 + wid; row < M; row += gridDim.x * 8) {
    float* xr = X + (size_t)row * DM; f32x4 v[4]; float s = 0.f;
#pragma unroll
    for (int k = 0; k < 4; ++k) { v[k] = *(const f32x4*)(xr + k * 256 + lane * 4); s += (v[k][0] + v[k][1]) + (v[k][2] + v[k][3]); }
    const float mean = wave_sum(s) * (1.0f / 1024.0f); float q = 0.f;
#pragma unroll
    for (int k = 0; k < 4; ++k) { const f32x4 d = v[k] - mean; q += (d[0] * d[0] + d[1] * d[1]) + (d[2] * d[2] + d[3] * d[3]); }
    const float rstd = rsqrtf(wave_sum(q) * (1.0f / 1024.0f) + LN_EPS); const int mb = row < ML ? row >> 11 : 8;
#pragma unroll
    for (int k = 0; k < 4; ++k) { const int col = k * 256 + lane * 4;
      const f32x4 y = (v[k] - mean) * rstd * *(const f32x4*)(g + col) + *(const f32x4*)(bta + col);
      if (final) { *(f32x4*)((p.out + zz) + (size_t)row * DM + col) = y; }
      else { *(f32x4*)(xr + col) = y; const f32x4 sh = *(const f32x4*)(shift + (size_t)mb * 9216 + col), sc = *(const f32x4*)(scale + (size_t)mb * 9216 + col);
        st_bf4(H + (size_t)row * DM + col, y * (sc + 1.0f) + sh); } }
  }
}

DI void sc_core_phase(const Params& p, int zz, int tx) {
  const bf16_t* BG = (const bf16_t*)((p.ws + zz) + WS_BIG); const bf16_t* CU = (const bf16_t*)((p.ws + zz) + WS_BIG + SZ_TOK1K); bf16_t* H = (bf16_t*)((p.ws + zz) + WS_H); const float* cw = p.in[zz + 33];
  for (int idx = blockIdx.x * NTHR + tx; idx < ML * 128; idx += gridDim.x * NTHR) {
    const int row = idx >> 7, c8 = (idx & 127) * 8, t = row & 2047; const size_t o = (size_t)row * 1024 + c8;
    const f32x4 z4 = (f32x4){0.f, 0.f, 0.f, 0.f};
#pragma unroll
    for (int hf = 0; hf < 2; ++hf) { const size_t oo = o + hf * 4; const int c = c8 + hf * 4;
      const f32x4 c0 = ld_bf4(CU + oo), cm = t > 0 ? ld_bf4(CU + oo - 1024) : z4, cp = t < 2047 ? ld_bf4(CU + oo + 1024) : z4, bg = ld_bf4(BG + oo);
      const f32x4 w0 = *(const f32x4*)(cw + c), w1 = *(const f32x4*)(cw + 1024 + c), w2 = *(const f32x4*)(cw + 2048 + c);
      st_bf4(H + oo, bg * (w0 * cm + w1 * c0 + w2 * cp)); }
  }
}

DI void hy_transpose_phase(const Params& p, int zz, int tx, LAS unsigned char* lds) {
  const bf16_t* ZT = (const bf16_t*)((p.ws + zz) + WS_BIG + 3 * SZ_TOK1K); bf16_t* H = (bf16_t*)((p.ws + zz) + WS_H); LAS bf16_t* T = (LAS bf16_t*)lds;
  const int tid = tx;
  for (int u = blockIdx.x; u < 16 * 288; u += gridDim.x) {
    const int ct = u & 15, tt = u >> 4, c0 = ct * 64, tok0 = tt * 64;
    { const int r = tid >> 3, ch = tid & 7; *(LAS u32x4*)(T + r * 72 + ch * 8) = *(const u32x4*)(ZT + (size_t)(c0 + r) * MT + tok0 + ch * 8); }
    __syncthreads();
    { const int tok = tid >> 3, cc = (tid & 7) * 8; unsigned w[4];
#pragma unroll
      for (int k = 0; k < 4; ++k) w[k] = (unsigned)T[(cc + 2 * k) * 72 + tok] | ((unsigned)T[(cc + 2 * k + 1) * 72 + tok] << 16);
      *(u32x4*)(H + (size_t)(tok0 + tok) * 1024 + c0 + cc) = (u32x4){w[0], w[1], w[2], w[3]}; }
    __syncthreads();
  }
}

DI void da_attn_phase(const Params& p, int zz, int tx, LAS unsigned char* lds) {
  const bf16_t* Q = (const bf16_t*)((p.ws + zz) + WS_BIG); const bf16_t* Kb = (const bf16_t*)((p.ws + zz) + WS_BIG + SZ_TOK1K); const bf16_t* VT = (const bf16_t*)((p.ws + zz) + WS_BIG + 2 * SZ_TOK1K);
  bf16_t* AO = (bf16_t*)((p.ws + zz) + WS_H);
  const int tid = tx, wid = tid >> 6, lane = tid & 63, fr = lane & 15, fq = lane >> 4;
  const float* lam = p.in[zz + 14]; const float* subln = p.in[zz + 15];
  const float lam_init = 0.2f;
  const float lam_full = __expf(wave_sum(lam[lane] * lam[64 + lane])) - __expf(wave_sum(lam[128 + lane] * lam[192 + lane])) + lam_init;
  LAS bf16_t* Ks = (LAS bf16_t*)lds;
  LAS bf16_t* Vs = (LAS bf16_t*)(lds + 17408);
  for (int it = blockIdx.x; it < 1024 + 128; it += gridDim.x) {
    const bool isctx = it >= 1024; int b, h, qrow0, nkt;
    if (!isctx) { b = it >> 7; h = (it >> 4) & 7; qrow0 = b * 2048 + (it & 15) * 128; nkt = 36; }
    else { const int j = it - 1024; b = j >> 4; h = (j >> 1) & 7; qrow0 = ML + b * 256 + (j & 1) * 128; nkt = 4; }
    bf16x8 qf[2][2];
    { const bf16_t* qp = Q + (size_t)(qrow0 + wid * 16 + fr) * 1024 + h * 128 + fq * 8;
#pragma unroll
      for (int m = 0; m < 2; ++m)
#pragma unroll
        for (int ks = 0; ks < 2; ++ks) qf[m][ks] = *(const bf16x8*)(qp + m * 64 + ks * 32); }
    f32x4 O[2][8]; float mrun[2] = {-1e30f, -1e30f}, lsum[2] = {0.f, 0.f};
#pragma unroll
    for (int m = 0; m < 2; ++m)
#pragma unroll
      for (int et = 0; et < 8; ++et) O[m][et] = (f32x4){0.f, 0.f, 0.f, 0.f};
    for (int kt = 0; kt < nkt; ++kt) {
      const int tok0 = (isctx || kt < 4) ? ML + b * 256 + kt * 64 : b * 2048 + (kt - 4) * 64;
      __syncthreads();
#pragma unroll
      for (int i = 0; i < 2; ++i) { const int id = tid + NTHR * i;
        { const int r = id >> 4, cc = id & 15; *(LAS u32x4*)(Ks + r * 136 + cc * 8) = *(const u32x4*)(Kb + (size_t)(tok0 + r) * 1024 + h * 128 + cc * 8); }
        { const int r = id >> 3, cc = id & 7; *(LAS u32x4*)(Vs + r * 72 + cc * 8) = *(const u32x4*)(VT + (size_t)(h * 128 + r) * MT + tok0 + cc * 8); } }
      __syncthreads();
      f32x4 s[2][4];
#pragma unroll
      for (int m = 0; m < 2; ++m)
#pragma unroll
        for (int kk = 0; kk < 4; ++kk) { f32x4 a4 = (f32x4){0.f, 0.f, 0.f, 0.f};
#pragma unroll
          for (int ks = 0; ks < 2; ++ks) { const bf16x8 kf = *(const LAS bf16x8*)(Ks + (kk * 16 + fr) * 136 + m * 64 + ks * 32 + fq * 8); a4 = __builtin_amdgcn_mfma_f32_16x16x32_bf16(kf, qf[m][ks], a4, 0, 0, 0); }
          s[m][kk] = a4; }
#pragma unroll
      for (int m = 0; m < 2; ++m) {
        float mx = -1e30f;
#pragma unroll
        for (int kk = 0; kk < 4; ++kk)
#pragma unroll
          for (int j = 0; j < 4; ++j) mx = fmaxf(mx, s[m][kk][j]);
        mx = fmaxf(mx, __shfl_xor(mx, 16)); mx = fmaxf(mx, __shfl_xor(mx, 32));
        const float mnew = fmaxf(mrun[m], mx), corr = fast_exp2(mrun[m] - mnew); mrun[m] = mnew; float ps = 0.f;
#pragma unroll
        for (int kk = 0; kk < 4; ++kk)
#pragma unroll
          for (int j = 0; j < 4; ++j) { const float e = fast_exp2(s[m][kk][j] - mnew); s[m][kk][j] = e; ps += e; }
        lsum[m] = lsum[m] * corr + ps;
#pragma unroll
        for (int et = 0; et < 8; ++et) O[m][et] *= corr;
      }
#pragma unroll
      for (int s2 = 0; s2 < 2; ++s2) {
        bf16x8 pf[2];
#pragma unroll
        for (int m = 0; m < 2; ++m) { u32x4 w; w.x = pk_bf16(s[m][2 * s2][0], s[m][2 * s2][1]); w.y = pk_bf16(s[m][2 * s2][2], s[m][2 * s2][3]); w.z = pk_bf16(s[m][2 * s2 + 1][0], s[m][2 * s2 + 1][1]); w.w = pk_bf16(s[m][2 * s2 + 1][2], s[m][2 * s2 + 1][3]); pf[m] = __builtin_bit_cast(bf16x8, w); }
#pragma unroll
        for (int et = 0; et < 8; ++et) {
          const u32x2 lo = *(const LAS u32x2*)(Vs + (et * 16 + fr) * 72 + 32 * s2 + 4 * fq), hi = *(const LAS u32x2*)(Vs + (et * 16 + fr) * 72 + 32 * s2 + 16 + 4 * fq);
          const bf16x8 vf = __builtin_bit_cast(bf16x8, (u32x4){lo.x, lo.y, hi.x, hi.y});
          O[0][et] = __builtin_amdgcn_mfma_f32_16x16x32_bf16(vf, pf[0], O[0][et], 0, 0, 0);
          O[1][et] = __builtin_amdgcn_mfma_f32_16x16x32_bf16(vf, pf[1], O[1][et], 0, 0, 0);
        }
      }
    }
    float inv[2];
#pragma unroll
    for (int m = 0; m < 2; ++m) { float l = lsum[m]; l += __shfl_xor(l, 16); l += __shfl_xor(l, 32); inv[m] = 1.0f / l; }
    float ss = 0.f;
#pragma unroll
    for (int et = 0; et < 8; ++et)
#pragma unroll
      for (int j = 0; j < 4; ++j) { const float o = O[0][et][j] * inv[0] - lam_full * (O[1][et][j] * inv[1]); O[0][et][j] = o; ss += o * o; }
    ss += __shfl_xor(ss, 16); ss += __shfl_xor(ss, 32);
    const float rn = rsqrtf(ss * (1.0f / 128.0f) + LN_EPS) * (1.0f - lam_init);
    bf16_t* op = AO + (size_t)(qrow0 + wid * 16 + fr) * 1024 + h * 128 + 4 * fq;
#pragma unroll
    for (int et = 0; et < 8; ++et) { const f32x4 g = *(const f32x4*)(subln + et * 16 + 4 * fq); st_bf4(op + et * 16, O[0][et] * g * rn); }
  }
}

DI void rt_attn_phase(const Params& p, int zz, int tx, LAS unsigned char* lds) {
  const bf16_t* Q = (const bf16_t*)((p.ws + zz) + WS_BIG); const bf16_t* Kb = (const bf16_t*)((p.ws + zz) + WS_BIG + SZ_TOK1K); const bf16_t* VT = (const bf16_t*)((p.ws + zz) + WS_BIG + 2 * SZ_TOK1K);
  bf16_t* G = (bf16_t*)((p.ws + zz) + WS_BIG + 4 * SZ_TOK1K);
  const int tid = tx, wid = tid >> 6, lane = tid & 63, fr = lane & 15, fq = lane >> 4;
  const float* dl = p.in[zz + 29]; const float* gn = p.in[zz + 30];
  LAS bf16_t* Ks = (LAS bf16_t*)lds;
  LAS bf16_t* Vs = (LAS bf16_t*)(lds + 16896);
  for (int it = blockIdx.x; it < 512; it += gridDim.x) {
    const int b = it >> 6, h = (it >> 4) & 3, qb = it & 15, qrow0 = b * 2048 + qb * 128;
    const float lgf = log2f(1.0f / (1.0f + expf(-dl[h]))), lgb = log2f(1.0f / (1.0f + expf(-dl[4 + h])));
    const int tq = qb * 128 + wid * 16 + fr;
    bf16x8 qf[8];
    { const bf16_t* qp = Q + (size_t)(qrow0 + wid * 16 + fr) * 1024 + h * 256 + fq * 8;
#pragma unroll
      for (int ks = 0; ks < 8; ++ks) qf[ks] = *(const bf16x8*)(qp + ks * 32); }
    f32x4 O[32];
#pragma unroll
    for (int et = 0; et < 32; ++et) O[et] = (f32x4){0.f, 0.f, 0.f, 0.f};
    for (int kt = 0; kt < 72; ++kt) {
      const bool kctx = kt < 8; const int spos = kctx ? kt * 32 : (kt - 8) * 32; const int tok0 = kctx ? ML + b * 256 + spos : b * 2048 + spos;
      __syncthreads();
#pragma unroll
      for (int i = 0; i < 2; ++i) { const int id = tid + NTHR * i, r = id >> 5, cc = id & 31; *(LAS u32x4*)(Ks + r * 264 + cc * 8) = *(const u32x4*)(Kb + (size_t)(tok0 + r) * 1024 + h * 256 + cc * 8); }
#pragma unroll
      for (int i = 0; i < 4; ++i) { const int id = tid + NTHR * i, r = id >> 2, cc = id & 3; *(LAS u32x4*)(Vs + r * 40 + cc * 8) = *(const u32x4*)(VT + (size_t)(h * 512 + r) * MT + tok0 + cc * 8); }
      __syncthreads();
      f32x4 s[2];
#pragma unroll
      for (int kk = 0; kk < 2; ++kk) { f32x4 a4 = (f32x4){0.f, 0.f, 0.f, 0.f};
#pragma unroll
        for (int ks = 0; ks < 8; ++ks) { const bf16x8 kf = *(const LAS bf16x8*)(Ks + (kk * 16 + fr) * 264 + ks * 32 + fq * 8); a4 = __builtin_amdgcn_mfma_f32_16x16x32_bf16(kf, qf[ks], a4, 0, 0, 0); }
        s[kk] = a4; }
#pragma unroll
      for (int kk = 0; kk < 2; ++kk)
#pragma unroll
        for (int j = 0; j < 4; ++j) { const int si = spos + kk * 16 + 4 * fq + j; float D;
          if (kctx) D = fast_exp2((float)(256 + tq - si) * lgf) + fast_exp2((float)(2048 + si - tq) * lgb);
          else { const int d = tq - si; D = d > 0 ? fast_exp2((float)d * lgf) : (d < 0 ? fast_exp2((float)(-d) * lgb) : 2.0f); }
          s[kk][j] *= D; }
      u32x4 w; w.x = pk_bf16(s[0][0], s[0][1]); w.y = pk_bf16(s[0][2], s[0][3]); w.z = pk_bf16(s[1][0], s[1][1]); w.w = pk_bf16(s[1][2], s[1][3]);
      const bf16x8 pf = __builtin_bit_cast(bf16x8, w);
#pragma unroll
      for (int et = 0; et < 32; ++et) {
        const u32x2 lo = *(const LAS u32x2*)(Vs + (et * 16 + fr) * 40 + 4 * fq), hi = *(const LAS u32x2*)(Vs + (et * 16 + fr) * 40 + 16 + 4 * fq);
        const bf16x8 vf = __builtin_bit_cast(bf16x8, (u32x4){lo.x, lo.y, hi.x, hi.y});
        O[et] = __builtin_amdgcn_mfma_f32_16x16x32_bf16(vf, pf, O[et], 0, 0, 0);
      }
    }
    float sm = 0.f;
#pragma unroll
    for (int et = 0; et < 32; ++et) sm += (O[et][0] + O[et][1]) + (O[et][2] + O[et][3]);
    sm += __shfl_xor(sm, 16); sm += __shfl_xor(sm, 32);
    const float mean = sm * (1.0f / 512.0f); float q = 0.f;
#pragma unroll
    for (int et = 0; et < 32; ++et) { const f32x4 d = O[et] - mean; q += (d[0] * d[0] + d[1] * d[1]) + (d[2] * d[2] + d[3] * d[3]); }
    q += __shfl_xor(q, 16); q += __shfl_xor(q, 32);
    const float rstd = rsqrtf(q * (1.0f / 512.0f) + LN_EPS);
    bf16_t* gp = G + (size_t)(qrow0 + wid * 16 + fr) * 2048 + h * 512 + 4 * fq;
#pragma unroll
    for (int et = 0; et < 32; ++et) { const f32x4 gg = ld_bf4(gp + et * 16); const f32x4 gw = *(const f32x4*)(gn + h * 512 + et * 16 + 4 * fq); st_bf4(gp + et * 16, (O[et] - mean) * rstd * gw * gg); }
  }
}

template <int SEQ>
DI void hy_conv_channel(const Params& p, int zz, int tx, LAS unsigned char* lds, int c, int tokbase, const bf16_t* Rrow) {
  constexpr int WROW = SEQ + 448, NB = SEQ / 32, NG = SEQ / 128, CAW = 2 * SEQ;
  const bf16_t* UT = (const bf16_t*)((p.ws + zz) + WS_BIG); bf16_t* ZT = (bf16_t*)((p.ws + zz) + WS_BIG + 3 * SZ_TOK1K);
  LAS bf16_t* CA = (LAS bf16_t*)lds;
  LAS bf16_t* WT = (LAS bf16_t*)(lds + 65536);
  LAS bf16_t* X0 = (LAS bf16_t*)(lds + 65536 + 39936);
  const int tid = tx, wid = tid >> 6, lane = tid & 63;
  __syncthreads();
  for (int idx = tid; idx < 8 * CAW; idx += NTHR) { const int a = idx / CAW, z = idx - a * CAW; CA[idx] = Rrow[z + a]; }
  for (int idx = tid; idx < 8 * 448; idx += NTHR) { const int b = idx / 448, e = idx - b * 448; WT[b * WROW + (e < 224 ? e : SEQ + e)] = 0; }
  const float* cw = p.in[zz + 17]; const float* cb = p.in[zz + 18];
  float w0[3], w1[3], w2[3], bs[3];
#pragma unroll
  for (int pt = 0; pt < 3; ++pt) { const int cc = pt * 1024 + c; w0[pt] = cw[cc]; w1[pt] = cw[3072 + cc]; w2[pt] = cw[6144 + cc]; bs[pt] = cb[cc]; }
  for (int idx = tid; idx < SEQ; idx += NTHR) {
    const int b = idx / (SEQ / 8), ch = idx - b * (SEQ / 8), t0 = ch * 8; const size_t tok = (size_t)tokbase + (size_t)b * SEQ + t0;
    float r[3][8];
#pragma unroll
    for (int pt = 0; pt < 3; ++pt) { const bf16_t* src = UT + (size_t)(pt * 1024 + c) * MT + tok; const u32x4 v = *(const u32x4*)src;
      float in[10]; in[0] = t0 > 0 ? bf2f(src[-1]) : 0.f; in[9] = t0 + 8 < SEQ ? bf2f(src[8]) : 0.f;
      in[1] = __uint_as_float(v.x << 16); in[2] = __uint_as_float(v.x & 0xffff0000u); in[3] = __uint_as_float(v.y << 16); in[4] = __uint_as_float(v.y & 0xffff0000u);
      in[5] = __uint_as_float(v.z << 16); in[6] = __uint_as_float(v.z & 0xffff0000u); in[7] = __uint_as_float(v.w << 16); in[8] = __uint_as_float(v.w & 0xffff0000u);
#pragma unroll
      for (int k = 0; k < 8; ++k) r[pt][k] = w0[pt] * in[k] + w1[pt] * in[k + 1] + w2[pt] * in[k + 2] + bs[pt]; }
    u32x4 wv, xv;
    wv.x = pk_bf16(r[1][0] * r[2][0], r[1][1] * r[2][1]); wv.y = pk_bf16(r[1][2] * r[2][2], r[1][3] * r[2][3]); wv.z = pk_bf16(r[1][4] * r[2][4], r[1][5] * r[2][5]); wv.w = pk_bf16(r[1][6] * r[2][6], r[1][7] * r[2][7]);
    xv.x = pk_bf16(r[0][0], r[0][1]); xv.y = pk_bf16(r[0][2], r[0][3]); xv.z = pk_bf16(r[0][4], r[0][5]); xv.w = pk_bf16(r[0][6], r[0][7]);
    *(LAS u32x4*)(WT + b * WROW + 224 + t0) = wv; *(LAS u32x4*)(X0 + b * SEQ + t0) = xv;
  }
  __syncthreads();
  if (2 * wid < NG) {
    const int i = lane & 31, hh = lane >> 5, Iq = i >> 3, bb = i & 7;
    f32x16 acc0, acc1;
#pragma unroll
    for (int r = 0; r < 16; ++r) { acc0[r] = 0.f; acc1[r] = 0.f; }
    for (int d = 8 * wid - (NB - 1); d <= 8 * wid + 7; ++d) {
#pragma unroll
      for (int ks = 0; ks < 2; ++ks) {
        const int x0i = SEQ - (32 * d + i - 16 * ks - 8 * hh), a = x0i & 7;
        const bf16x8 A = *(const LAS bf16x8*)(CA + a * CAW + (x0i - a));
        const int jtok = 224 + (8 * wid + Iq - d) * 32 + 16 * ks + 8 * hh;
        const bf16x8 B0 = *(const LAS bf16x8*)(WT + bb * WROW + jtok), B1 = *(const LAS bf16x8*)(WT + bb * WROW + jtok + 128);
        acc0 = __builtin_amdgcn_mfma_f32_32x32x16_bf16(A, B0, acc0, 0, 0, 0);
        acc1 = __builtin_amdgcn_mfma_f32_32x32x16_bf16(A, B1, acc1, 0, 0, 0);
      }
    }
#pragma unroll
    for (int g = 0; g < 2; ++g)
#pragma unroll
      for (int rg = 0; rg < 4; ++rg) {
        const int t0 = (8 * wid + 4 * g + Iq) * 32 + 8 * rg + 4 * hh;
        const u32x2 xw = *(const LAS u32x2*)(X0 + bb * SEQ + t0);
        const f32x4 xf = (f32x4){__uint_as_float(xw.x << 16), __uint_as_float(xw.x & 0xffff0000u), __uint_as_float(xw.y << 16), __uint_as_float(xw.y & 0xffff0000u)};
        f32x4 y; if (g == 0) y = (f32x4){acc0[4 * rg], acc0[4 * rg + 1], acc0[4 * rg + 2], acc0[4 * rg + 3]}; else y = (f32x4){acc1[4 * rg], acc1[4 * rg + 1], acc1[4 * rg + 2], acc1[4 * rg + 3]};
        st_bf4(ZT + (size_t)c * MT + tokbase + bb * SEQ + t0, y * xf);
      }
  }
}

DI void hy_conv_phase(const Params& p, int zz, int tx, LAS unsigned char* lds) {
  const bf16_t* RL = (const bf16_t*)((p.ws + zz) + WS_HYRL); const bf16_t* RC = (const bf16_t*)((p.ws + zz) + WS_HYRC);
  for (int c = blockIdx.x; c < 1024; c += gridDim.x) {
    hy_conv_channel<2048>(p, zz, tx, lds, c, 0, RL + (size_t)c * RL_STRIDE);
    hy_conv_channel<256>(p, zz, tx, lds, c, ML, RC + (size_t)c * RC_STRIDE);
  }
}

#ifndef PHMASK
#define PHMASK 0xffff
#endif
#define HAS(x) (((PHMASK) >> (x)) & 1)
__global__ void __launch_bounds__(NTHR) fwd_kernel(Params p) {
  extern __shared__ __attribute__((aligned(16))) unsigned char lds_raw[];
  LAS unsigned char* lds = (LAS unsigned char*)lds_raw;
  cg::grid_group grid = cg::this_grid();
  for (int ph = p.ph_lo; ph < p.ph_hi; ++ph) {
    if (ph > p.ph_lo) grid.sync();
    int zz = 0; asm volatile("" : "+s"(zz));
    int tx = threadIdx.x; asm volatile("" : "+v"(tx));
    unsigned char* ws = p.ws + zz;
    const float* mods = (const float*)(ws + WS_MODS);
    if (HAS(0) && ph == 0) {
      mods_prepare(p, zz, tx, lds);
      for (int u = blockIdx.x; u < 576; u += gridDim.x) mods_unit(p, zz, tx, lds, u);
      for (int u = blockIdx.x; u < 288; u += gridDim.x) filter_unit(p, zz, tx, lds, u);
      for (int u = blockIdx.x; u < p.nconv_units; u += gridDim.x) conv_unit(p, zz, tx, lds, u);
      rope_tables(p, zz, tx);
      continue;
    }
    if (HAS(1) && ph == 1) { init_phase(p, zz, tx); continue; }
    const int l = (ph - 2) / 11, sub = (ph - 2) % 11;
    const int Mfull = l < 2 ? MT : ML, Mpre = l < 3 ? MT : ML;
    const float* lmods = mods + (size_t)l * 9 * 9216;
    const bf16_t* wl = (const bf16_t*)(ws + (size_t)l * LAYER_W);
    bool is_gemm = false; pg8::Gemm g{nullptr, nullptr, 0, 0, 0}; Epi E{0, 0.f, nullptr, nullptr, nullptr, nullptr, nullptr};
    bf16_t* Hb = (bf16_t*)(ws + WS_H); bf16_t* BIG = (bf16_t*)(ws + WS_BIG); float* X = (float*)(ws + WS_X);
    switch (sub) {
      case 0: is_gemm = true; g = {Hb, wl, Mpre, 2 * DFF, DM}; E.mode = EPI_SWIGLU; E.p0 = BIG; break;
      case 1: is_gemm = true; g = {BIG, wl + (size_t)2 * DFF * DM, Mpre, DM, DFF}; E.mode = EPI_RES; E.p0 = X; E.f0 = lmods + 2 * 1024; E.coef = 0.5f; break;
      case 2: if (HAS(2)) ln_phase(p, zz, tx, Mpre, p.in[zz + 6] + (l * 3 + 0) * 1024, p.in[zz + 7] + (l * 3 + 0) * 1024, lmods + 3 * 1024, lmods + 4 * 1024, false); break;
      case 3: is_gemm = true;
        if (l == 0) { g = {Hb, (const bf16_t*)(ws + W_DA_QKV), Mpre, 3072, DM}; E.mode = EPI_DA; E.p0 = BIG; E.p1 = (unsigned char*)BIG + SZ_TOK1K; E.p2 = (unsigned char*)BIG + 2 * SZ_TOK1K; E.f0 = (const float*)(ws + WS_ROPE_DA); }
        else if (l == 1) { g = {Hb, (const bf16_t*)(ws + W_HY_IN), Mpre, 3072, DM}; E.mode = EPI_HY; E.p0 = BIG; }
        else if (l == 2) { g = {Hb, (const bf16_t*)(ws + W_RT_IN), Mpre, 6144, DM}; E.mode = EPI_RT; E.p0 = BIG; E.p1 = (unsigned char*)BIG + SZ_TOK1K; E.p2 = (unsigned char*)BIG + 2 * SZ_TOK1K; E.p3 = (unsigned char*)BIG + 4 * SZ_TOK1K; E.f0 = (const float*)(ws + WS_ROPE_RT); }
        else { g = {Hb, (const bf16_t*)(ws + W_SC_IN), Mpre, 3072, DM}; E.mode = EPI_SC; E.p0 = BIG; E.p1 = (unsigned char*)BIG + SZ_TOK1K; }
        break;
      case 4:
        if (HAS(4) && l == 0) da_attn_phase(p, zz, tx, lds); else if (HAS(5) && l == 1) hy_conv_phase(p, zz, tx, lds); else if (HAS(6) && l == 2) rt_attn_phase(p, zz, tx, lds); else if (HAS(7) && l == 3) sc_core_phase(p, zz, tx);
        break;
      case 5: if (HAS(8) && l == 1) hy_transpose_phase(p, zz, tx, lds); break;
      case 6: is_gemm = true; E.mode = EPI_RES; E.p0 = X; E.f0 = lmods + 5 * 1024; E.coef = 1.0f;
        if (l == 0) g = {Hb, (const bf16_t*)(ws + W_DA_O), Mfull, DM, DM};
        else if (l == 1) g = {Hb, (const bf16_t*)(ws + W_HY_O), Mfull, DM, DM};
        else if (l == 2) g = {(const bf16_t*)((unsigned char*)BIG + 4 * SZ_TOK1K), (const bf16_t*)(ws + W_RT_O), Mfull, DM, 2048};
        else g = {Hb, (const bf16_t*)(ws + W_SC_O), Mfull, DM, DM};
        break;
      case 7: if (HAS(2)) ln_phase(p, zz, tx, Mfull, p.in[zz + 6] + (l * 3 + 1) * 1024, p.in[zz + 7] + (l * 3 + 1) * 1024, lmods + 6 * 1024, lmods + 7 * 1024, false); break;
      case 8: is_gemm = true; g = {Hb, wl + (size_t)(2 * DFF * DM + DM * DFF), Mfull, 2 * DFF, DM}; E.mode = EPI_SWIGLU; E.p0 = BIG; break;
      case 9: is_gemm = true; g = {BIG, wl + (size_t)(2 * DFF * DM + DM * DFF + 2 * DFF * DM), Mfull, DM, DFF}; E.mode = EPI_RES; E.p0 = X; E.f0 = lmods + 8 * 1024; E.coef = 0.5f; break;
      default:
        if (HAS(2)) ln_phase(p, zz, tx, Mfull, p.in[zz + 6] + (l * 3 + 2) * 1024, p.in[zz + 7] + (l * 3 + 2) * 1024, lmods + 9 * 9216, lmods + 9 * 9216 + 1024, l == 3); break;
    }
    if (HAS(3) && is_gemm) { pg8::StaticOrder S; S.init(g.M, g.N, (int)gridDim.x, (int)blockIdx.x); pg8::gemm_phase<Epi>(tx, lds, g, S, E); }
  }
}

extern "C" void kernel_launch(void* const* d_in, const int* in_sizes, int n_in, void* d_out, int out_size, void* d_ws, size_t ws_size, hipStream_t stream) {
  static int grid = 0;
  if (grid == 0) {
    if (n_in != 35 || ws_size < WS_END) { fprintf(stderr, "kernel_launch: need 35 inputs and %zu bytes of workspace; got %d, %zu\n", (size_t)WS_END, n_in, ws_size); grid = -1; return; }
    int dev = 0, cus = 0, per_cu = 0;
    hipGetDevice(&dev); hipDeviceGetAttribute(&cus, hipDeviceAttributeMultiprocessorCount, dev);
    if (hipFuncSetAttribute((const void*)fwd_kernel, hipFuncAttributeMaxDynamicSharedMemorySize, LDS_BYTES) != hipSuccess) { fprintf(stderr, "kernel_launch: hipFuncSetAttribute failed\n"); grid = -1; return; }
    if (hipOccupancyMaxActiveBlocksPerMultiprocessor(&per_cu, (const void*)fwd_kernel, NTHR, LDS_BYTES) != hipSuccess || per_cu < 1) { fprintf(stderr, "kernel_launch: occupancy query gave %d\n", per_cu); per_cu = 1; }
    (void)hipGetLastError();
    grid = cus * per_cu;
    fprintf(stderr, "kernel_launch: grid %d (%d CUs x %d)\n", grid, cus, per_cu);
  }
  if (grid < 0) return;
  Params p{};
  for (int i = 0; i < 35; ++i) p.in[i] = (const float*)d_in[i];
  p.out = (float*)d_out; p.ws = (unsigned char*)d_ws;
  unsigned char* ws = (unsigned char*)d_ws;
  int nj = 0, ustart = 0;
  auto add = [&](const float* src, size_t dst_off, int K, int N, int kind) { WJob& j = p.jobs[nj++]; j.src = src; j.dst = (bf16_t*)(ws + dst_off); j.K = K; j.N = N; j.srcN = N; j.kind = kind; j.ustart = ustart; j.pad = 0; ustart += (N / 32) * (K / 128); };
  for (int l = 0; l < 4; ++l) {
    const size_t base = (size_t)l * LAYER_W;
    add(p.in[8] + (size_t)l * DM * 2 * DFF, base, DM, 2 * DFF, 1);
    add(p.in[9] + (size_t)l * DFF * DM, base + SZ_WI, DFF, DM, 0);
    add(p.in[10] + (size_t)l * DM * 2 * DFF, base + SZ_WI + SZ_WO, DM, 2 * DFF, 1);
    add(p.in[11] + (size_t)l * DFF * DM, base + 2 * SZ_WI + SZ_WO, DFF, DM, 0);
  }
  add(p.in[12], W_DA_QKV, DM, 3072, 2); add(p.in[13], W_DA_O, DM, DM, 0);
  add(p.in[16], W_HY_IN, DM, 3072, 0);  add(p.in[27], W_HY_O, DM, DM, 0);
  add(p.in[28], W_RT_IN, DM, 6144, 0);  add(p.in[31], W_RT_O, 2048, DM, 0);
  add(p.in[32], W_SC_IN, DM, 3072, 3);  add(p.in[34], W_SC_O, DM, DM, 0);
  p.nconv_units = ustart; p.ph_lo = 0; p.ph_hi = 2 + 4 * 11; p.pad = 0;
  void* args[] = {&p};
  hipError_t e = hipLaunchCooperativeKernel((const void*)fwd_kernel, dim3(grid), dim3(NTHR), args, LDS_BYTES, stream);
  if (e != hipSuccess) fprintf(stderr, "kernel_launch: cooperative launch failed: %s (grid %d)\n", hipGetErrorString(e), grid);
}
```

```cpp
#include <hip/hip_runtime.h>
#include <hip/hip_cooperative_groups.h>
#include <cstdio>
namespace cg = cooperative_groups;

#define LAS __attribute__((address_space(3)))
#define DI __device__ __forceinline__
typedef unsigned short bf16_t;
typedef short bf16x8 __attribute__((ext_vector_type(8)));
typedef short s16x4 __attribute__((ext_vector_type(4)));
typedef float f32x4 __attribute__((ext_vector_type(4)));
typedef float f32x2 __attribute__((ext_vector_type(2)));
typedef float f32x16 __attribute__((ext_vector_type(16)));
typedef unsigned u32x4 __attribute__((ext_vector_type(4)));
typedef unsigned u32x2 __attribute__((ext_vector_type(2)));

constexpr int ML = 16384, MC = 2048, MT = 18432, DM = 1024, DFF = 2816;
constexpr int NTHR = 512;
constexpr int LDS_BYTES = 140 * 1024;
constexpr float ALPHA = 1.681792830507429f;
constexpr float LN_EPS = 1e-5f;
constexpr float LOG2E = 1.4426950408889634f;

constexpr size_t al256(size_t x) { return (x + 255) & ~(size_t)255; }
constexpr size_t SZ_WI = (size_t)2 * DFF * DM * 2, SZ_WO = (size_t)DM * DFF * 2;
constexpr size_t LAYER_W = 2 * (SZ_WI + SZ_WO);
constexpr size_t WS_WMIX = 4 * LAYER_W;
constexpr size_t W_DA_QKV = WS_WMIX, W_DA_O = W_DA_QKV + (size_t)3072 * 1024 * 2, W_HY_IN = W_DA_O + (size_t)1024 * 1024 * 2,
                 W_HY_O = W_HY_IN + (size_t)3072 * 1024 * 2, W_RT_IN = W_HY_O + (size_t)1024 * 1024 * 2, W_RT_O = W_RT_IN + (size_t)6144 * 1024 * 2,
                 W_SC_IN = W_RT_O + (size_t)1024 * 2048 * 2, W_SC_O = W_SC_IN + (size_t)3072 * 1024 * 2, W_END = W_SC_O + (size_t)1024 * 1024 * 2;
constexpr size_t WS_MODS = al256(W_END);
constexpr size_t WS_ROPE_DA = al256(WS_MODS + (size_t)4 * 9 * 9216 * 4);
constexpr size_t WS_ROPE_RT = al256(WS_ROPE_DA + (size_t)2048 * 32 * 8);
constexpr int RL_STRIDE = 4104, RC_STRIDE = 520;
constexpr size_t WS_HYRL = al256(WS_ROPE_RT + (size_t)2048 * 128 * 8);
constexpr size_t WS_HYRC = al256(WS_HYRL + (size_t)1024 * RL_STRIDE * 2);
constexpr size_t WS_X = al256(WS_HYRC + (size_t)1024 * RC_STRIDE * 2);
constexpr size_t WS_H = al256(WS_X + (size_t)MT * DM * 4);
constexpr size_t WS_BIG = al256(WS_H + (size_t)MT * DM * 2);
constexpr size_t SZ_TOK1K = (size_t)MT * 1024 * 2;
constexpr size_t BIG_BYTES = 6 * SZ_TOK1K;
constexpr size_t WS_BAR = al256(WS_BIG + BIG_BYTES);
constexpr size_t WS_END = WS_BAR + 16384;

struct WJob { const float* src; bf16_t* dst; int K, N, srcN, kind, ustart, pad; };
struct Params {
  const float* in[35];
  float* out;
  unsigned char* ws;
  WJob jobs[24];
  int nconv_units, ph_lo, ph_hi, pad;
};

DI float bf2f(bf16_t h) { return __uint_as_float(((unsigned)h) << 16); }
DI unsigned pk_bf16(float lo, float hi) { unsigned r; asm("v_cvt_pk_bf16_f32 %0, %1, %2" : "=v"(r) : "v"(lo), "v"(hi)); return r; }
DI bf16_t f2bf(float f) { return (bf16_t)(pk_bf16(f, 0.f) & 0xffffu); }
DI float fast_exp2(float x) { return __builtin_amdgcn_exp2f(x); }
DI float silu_f(float a) { return a * __builtin_amdgcn_rcpf(1.0f + __expf(-a)); }
DI float wave_sum(float v) {
#pragma unroll
  for (int o = 32; o >= 1; o >>= 1) v += __shfl_xor(v, o);
  return v;
}
DI f32x4 ld_bf4(const bf16_t* p) { u32x2 w = *(const u32x2*)p; return (f32x4){__uint_as_float(w.x << 16), __uint_as_float(w.x & 0xffff0000u), __uint_as_float(w.y << 16), __uint_as_float(w.y & 0xffff0000u)}; }
DI void st_bf4(bf16_t* p, f32x4 v) { u32x2 w; w.x = pk_bf16(v[0], v[1]); w.y = pk_bf16(v[2], v[3]); *(u32x2*)p = w; }

namespace pg8 {
constexpr int BM = 256, BK = 64, HALF = 128, HTB = HALF * BK * 2, STAGE_BYTES = 8 * HTB, NXCD = 8, WGM = 8;
DI int lds_byte(int r, int c) { const int st = (r >> 4) * 2 + (c >> 5), rr = r & 15, cc = c & 31, ob = rr * 64 + cc * 2; return st * 1024 + (ob ^ (((ob >> 9) & 1) << 5)); }
DI void stage_rc(int b, int& R, int& C) { const int st = b / 1024, sb = b % 1024, swz = sb ^ (((sb >> 9) & 1) << 5); R = (st >> 1) * 16 + swz / 64; C = (st & 1) * 32 + (swz % 64) / 2; }
struct Unit { int pm, pn; };
struct Gemm { const bf16_t* A; const bf16_t* Bt; int M, N, K; };
struct StaticOrder {
  int nM, nN, nwg, G, c;
  DI void init(int M, int N, int G_, int c_) { nM = M / BM; nN = N / BM; nwg = nM * nN; G = G_; c = c_; }
  DI bool next(int i, Unit& u) const {
    const long L = (long)i * G + c; if (L >= nwg) return false;
    int wgid = (int)L; { const int q = nwg / NXCD, r = nwg % NXCD, xcd = wgid % NXCD, off = wgid / NXCD; wgid = (xcd < r ? xcd * (q + 1) : r * (q + 1) + (xcd - r) * q) + off; }
    const int nig = WGM * nN, gid = wgid / nig, fm = gid * WGM, gsz = (nM - fm) < WGM ? (nM - fm) : WGM;
    u.pm = fm + ((wgid % nig) % gsz); u.pn = (wgid % nig) / gsz; return true;
  }
};

template <class Epi>
DI void gemm_phase(int tx, LAS unsigned char* lds, const Gemm g, const StaticOrder& S, const Epi& E) {
  const int tid = tx, wid = __builtin_amdgcn_readfirstlane(tid >> 6), lane = tid & 63, wr = wid >> 2, wc = wid & 3, fr = lane & 15, fq = lane >> 4;
  const int K = g.K, nt = K / BK;
  unsigned voffA[2];
#pragma unroll
  for (int i = 0; i < 2; ++i) { int R, C; stage_rc(tid * 16 + i * 8192, R, C); voffA[i] = (unsigned)(R * K + C) * 2u; }
  const size_t kstep = (size_t)(BK * 2);
  const size_t hstep = (size_t)HALF * K * 2;
  const size_t tstep = 2 * hstep;
  const unsigned ldsw = (unsigned)wid * 1024u;
  const int aoff = lds_byte(wr * 64 + fr, fq * 8), boff = lds_byte(wc * 32 + fr, fq * 8);
#define PG8_SA(b, h) (((b) * 2 + (h)) * HTB)
#define PG8_SB(b, h) ((4 + (b) * 2 + (h)) * HTB)
#define PG8_STAGE(bufoff, gbase) do { _Pragma("unroll") for (int _i = 0; _i < 2; ++_i) \
    __builtin_amdgcn_global_load_lds((const unsigned*)((const char*)(gbase) + voffA[_i]), (LAS unsigned*)(lds + (bufoff) + ldsw + _i * 8192), 16, 0, 0); } while (0)
#define PG8_LDA(dst, b, h) do { _Pragma("unroll") for (int m = 0; m < 4; ++m) _Pragma("unroll") for (int k = 0; k < 2; ++k) dst[m][k] = *(const LAS bf16x8*)(lds + PG8_SA(b, h) + aoff + m * 2048 + k * 1024); } while (0)
#define PG8_LDB(dst, b, h) do { _Pragma("unroll") for (int n = 0; n < 2; ++n) _Pragma("unroll") for (int k = 0; k < 2; ++k) dst[n][k] = *(const LAS bf16x8*)(lds + PG8_SB(b, h) + boff + n * 2048 + k * 1024); } while (0)
#define PG8_MMA(ai, bj, At, Bt) do { __builtin_amdgcn_s_setprio(1); _Pragma("unroll") for (int m = 0; m < 4; ++m) _Pragma("unroll") for (int n = 0; n < 2; ++n) _Pragma("unroll") for (int k = 0; k < 2; ++k) \
    acc[ai][bj][m][n] = __builtin_amdgcn_mfma_f32_16x16x32_bf16(Bt[n][k], At[m][k], acc[ai][bj][m][n], 0, 0, 0); __builtin_amdgcn_s_setprio(0); } while (0)
#define PG8_WAIT_V(n) asm volatile("s_waitcnt vmcnt(" #n ")" ::: "memory")
#define PG8_WAIT_L(n) asm volatile("s_waitcnt lgkmcnt(" #n ")" ::: "memory")
#define PG8_BAR __builtin_amdgcn_s_barrier()
#define PG8_SCHED __builtin_amdgcn_sched_barrier(0)
  Unit cur, nxt; int ui = 0;
  if (!S.next(0, cur)) return;
  f32x4 acc[2][2][4][2];
#pragma unroll
  for (int a = 0; a < 2; ++a)
#pragma unroll
    for (int b = 0; b < 2; ++b)
#pragma unroll
      for (int m = 0; m < 4; ++m)
#pragma unroll
        for (int n = 0; n < 2; ++n) acc[a][b][m][n] = (f32x4){0.f, 0.f, 0.f, 0.f};
  bf16x8 At[4][2], B0[2][2], B1[2][2];
  const char* cA = (const char*)g.A + (size_t)cur.pm * tstep; const char* cB = (const char*)g.Bt + (size_t)cur.pn * tstep;
  PG8_STAGE(PG8_SB(0, 0), cB); PG8_STAGE(PG8_SA(0, 0), cA); PG8_STAGE(PG8_SB(0, 1), cB + hstep); PG8_STAGE(PG8_SA(0, 1), cA + hstep);
  if (wr == 1) PG8_BAR;
  PG8_WAIT_V(4); PG8_BAR;
  PG8_STAGE(PG8_SB(1, 0), cB + kstep); PG8_STAGE(PG8_SA(1, 0), cA + kstep); PG8_STAGE(PG8_SB(1, 1), cB + hstep + kstep);
  PG8_WAIT_V(6); PG8_BAR;
  for (;;) {
    const bool has_next = S.next(ui + 1, nxt);
    const char* nA = has_next ? (const char*)g.A + (size_t)nxt.pm * tstep : cA; const char* nB = has_next ? (const char*)g.Bt + (size_t)nxt.pn * tstep : cB;
    for (int t = 0; t < nt; t += 2) {
      const bool last = (t == nt - 2);
      const char* a1 = cA + (size_t)(t + 1) * kstep;
      const char* a2 = last ? nA : cA + (size_t)(t + 2) * kstep; const char* b2 = last ? nB : cB + (size_t)(t + 2) * kstep;
      const char* a3 = a2 + kstep; const char* b3 = b2 + kstep;
      PG8_LDB(B0, 0, 0); PG8_SCHED; PG8_LDA(At, 0, 0); PG8_STAGE(PG8_SA(1, 1), a1 + hstep);
      PG8_WAIT_L(8); PG8_BAR; PG8_WAIT_L(0); PG8_MMA(0, 0, At, B0); PG8_BAR; PG8_SCHED;
      PG8_LDB(B1, 0, 1); PG8_STAGE(PG8_SB(0, 0), b2);
      PG8_BAR; PG8_WAIT_L(0); PG8_MMA(0, 1, At, B1); PG8_BAR;
      PG8_LDA(At, 0, 1); PG8_STAGE(PG8_SA(0, 0), a2);
      PG8_BAR; PG8_WAIT_L(0); PG8_MMA(1, 0, At, B0); PG8_BAR; PG8_SCHED;
      PG8_STAGE(PG8_SB(0, 1), b2 + hstep);
      PG8_WAIT_V(6); PG8_BAR; PG8_MMA(1, 1, At, B1); PG8_BAR;
      PG8_LDB(B0, 1, 0); PG8_SCHED; PG8_LDA(At, 1, 0); PG8_STAGE(PG8_SA(0, 1), a2 + hstep);
      PG8_WAIT_L(8); PG8_BAR; PG8_WAIT_L(0); PG8_MMA(0, 0, At, B0); PG8_BAR; PG8_SCHED;
      PG8_LDB(B1, 1, 1); PG8_STAGE(PG8_SB(1, 0), b3);
      PG8_BAR; PG8_WAIT_L(0); PG8_MMA(0, 1, At, B1); PG8_BAR;
      PG8_LDA(At, 1, 1); PG8_STAGE(PG8_SA(1, 0), a3);
      PG8_BAR; PG8_WAIT_L(0); PG8_MMA(1, 0, At, B0); PG8_BAR; PG8_SCHED;
      PG8_STAGE(PG8_SB(1, 1), b3 + hstep);
      PG8_WAIT_V(6); PG8_BAR; PG8_MMA(1, 1, At, B1); PG8_BAR;
    }
    E(acc, cur, wr, wc, fr, fq);
    if (!has_next) break;
#pragma unroll
    for (int a = 0; a < 2; ++a)
#pragma unroll
      for (int b = 0; b < 2; ++b)
#pragma unroll
        for (int m = 0; m < 4; ++m)
#pragma unroll
          for (int n = 0; n < 2; ++n) acc[a][b][m][n] = (f32x4){0.f, 0.f, 0.f, 0.f};
    cur = nxt; cA = nA; cB = nB; ++ui;
  }
  PG8_WAIT_V(0);
  if (wr == 0) PG8_BAR;
  PG8_BAR;
#undef PG8_SA
#undef PG8_SB
#undef PG8_STAGE
#undef PG8_LDA
#undef PG8_LDB
#undef PG8_MMA
#undef PG8_WAIT_V
#undef PG8_WAIT_L
#undef PG8_BAR
#undef PG8_SCHED
}
}

enum { EPI_SWIGLU = 0, EPI_RES = 1, EPI_DA = 2, EPI_HY = 3, EPI_RT = 4, EPI_SC = 5 };
struct Epi {
  int mode; float coef;
  void* p0; void* p1; void* p2; void* p3; const float* f0;
  DI void store_t(bf16_t* T, int colbase, const f32x4 (&acc)[2][2][4][2], int rowbase, int wr, int wc, int fr, int fq) const {
#pragma unroll
    for (int ai = 0; ai < 2; ++ai)
#pragma unroll
      for (int m = 0; m < 4; ++m) {
        const int row = rowbase + ai * 128 + wr * 64 + m * 16 + fr;
#pragma unroll
        for (int bj = 0; bj < 2; ++bj)
#pragma unroll
          for (int n = 0; n < 2; ++n) {
            const int col = colbase + bj * 128 + wc * 32 + n * 16 + fq * 4;
            const unsigned w0 = pk_bf16(acc[ai][bj][m][n][0], acc[ai][bj][m][n][1]), w1 = pk_bf16(acc[ai][bj][m][n][2], acc[ai][bj][m][n][3]);
            T[(size_t)(col + 0) * MT + row] = (bf16_t)(w0 & 0xffffu); T[(size_t)(col + 1) * MT + row] = (bf16_t)(w0 >> 16);
            T[(size_t)(col + 2) * MT + row] = (bf16_t)(w1 & 0xffffu); T[(size_t)(col + 3) * MT + row] = (bf16_t)(w1 >> 16);
          }
      }
  }
  DI void operator()(const f32x4 (&acc)[2][2][4][2], const pg8::Unit& u, int wr, int wc, int fr, int fq) const {
    const int rowbase = u.pm * 256;
    if (mode == EPI_SWIGLU) {
      bf16_t* O = (bf16_t*)p0;
#pragma unroll
      for (int ai = 0; ai < 2; ++ai)
#pragma unroll
        for (int m = 0; m < 4; ++m) {
          bf16_t* rowp = O + (size_t)(rowbase + ai * 128 + wr * 64 + m * 16 + fr) * DFF + u.pn * 128 + wc * 32 + 4 * fq;
#pragma unroll
          for (int n = 0; n < 2; ++n) {
            const f32x4 a = acc[ai][0][m][n], g = acc[ai][1][m][n]; f32x4 v;
#pragma unroll
            for (int j = 0; j < 4; ++j) v[j] = silu_f(a[j]) * g[j];
            st_bf4(rowp + n * 16, v);
          }
        }
    } else if (mode == EPI_RES) {
      float* X = (float*)p0; const int mb = u.pm < 64 ? (u.pm >> 3) : 8;
      const int col0 = u.pn * 256 + wc * 32 + 4 * fq;
      f32x4 gv[2][2];
#pragma unroll
      for (int bj = 0; bj < 2; ++bj)
#pragma unroll
        for (int n = 0; n < 2; ++n) gv[bj][n] = *(const f32x4*)(f0 + (size_t)mb * 9216 + col0 + bj * 128 + n * 16) * coef;
#pragma unroll
      for (int ai = 0; ai < 2; ++ai)
#pragma unroll
        for (int m = 0; m < 4; ++m) {
          float* rowp = X + (size_t)(rowbase + ai * 128 + wr * 64 + m * 16 + fr) * DM + col0;
#pragma unroll
          for (int bj = 0; bj < 2; ++bj)
#pragma unroll
            for (int n = 0; n < 2; ++n) { float* q = rowp + bj * 128 + n * 16; const f32x4 x = *(const f32x4*)q; *(f32x4*)q = x * ALPHA + gv[bj][n] * acc[ai][bj][m][n]; }
        }
    } else if (mode == EPI_DA) {
      if (u.pn < 8) {
        bf16_t* base = (bf16_t*)(u.pn < 4 ? p0 : p1); const float sc = u.pn < 4 ? 0.125f * LOG2E : 1.0f; const int tcol = (u.pn & 3) * 256 + wc * 64;
        const bool lat = u.pm < 64; const f32x2* rope = (const f32x2*)f0;
#pragma unroll
        for (int ai = 0; ai < 2; ++ai)
#pragma unroll
          for (int m = 0; m < 4; ++m) {
            const int row = rowbase + ai * 128 + wr * 64 + m * 16 + fr, t = row & 2047;
#pragma unroll
            for (int n = 0; n < 2; ++n) {
              const int dd = 16 * n + 4 * fq; const f32x4 x1 = acc[ai][0][m][n], x2 = acc[ai][1][m][n]; f32x4 o1, o2;
              if (lat) {
#pragma unroll
                for (int j = 0; j < 4; ++j) { const f32x2 cs = rope[t * 32 + dd + j]; o1[j] = (x1[j] * cs.x - x2[j] * cs.y) * sc; o2[j] = (x1[j] * cs.y + x2[j] * cs.x) * sc; }
              } else { o1 = x1 * sc; o2 = x2 * sc; }
              bf16_t* q = base + (size_t)row * 1024 + tcol + dd; st_bf4(q, o1); st_bf4(q + 32, o2);
            }
          }
      } else store_t((bf16_t*)p2, (u.pn - 8) * 256, acc, rowbase, wr, wc, fr, fq);
    } else if (mode == EPI_HY) {
      store_t((bf16_t*)p0, u.pn * 256, acc, rowbase, wr, wc, fr, fq);
    } else if (mode == EPI_RT) {
      if (u.pn < 8) {
        bf16_t* base = (bf16_t*)(u.pn < 4 ? p0 : p1); const float sc = u.pn < 4 ? 1.0f : 0.0625f; const int tcol = (u.pn & 3) * 256 + wc * 32;
        const bool lat = u.pm < 64; const f32x2* rope = (const f32x2*)f0;
#pragma unroll
        for (int ai = 0; ai < 2; ++ai)
#pragma unroll
          for (int m = 0; m < 4; ++m) {
            const int row = rowbase + ai * 128 + wr * 64 + m * 16 + fr, t = row & 2047;
#pragma unroll
            for (int n = 0; n < 2; ++n) {
              const int dd = wc * 32 + 16 * n + 4 * fq; const f32x4 x1 = acc[ai][0][m][n], x2 = acc[ai][1][m][n]; f32x4 o1, o2;
              if (lat) {
#pragma unroll
                for (int j = 0; j < 4; ++j) { const f32x2 cs = rope[t * 128 + dd + j]; o1[j] = (x1[j] * cs.x - x2[j] * cs.y) * sc; o2[j] = (x1[j] * cs.y + x2[j] * cs.x) * sc; }
              } else { o1 = x1 * sc; o2 = x2 * sc; }
              bf16_t* q = base + (size_t)row * 1024 + (u.pn & 3) * 256 + 16 * n + 4 * fq + wc * 32; st_bf4(q, o1); st_bf4(q + 128, o2);
            }
          }
        (void)tcol;
      } else if (u.pn < 16) store_t((bf16_t*)p2, (u.pn - 8) * 256, acc, rowbase, wr, wc, fr, fq);
      else {
        bf16_t* G = (bf16_t*)p3;
#pragma unroll
        for (int ai = 0; ai < 2; ++ai)
#pragma unroll
          for (int m = 0; m < 4; ++m) {
            bf16_t* rowp = G + (size_t)(rowbase + ai * 128 + wr * 64 + m * 16 + fr) * 2048 + (u.pn - 16) * 256 + wc * 32 + 4 * fq;
#pragma unroll
            for (int bj = 0; bj < 2; ++bj)
#pragma unroll
              for (int n = 0; n < 2; ++n) { const f32x4 a = acc[ai][bj][m][n]; f32x4 v;
#pragma unroll
                for (int j = 0; j < 4; ++j) v[j] = silu_f(a[j]);
                st_bf4(rowp + bj * 128 + n * 16, v); }
          }
      }
    } else {
      if (u.pn < 4) {
        bf16_t* BG = (bf16_t*)p0;
#pragma unroll
        for (int ai = 0; ai < 2; ++ai)
#pragma unroll
          for (int m = 0; m < 4; ++m) {
            bf16_t* rowp = BG + (size_t)(rowbase + ai * 128 + wr * 64 + m * 16 + fr) * 1024 + u.pn * 256 + wc * 32 + 4 * fq;
#pragma unroll
            for (int bj = 0; bj < 2; ++bj)
#pragma unroll
              for (int n = 0; n < 2; ++n) st_bf4(rowp + bj * 128 + n * 16, acc[ai][bj][m][n]);
          }
      } else {
        bf16_t* CU = (bf16_t*)p1;
#pragma unroll
        for (int ai = 0; ai < 2; ++ai)
#pragma unroll
          for (int m = 0; m < 4; ++m) {
            bf16_t* rowp = CU + (size_t)(rowbase + ai * 128 + wr * 64 + m * 16 + fr) * 1024 + (u.pn - 4) * 128 + wc * 32 + 4 * fq;
#pragma unroll
            for (int n = 0; n < 2; ++n) st_bf4(rowp + n * 16, acc[ai][0][m][n] * acc[ai][1][m][n]);
          }
      }
    }
  }
};

DI int map_col(int kind, int rho) {
  if (kind == 1) { const int t = rho >> 8, r = rho & 255; return r < 128 ? 128 * t + r : DFF + 128 * t + (r - 128); }
  if (kind == 2) { if (rho >= 2048) return rho; const int base = rho & ~255, r = rho & 255; const int bj = r >> 7, hm = (r & 127) >> 5, dd = r & 31; return base + hm * 64 + bj * 32 + dd; }
  if (kind == 3) { if (rho < 1024) return rho; const int t = (rho - 1024) >> 8, r = (rho - 1024) & 255; return r < 128 ? 1024 + 128 * t + r : 2048 + 128 * t + (r - 128); }
  return rho;
}

DI void conv_unit(const Params& p, int zz, int tx, LAS unsigned char* lds, int u) {
  int j = 0;
#pragma unroll 1
  for (int k = 1; k < 24; ++k) if (u >= p.jobs[k + zz].ustart) j = k;
  const WJob jb = p.jobs[j + zz];
  const int lu = u - jb.ustart, nkb = jb.K >> 7, rb = lu / nkb, kb = lu - rb * nkb;
  const int rho0 = rb * 32, k0 = kb * 128, scol0 = map_col(jb.kind, rho0);
  LAS bf16_t* T = (LAS bf16_t*)lds;
  const int tid = tx;
  { const int kk = tid >> 3, c4 = (tid & 7) * 4;
#pragma unroll
    for (int i = 0; i < 2; ++i) {
      const f32x4 v = *(const f32x4*)(jb.src + (size_t)(k0 + kk + 64 * i) * jb.srcN + scol0 + c4);
#pragma unroll
      for (int e = 0; e < 4; ++e) T[(c4 + e) * 136 + kk + 64 * i] = f2bf(v[e]);
    } }
  __syncthreads();
  { const int r = tid >> 4, kc = (tid & 15) * 8;
    const u32x4 v = *(const LAS u32x4*)(T + r * 136 + kc);
    *(u32x4*)(jb.dst + (size_t)(rho0 + r) * jb.K + k0 + kc) = v; }
  __syncthreads();
}

DI void mods_prepare(const Params& p, int zz, int tx, LAS unsigned char* lds) {
  LAS float* sc = (LAS float*)lds;
  for (int idx = tx; idx < 9216; idx += NTHR) { const int r = idx >> 10, k = idx & 1023; const float v = r < 8 ? p.in[zz + 1][r * 1024 + k] : p.in[zz + 3][k]; sc[idx] = v / (1.0f + __expf(-v)); }
  __syncthreads();
}
DI void mods_unit(const Params& p, int zz, int tx, LAS unsigned char* lds, int u) {
  LAS float* sc = (LAS float*)lds; LAS float* part = (LAS float*)(lds + 36864);
  const int l = u / 144, cb = u - l * 144, wid = tx >> 6, lane = tx & 63, col = cb * 64 + lane;
  const float* W = p.in[zz + 4] + (size_t)l * 1024 * 9216 + col;
  float acc[9];
#pragma unroll
  for (int r = 0; r < 9; ++r) acc[r] = 0.f;
#pragma unroll 8
  for (int k = wid * 128; k < wid * 128 + 128; ++k) {
    const float w = W[(size_t)k * 9216];
#pragma unroll
    for (int r = 0; r < 9; ++r) acc[r] += sc[r * 1024 + k] * w;
  }
#pragma unroll
  for (int r = 0; r < 9; ++r) part[(wid * 9 + r) * 64 + lane] = acc[r];
  __syncthreads();
  float* mods = (float*)((p.ws + zz) + WS_MODS);
  for (int idx = tx; idx < 576; idx += NTHR) {
    const int r = idx >> 6, ln = idx & 63; float s = p.in[zz + 5][l * 9216 + cb * 64 + ln];
#pragma unroll
    for (int w = 0; w < 8; ++w) s += part[(w * 9 + r) * 64 + ln];
    mods[(size_t)(l * 9 + r) * 9216 + cb * 64 + ln] = s;
  }
  __syncthreads();
}

DI void filter_unit(const Params& p, int zz, int tx, LAS unsigned char* lds, int u) {
  const bool lat = u < 256; const int n = lat ? 2048 : 256, p0 = lat ? u * 8 : (u - 256) * 8, tid = tx;
  LAS float* z = (LAS float*)lds;
  LAS float* h1 = z + 8 * 33;
  LAS float* h2 = h1 + 8 * 64;
  const float* w1 = p.in[zz + 19]; const float* b1 = p.in[zz + 20]; const float* f1 = p.in[zz + 21]; const float* w2 = p.in[zz + 22]; const float* b2 = p.in[zz + 23]; const float* f2 = p.in[zz + 24];
  const float* w3 = p.in[zz + 25]; const float* dsk = p.in[zz + 26];
  if (tid < 8 * 33) { const int pos = tid / 33, f = tid - pos * 33; const int pp = p0 + pos; const float t = (float)pp / (float)(n - 1), w = 6.283185307179586f * (float)pp / (float)n;
    float v; if (f == 0) v = t; else { const int k = (f - 1) & 15; const float fr = 1e-4f + (float)k * ((15.0f - 1e-4f) / 15.0f); v = f <= 16 ? __cosf(fr * w) : -__sinf(fr * w); }
    z[tid] = v; }
  __syncthreads();
  { const int pos = tid >> 6, o = tid & 63; float s = b1[o];
#pragma unroll 3
    for (int f = 0; f < 33; ++f) s += z[pos * 33 + f] * w1[f * 64 + o];
    h1[tid] = __sinf(f1[o] * s); }
  __syncthreads();
  { const int pos = tid >> 6, o = tid & 63; float s = b2[o];
#pragma unroll 4
    for (int k = 0; k < 64; ++k) s += h1[pos * 64 + k] * w2[k * 64 + o];
    h2[tid] = __sinf(f2[o] * s); }
  __syncthreads();
  { const int cc = tid * 4; f32x4 a[8];
#pragma unroll
    for (int q = 0; q < 8; ++q) a[q] = (f32x4){0.f, 0.f, 0.f, 0.f};
#pragma unroll 4
    for (int k = 0; k < 64; ++k) { const f32x4 w = *(const f32x4*)(w3 + (size_t)k * 2048 + cc);
#pragma unroll
      for (int q = 0; q < 8; ++q) a[q] += w * h2[q * 64 + k]; }
    const bool bwd = cc >= 1024; const int c0 = cc & 1023;
    const float mind = -3.0701134573253944f, maxd = -15.350567286626972f;
    bf16_t* R = (bf16_t*)((p.ws + zz) + (lat ? WS_HYRL : WS_HYRC)); const int rs = lat ? RL_STRIDE : RC_STRIDE;
#pragma unroll
    for (int q = 0; q < 8; ++q) { const int pp = p0 + q; const float t = (float)pp / (float)(n - 1);
#pragma unroll
      for (int e = 0; e < 4; ++e) { const int c = c0 + e; const float dl = fabsf(mind + (maxd - mind) * ((float)c / 1023.0f));
        float v = a[q][e] * __expf(-t * dl);
        if (!bwd) { if (pp == 0) v += dsk[c]; R[(size_t)c * rs + (n - pp)] = f2bf(v); }
        else if (pp > 0) R[(size_t)c * rs + (n + pp)] = f2bf(v); } }
    if (p0 == 0) { for (int idx = tid; idx < 1024 * 9; idx += NTHR) { const int c = idx / 9, e = idx - c * 9; R[(size_t)c * rs + (e == 0 ? 0 : 2 * n + e - 1)] = 0; } }
  }
  __syncthreads();
}

DI void rope_tables(const Params& p, int zz, int tx) {
  f32x2* rd = (f32x2*)((p.ws + zz) + WS_ROPE_DA); f32x2* rr = (f32x2*)((p.ws + zz) + WS_ROPE_RT);
  const int gsz = gridDim.x * NTHR, gid = blockIdx.x * NTHR + tx;
  for (int idx = gid; idx < 2048 * 32; idx += gsz) { const int t = idx >> 5, d = idx & 31; const int k = d & 15; const float inv = exp2f(-(float)k / 16.0f * 13.287712379549449f);
    const float ang = (float)(d < 16 ? (t >> 6) : (t & 63)) * inv; rd[idx] = (f32x2){__cosf(ang), __sinf(ang)}; }
  for (int idx = gid; idx < 2048 * 128; idx += gsz) { const int t = idx >> 7, d = idx & 127; const int k = d & 63; const float inv = exp2f(-(float)k / 64.0f * 13.287712379549449f);
    const float ang = (float)(d < 64 ? (t >> 6) : (t & 63)) * inv; rr[idx] = (f32x2){__cosf(ang), __sinf(ang)}; }
}

DI void init_phase(const Params& p, int zz, int tx) {
  float* X = (float*)((p.ws + zz) + WS_X); bf16_t* H = (bf16_t*)((p.ws + zz) + WS_H); const float* mods = (const float*)((p.ws + zz) + WS_MODS);
  const int wid = tx >> 6, lane = tx & 63;
  for (int row = blockIdx.x * 8 + wid; row < MT; row += gridDim.x * 8) {
    const float* src = row < ML ? p.in[zz + 0] + (size_t)row * DM : p.in[zz + 2] + (size_t)(row - ML) * DM; const int mb = row < ML ? row >> 11 : 8;
#pragma unroll
    for (int k = 0; k < 4; ++k) { const int col = k * 256 + lane * 4; const f32x4 v = *(const f32x4*)(src + col);
      *(f32x4*)(X + (size_t)row * DM + col) = v;
      const f32x4 sh = *(const f32x4*)(mods + (size_t)mb * 9216 + col), sc = *(const f32x4*)(mods + (size_t)mb * 9216 + 1024 + col);
      st_bf4(H + (size_t)row * DM + col, v * (sc + 1.0f) + sh); }
  }
}

DI void ln_phase(const Params& p, int zz, int tx, int M, const float* g, const float* bta, const float* shift, const float* scale, bool final) {
  float* X = (float*)((p.ws + zz) + WS_X); bf16_t* H = (bf16_t*)((p.ws + zz) + WS_H);
  const int wid = tx >> 6, lane = tx & 63;
  for (int row = blockIdx.x * 8 + wid; row < M; row += gridDim.x * 8) {
    float* xr = X + (size_t)row * DM; f32x4 v[4]; float s = 0.f;
#pragma unroll
    for (int k = 0; k < 4; ++k) { v[k] = *(const f32x4*)(xr + k * 256 + lane * 4); s += (v[k][0] + v[k][1]) + (v[k][2] + v[k][3]); }
    const float mean = wave_sum(s) * (1.0f / 1024.0f); float q = 0.f;
#pragma unroll
    for (int k = 0; k < 4; ++k) { const f32x4 d = v[k] - mean; q += (d[0] * d[0] + d[1] * d[1]) + (d[2] * d[2] + d[3] * d[3]); }
    const float rstd = rsqrtf(wave_sum(q) * (1.0f / 1024.0f) + LN_EPS); const int mb = row < ML ? row >> 11 : 8;
#pragma unroll
    for (int k = 0; k < 4; ++k) { const int col = k * 256 + lane * 4;
      const f32x4 y = (v[k] - mean) * rstd * *(const f32x4*)(g + col) + *(const f32x4*)(bta + col);
      if (final) { *(f32x4*)((p.out + zz) + (size_t)row * DM + col) = y; }
      else { *(f32x4*)(xr + col) = y; const f32x4 sh = *(const f32x4*)(shift + (size_t)mb * 9216 + col), sc = *(const f32x4*)(scale + (size_t)mb * 9216 + col);
        st_bf4(H + (size_t)row * DM + col, y * (sc + 1.0f) + sh); } }
  }
}

DI void sc_core_phase(const Params& p, int zz, int tx) {
  const bf16_t* BG = (const bf16_t*)((p.ws + zz) + WS_BIG); const bf16_t* CU = (const bf16_t*)((p.ws + zz) + WS_BIG + SZ_TOK1K); bf16_t* H = (bf16_t*)((p.ws + zz) + WS_H); const float* cw = p.in[zz + 33];
  for (int idx = blockIdx.x * NTHR + tx; idx < ML * 128; idx += gridDim.x * NTHR) {
    const int row = idx >> 7, c8 = (idx & 127) * 8, t = row & 2047; const size_t o = (size_t)row * 1024 + c8;
    const f32x4 z4 = (f32x4){0.f, 0.f, 0.f, 0.f};
#pragma unroll
    for (int hf = 0; hf < 2; ++hf) { const size_t oo = o + hf * 4; const int c = c8 + hf * 4;
      const f32x4 c0 = ld_bf4(CU + oo), cm = t > 0 ? ld_bf4(CU + oo - 1024) : z4, cp = t < 2047 ? ld_bf4(CU + oo + 1024) : z4, bg = ld_bf4(BG + oo);
      const f32x4 w0 = *(const f32x4*)(cw + c), w1 = *(const f32x4*)(cw + 1024 + c), w2 = *(const f32x4*)(cw + 2048 + c);
      st_bf4(H + oo, bg * (w0 * cm + w1 * c0 + w2 * cp)); }
  }
}

DI void hy_transpose_phase(const Params& p, int zz, int tx, LAS unsigned char* lds) {
  const bf16_t* ZT = (const bf16_t*)((p.ws + zz) + WS_BIG + 3 * SZ_TOK1K); bf16_t* H = (bf16_t*)((p.ws + zz) + WS_H); LAS bf16_t* T = (LAS bf16_t*)lds;
  const int tid = tx;
  for (int u = blockIdx.x; u < 16 * 288; u += gridDim.x) {
    const int ct = u & 15, tt = u >> 4, c0 = ct * 64, tok0 = tt * 64;
    { const int r = tid >> 3, ch = tid & 7; *(LAS u32x4*)(T + r * 72 + ch * 8) = *(const u32x4*)(ZT + (size_t)(c0 + r) * MT + tok0 + ch * 8); }
    __syncthreads();
    { const int tok = tid >> 3, cc = (tid & 7) * 8; unsigned w[4];
#pragma unroll
      for (int k = 0; k < 4; ++k) w[k] = (unsigned)T[(cc + 2 * k) * 72 + tok] | ((unsigned)T[(cc + 2 * k + 1) * 72 + tok] << 16);
      *(u32x4*)(H + (size_t)(tok0 + tok) * 1024 + c0 + cc) = (u32x4){w[0], w[1], w[2], w[3]}; }
    __syncthreads();
  }
}

DI void da_attn_phase(const Params& p, int zz, int tx, LAS unsigned char* lds) {
  const bf16_t* Q = (const bf16_t*)((p.ws + zz) + WS_BIG); const bf16_t* Kb = (const bf16_t*)((p.ws + zz) + WS_BIG + SZ_TOK1K); const bf16_t* VT = (const bf16_t*)((p.ws + zz) + WS_BIG + 2 * SZ_TOK1K);
  bf16_t* AO = (bf16_t*)((p.ws + zz) + WS_H);
  const int tid = tx, wid = tid >> 6, lane = tid & 63, fr = lane & 15, fq = lane >> 4;
  const float* lam = p.in[zz + 14]; const float* subln = p.in[zz + 15];
  const float lam_init = 0.2f;
  const float lam_full = __expf(wave_sum(lam[lane] * lam[64 + lane])) - __expf(wave_sum(lam[128 + lane] * lam[192 + lane])) + lam_init;
  LAS bf16_t* Ks = (LAS bf16_t*)lds;
  LAS bf16_t* Vs = (LAS bf16_t*)(lds + 17408);
  for (int it = blockIdx.x; it < 1024 + 128; it += gridDim.x) {
    const bool isctx = it >= 1024; int b, h, qrow0, nkt;
    if (!isctx) { b = it >> 7; h = (it >> 4) & 7; qrow0 = b * 2048 + (it & 15) * 128; nkt = 36; }
    else { const int j = it - 1024; b = j >> 4; h = (j >> 1) & 7; qrow0 = ML + b * 256 + (j & 1) * 128; nkt = 4; }
    bf16x8 qf[2][2];
    { const bf16_t* qp = Q + (size_t)(qrow0 + wid * 16 + fr) * 1024 + h * 128 + fq * 8;
#pragma unroll
      for (int m = 0; m < 2; ++m)
#pragma unroll
        for (int ks = 0; ks < 2; ++ks) qf[m][ks] = *(const bf16x8*)(qp + m * 64 + ks * 32); }
    f32x4 O[2][8]; float mrun[2] = {-1e30f, -1e30f}, lsum[2] = {0.f, 0.f};
#pragma unroll
    for (int m = 0; m < 2; ++m)
#pragma unroll
      for (int et = 0; et < 8; ++et) O[m][et] = (f32x4){0.f, 0.f, 0.f, 0.f};
    for (int kt = 0; kt < nkt; ++kt) {
      const int tok0 = (isctx || kt < 4) ? ML + b * 256 + kt * 64 : b * 2048 + (kt - 4) * 64;
      __syncthreads();
#pragma unroll
      for (int i = 0; i < 2; ++i) { const int id = tid + NTHR * i;
        { const int r = id >> 4, cc = id & 15; *(LAS u32x4*)(Ks + r * 136 + cc * 8) = *(const u32x4*)(Kb + (size_t)(tok0 + r) * 1024 + h * 128 + cc * 8); }
        { const int r = id >> 3, cc = id & 7; *(LAS u32x4*)(Vs + r * 72 + cc * 8) = *(const u32x4*)(VT + (size_t)(h * 128 + r) * MT + tok0 + cc * 8); } }
      __syncthreads();
      f32x4 s[2][4];
#pragma unroll
      for (int m = 0; m < 2; ++m)
#pragma unroll
        for (int kk = 0; kk < 4; ++kk) { f32x4 a4 = (f32x4){0.f, 0.f, 0.f, 0.f};
#pragma unroll
          for (int ks = 0; ks < 2; ++ks) { const bf16x8 kf = *(const LAS bf16x8*)(Ks + (kk * 16 + fr) * 136 + m * 64 + ks * 32 + fq * 8); a4 = __builtin_amdgcn_mfma_f32_16x16x32_bf16(kf, qf[m][ks], a4, 0, 0, 0); }
          s[m][kk] = a4; }
#pragma unroll
      for (int m = 0; m < 2; ++m) {
        float mx = -1e30f;
#pragma unroll
        for (int kk = 0; kk < 4; ++kk)
#pragma unroll
          for (int j = 0; j < 4; ++j) mx = fmaxf(mx, s[m][kk][j]);
        mx = fmaxf(mx, __shfl_xor(mx, 16)); mx = fmaxf(mx, __shfl_xor(mx, 32));
        const float mnew = fmaxf(mrun[m], mx), corr = fast_exp2(mrun[m] - mnew); mrun[m] = mnew; float ps = 0.f;
#pragma unroll
        for (int kk = 0; kk < 4; ++kk)
#pragma unroll
          for (int j = 0; j < 4; ++j) { const float e = fast_exp2(s[m][kk][j] - mnew); s[m][kk][j] = e; ps += e; }
        lsum[m] = lsum[m] * corr + ps;
#pragma unroll
        for (int et = 0; et < 8; ++et) O[m][et] *= corr;
      }
#pragma unroll
      for (int s2 = 0; s2 < 2; ++s2) {
        bf16x8 pf[2];
#pragma unroll
        for (int m = 0; m < 2; ++m) { u32x4 w; w.x = pk_bf16(s[m][2 * s2][0], s[m][2 * s2][1]); w.y = pk_bf16(s[m][2 * s2][2], s[m][2 * s2][3]); w.z = pk_bf16(s[m][2 * s2 + 1][0], s[m][2 * s2 + 1][1]); w.w = pk_bf16(s[m][2 * s2 + 1][2], s[m][2 * s2 + 1][3]); pf[m] = __builtin_bit_cast(bf16x8, w); }
#pragma unroll
        for (int et = 0; et < 8; ++et) {
          const u32x2 lo = *(const LAS u32x2*)(Vs + (et * 16 + fr) * 72 + 32 * s2 + 4 * fq), hi = *(const LAS u32x2*)(Vs + (et * 16 + fr) * 72 + 32 * s2 + 16 + 4 * fq);
          const bf16x8 vf = __builtin_bit_cast(bf16x8, (u32x4){lo.x, lo.y, hi.x, hi.y});
          O[0][et] = __builtin_amdgcn_mfma_f32_16x16x32_bf16(vf, pf[0], O[0][et], 0, 0, 0);
          O[1][et] = __builtin_amdgcn_mfma_f32_16x16x32_bf16(vf, pf[1], O[1][et], 0, 0, 0);
        }
      }
    }
    float inv[2];
#pragma unroll
    for (int m = 0; m < 2; ++m) { float l = lsum[m]; l += __shfl_xor(l, 16); l += __shfl_xor(l, 32); inv[m] = 1.0f / l; }
    float ss = 0.f;
#pragma unroll
    for (int et = 0; et < 8; ++et)
#pragma unroll
      for (int j = 0; j < 4; ++j) { const float o = O[0][et][j] * inv[0] - lam_full * (O[1][et][j] * inv[1]); O[0][et][j] = o; ss += o * o; }
    ss += __shfl_xor(ss, 16); ss += __shfl_xor(ss, 32);
    const float rn = rsqrtf(ss * (1.0f / 128.0f) + LN_EPS) * (1.0f - lam_init);
    bf16_t* op = AO + (size_t)(qrow0 + wid * 16 + fr) * 1024 + h * 128 + 4 * fq;
#pragma unroll
    for (int et = 0; et < 8; ++et) { const f32x4 g = *(const f32x4*)(subln + et * 16 + 4 * fq); st_bf4(op + et * 16, O[0][et] * g * rn); }
  }
}

DI void rt_attn_phase(const Params& p, int zz, int tx, LAS unsigned char* lds) {
  const bf16_t* Q = (const bf16_t*)((p.ws + zz) + WS_BIG); const bf16_t* Kb = (const bf16_t*)((p.ws + zz) + WS_BIG + SZ_TOK1K); const bf16_t* VT = (const bf16_t*)((p.ws + zz) + WS_BIG + 2 * SZ_TOK1K);
  bf16_t* G = (bf16_t*)((p.ws + zz) + WS_BIG + 4 * SZ_TOK1K);
  const int tid = tx, wid = tid >> 6, lane = tid & 63, fr = lane & 15, fq = lane >> 4;
  const float* dl = p.in[zz + 29]; const float* gn = p.in[zz + 30];
  LAS bf16_t* Ks = (LAS bf16_t*)lds;
  LAS bf16_t* Vs = (LAS bf16_t*)(lds + 16896);
  for (int it = blockIdx.x; it < 512; it += gridDim.x) {
    const int b = it >> 6, h = (it >> 4) & 3, qb = it & 15, qrow0 = b * 2048 + qb * 128;
    const float lgf = log2f(1.0f / (1.0f + expf(-dl[h]))), lgb = log2f(1.0f / (1.0f + expf(-dl[4 + h])));
    const int tq = qb * 128 + wid * 16 + fr;
    bf16x8 qf[8];
    { const bf16_t* qp = Q + (size_t)(qrow0 + wid * 16 + fr) * 1024 + h * 256 + fq * 8;
#pragma unroll
      for (int ks = 0; ks < 8; ++ks) qf[ks] = *(const bf16x8*)(qp + ks * 32); }
    f32x4 O[32];
#pragma unroll
    for (int et = 0; et < 32; ++et) O[et] = (f32x4){0.f, 0.f, 0.f, 0.f};
    for (int kt = 0; kt < 72; ++kt) {
      const bool kctx = kt < 8; const int spos = kctx ? kt * 32 : (kt - 8) * 32; const int tok0 = kctx ? ML + b * 256 + spos : b * 2048 + spos;
      __syncthreads();
#pragma unroll
      for (int i = 0; i < 2; ++i) { const int id = tid + NTHR * i, r = id >> 5, cc = id & 31; *(LAS u32x4*)(Ks + r * 264 + cc * 8) = *(const u32x4*)(Kb + (size_t)(tok0 + r) * 1024 + h * 256 + cc * 8); }
#pragma unroll
      for (int i = 0; i < 4; ++i) { const int id = tid + NTHR * i, r = id >> 2, cc = id & 3; *(LAS u32x4*)(Vs + r * 40 + cc * 8) = *(const u32x4*)(VT + (size_t)(h * 512 + r) * MT + tok0 + cc * 8); }
      __syncthreads();
      f32x4 s[2];
#pragma unroll
      for (int kk = 0; kk < 2; ++kk) { f32x4 a4 = (f32x4){0.f, 0.f, 0.f, 0.f};
#pragma unroll
        for (int ks = 0; ks < 8; ++ks) { const bf16x8 kf = *(const LAS bf16x8*)(Ks + (kk * 16 + fr) * 264 + ks * 32 + fq * 8); a4 = __builtin_amdgcn_mfma_f32_16x16x32_bf16(kf, qf[ks], a4, 0, 0, 0); }
        s[kk] = a4; }
#pragma unroll
      for (int kk = 0; kk < 2; ++kk)
#pragma unroll
        for (int j = 0; j < 4; ++j) { const int si = spos + kk * 16 + 4 * fq + j; float D;
          if (kctx) D = fast_exp2((float)(256 + tq - si) * lgf) + fast_exp2((float)(2048 + si - tq) * lgb);
          else { const int d = tq - si; D = d > 0 ? fast_exp2((float)d * lgf) : (d < 0 ? fast_exp2((float)(-d) * lgb) : 2.0f); }
          s[kk][j] *= D; }
      u32x4 w; w.x = pk_bf16(s[0][0], s[0][1]); w.y = pk_bf16(s[0][2], s[0][3]); w.z = pk_bf16(s[1][0], s[1][1]); w.w = pk_bf16(s[1][2], s[1][3]);
      const bf16x8 pf = __builtin_bit_cast(bf16x8, w);
#pragma unroll
      for (int et = 0; et < 32; ++et) {
        const u32x2 lo = *(const LAS u32x2*)(Vs + (et * 16 + fr) * 40 + 4 * fq), hi = *(const LAS u32x2*)(Vs + (et * 16 + fr) * 40 + 16 + 4 * fq);
        const bf16x8 vf = __builtin_bit_cast(bf16x8, (u32x4){lo.x, lo.y, hi.x, hi.y});
        O[et] = __builtin_amdgcn_mfma_f32_16x16x32_bf16(vf, pf, O[et], 0, 0, 0);
      }
    }
    float sm = 0.f;
#pragma unroll
    for (int et = 0; et < 32; ++et) sm += (O[et][0] + O[et][1]) + (O[et][2] + O[et][3]);
    sm += __shfl_xor(sm, 16); sm += __shfl_xor(sm, 32);
    const float mean = sm * (1.0f / 512.0f); float q = 0.f;
#pragma unroll
    for (int et = 0; et < 32; ++et) { const f32x4 d = O[et] - mean; q += (d[0] * d[0] + d[1] * d[1]) + (d[2] * d[2] + d[3] * d[3]); }
    q += __shfl_xor(q, 16); q += __shfl_xor(q, 32);
    const float rstd = rsqrtf(q * (1.0f / 512.0f) + LN_EPS);
    bf16_t* gp = G + (size_t)(qrow0 + wid * 16 + fr) * 2048 + h * 512 + 4 * fq;
#pragma unroll
    for (int et = 0; et < 32; ++et) { const f32x4 gg = ld_bf4(gp + et * 16); const f32x4 gw = *(const f32x4*)(gn + h * 512 + et * 16 + 4 * fq); st_bf4(gp + et * 16, (O[et] - mean) * rstd * gw * gg); }
  }
}

template <int SEQ>
DI void hy_conv_channel(const Params& p, int zz, int tx, LAS unsigned char* lds, int c, int tokbase, const bf16_t* Rrow) {
  constexpr int WROW = SEQ + 448, NB = SEQ / 32, NG = SEQ / 128, CAW = 2 * SEQ;
  const bf16_t* UT = (const bf16_t*)((p.ws + zz) + WS_BIG); bf16_t* ZT = (bf16_t*)((p.ws + zz) + WS_BIG + 3 * SZ_TOK1K);
  LAS bf16_t* CA = (LAS bf16_t*)lds;
  LAS bf16_t* WT = (LAS bf16_t*)(lds + 65536);
  LAS bf16_t* X0 = (LAS bf16_t*)(lds + 65536 + 39936);
  const int tid = tx, wid = tid >> 6, lane = tid & 63;
  __syncthreads();
  for (int idx = tid; idx < 8 * CAW; idx += NTHR) { const int a = idx / CAW, z = idx - a * CAW; CA[idx] = Rrow[z + a]; }
  for (int idx = tid; idx < 8 * 448; idx += NTHR) { const int b = idx / 448, e = idx - b * 448; WT[b * WROW + (e < 224 ? e : SEQ + e)] = 0; }
  const float* cw = p.in[zz + 17]; const float* cb = p.in[zz + 18];
  float w0[3], w1[3], w2[3], bs[3];
#pragma unroll
  for (int pt = 0; pt < 3; ++pt) { const int cc = pt * 1024 + c; w0[pt] = cw[cc]; w1[pt] = cw[3072 + cc]; w2[pt] = cw[6144 + cc]; bs[pt] = cb[cc]; }
  for (int idx = tid; idx < SEQ; idx += NTHR) {
    const int b = idx / (SEQ / 8), ch = idx - b * (SEQ / 8), t0 = ch * 8; const size_t tok = (size_t)tokbase + (size_t)b * SEQ + t0;
    float r[3][8];
#pragma unroll
    for (int pt = 0; pt < 3; ++pt) { const bf16_t* src = UT + (size_t)(pt * 1024 + c) * MT + tok; const u32x4 v = *(const u32x4*)src;
      float in[10]; in[0] = t0 > 0 ? bf2f(src[-1]) : 0.f; in[9] = t0 + 8 < SEQ ? bf2f(src[8]) : 0.f;
      in[1] = __uint_as_float(v.x << 16); in[2] = __uint_as_float(v.x & 0xffff0000u); in[3] = __uint_as_float(v.y << 16); in[4] = __uint_as_float(v.y & 0xffff0000u);
      in[5] = __uint_as_float(v.z << 16); in[6] = __uint_as_float(v.z & 0xffff0000u); in[7] = __uint_as_float(v.w << 16); in[8] = __uint_as_float(v.w & 0xffff0000u);
#pragma unroll
      for (int k = 0; k < 8; ++k) r[pt][k] = w0[pt] * in[k] + w1[pt] * in[k + 1] + w2[pt] * in[k + 2] + bs[pt]; }
    u32x4 wv, xv;
    wv.x = pk_bf16(r[1][0] * r[2][0], r[1][1] * r[2][1]); wv.y = pk_bf16(r[1][2] * r[2][2], r[1][3] * r[2][3]); wv.z = pk_bf16(r[1][4] * r[2][4], r[1][5] * r[2][5]); wv.w = pk_bf16(r[1][6] * r[2][6], r[1][7] * r[2][7]);
    xv.x = pk_bf16(r[0][0], r[0][1]); xv.y = pk_bf16(r[0][2], r[0][3]); xv.z = pk_bf16(r[0][4], r[0][5]); xv.w = pk_bf16(r[0][6], r[0][7]);
    *(LAS u32x4*)(WT + b * WROW + 224 + t0) = wv; *(LAS u32x4*)(X0 + b * SEQ + t0) = xv;
  }
  __syncthreads();
  if (2 * wid < NG) {
    const int i = lane & 31, hh = lane >> 5, Iq = i >> 3, bb = i & 7;
    f32x16 acc0, acc1;
#pragma unroll
    for (int r = 0; r < 16; ++r) { acc0[r] = 0.f; acc1[r] = 0.f; }
    for (int d = 8 * wid - (NB - 1); d <= 8 * wid + 7; ++d) {
#pragma unroll
      for (int ks = 0; ks < 2; ++ks) {
        const int x0i = SEQ - (32 * d + i - 16 * ks - 8 * hh), a = x0i & 7;
        const bf16x8 A = *(const LAS bf16x8*)(CA + a * CAW + (x0i - a));
        const int jtok = 224 + (8 * wid + Iq - d) * 32 + 16 * ks + 8 * hh;
        const bf16x8 B0 = *(const LAS bf16x8*)(WT + bb * WROW + jtok), B1 = *(const LAS bf16x8*)(WT + bb * WROW + jtok + 128);
        acc0 = __builtin_amdgcn_mfma_f32_32x32x16_bf16(A, B0, acc0, 0, 0, 0);
        acc1 = __builtin_amdgcn_mfma_f32_32x32x16_bf16(A, B1, acc1, 0, 0, 0);
      }
    }
#pragma unroll
    for (int g = 0; g < 2; ++g)
#pragma unroll
      for (int rg = 0; rg < 4; ++rg) {
        const int t0 = (8 * wid + 4 * g + Iq) * 32 + 8 * rg + 4 * hh;
        const u32x2 xw = *(const LAS u32x2*)(X0 + bb * SEQ + t0);
        const f32x4 xf = (f32x4){__uint_as_float(xw.x << 16), __uint_as_float(xw.x & 0xffff0000u), __uint_as_float(xw.y << 16), __uint_as_float(xw.y & 0xffff0000u)};
        f32x4 y; if (g == 0) y = (f32x4){acc0[4 * rg], acc0[4 * rg + 1], acc0[4 * rg + 2], acc0[4 * rg + 3]}; else y = (f32x4){acc1[4 * rg], acc1[4 * rg + 1], acc1[4 * rg + 2], acc1[4 * rg + 3]};
        st_bf4(ZT + (size_t)c * MT + tokbase + bb * SEQ + t0, y * xf);
      }
  }
}

DI void hy_conv_phase(const Params& p, int zz, int tx, LAS unsigned char* lds) {
  const bf16_t* RL = (const bf16_t*)((p.ws + zz) + WS_HYRL); const bf16_t* RC = (const bf16_t*)((p.ws + zz) + WS_HYRC);
  for (int c = blockIdx.x; c < 1024; c += gridDim.x) {
    hy_conv_channel<2048>(p, zz, tx, lds, c, 0, RL + (size_t)c * RL_STRIDE);
    hy_conv_channel<256>(p, zz, tx, lds, c, ML, RC + (size_t)c * RC_STRIDE);
  }
}


#define XB_TMO      128
#define XB_XCNT(j)  (256  + 64 * (j))
#define XB_XSUB(j)  (1280 + 64 * (j))
#define XB_XGEN(j)  (2304 + 64 * (j))
#define XB_TOP      3328
#define XB_TOPGEN   3392
#define XCD_BAR_WORDS 3456
#define XB_SPIN_CAP (1u << 18)
DI unsigned xb_ld(unsigned* p)              { return __hip_atomic_load(p, __ATOMIC_RELAXED, __HIP_MEMORY_SCOPE_AGENT); }
DI unsigned xb_add(unsigned* p, unsigned v) { return __hip_atomic_fetch_add(p, v, __ATOMIC_RELAXED, __HIP_MEMORY_SCOPE_AGENT); }
DI unsigned xb_xcc_id() { return (unsigned)__builtin_amdgcn_s_getreg((3 << 11) | 20) & 0xFu; }
#define XB_SPIN(cond, bar) do { unsigned _sp = 0; while (cond) { __builtin_amdgcn_s_sleep(1); \
    if ((++_sp & 255u) == 0u) { if (xb_ld(&(bar)[XB_TMO])) break; if (_sp > XB_SPIN_CAP) { atomicAdd(&(bar)[XB_TMO], 1u); break; } } } } while (0)
struct XcdBarrier { unsigned* bar; unsigned x; volatile LAS unsigned* st; };
DI XcdBarrier xcd_barrier_post(unsigned* bar, volatile LAS unsigned* st) {
  XcdBarrier b; b.bar = bar; b.x = xb_xcc_id(); b.st = st;
  if (threadIdx.x == 0) (void)xb_add(&bar[XB_XCNT(b.x)], 1u);
  return b;
}
DI void xcd_barrier_complete(unsigned* bar, unsigned x, unsigned& nloc, unsigned& nx) {
  const unsigned G = gridDim.x * gridDim.y * gridDim.z;
  unsigned sum, cnt, mine, sp = 0u;
  for (;;) {
    sum = 0u; cnt = 0u; mine = 0u;
#pragma unroll
    for (unsigned j = 0; j < 16; ++j) { const unsigned c = xb_ld(&bar[XB_XCNT(j)]); sum += c; cnt += (c > 0u) ? 1u : 0u; mine = (j == x) ? c : mine; }
    if (sum == G) break;
    __builtin_amdgcn_s_sleep(1);
    if ((++sp & 255u) == 0u) { if (xb_ld(&bar[XB_TMO])) break; if (sp > XB_SPIN_CAP) { atomicAdd(&bar[XB_TMO], 1u); break; } }
  }
  nloc = mine > 0u ? mine : 1u; nx = cnt > 0u ? cnt : 1u;
}
DI void xcd_barrier(const XcdBarrier& b) {
  asm volatile("s_waitcnt vmcnt(0)" ::: "memory");
  __syncthreads();
  if (threadIdx.x == 0) {
    unsigned* bar = b.bar;
    __builtin_amdgcn_s_waitcnt(0);
    unsigned nloc = b.st[0], nx = b.st[1];
    if (nloc == 0u) { xcd_barrier_complete(bar, b.x, nloc, nx); b.st[0] = nloc; b.st[1] = nx; }
    const unsigned old = xb_add(&bar[XB_XSUB(b.x)], 1u);
    const unsigned gen = old / nloc;
    if (old + 1u == (gen + 1u) * nloc) {
      __builtin_amdgcn_fence(__ATOMIC_RELEASE, "agent");
      asm volatile("s_waitcnt vmcnt(0)" ::: "memory");
      const unsigned og = xb_add(&bar[XB_TOP], 1u);
      const unsigned tg = og / nx;
      if (og + 1u == (tg + 1u) * nx) xb_add(&bar[XB_TOPGEN], 1u);
      else XB_SPIN(xb_ld(&bar[XB_TOPGEN]) == tg, bar);
      __builtin_amdgcn_fence(__ATOMIC_ACQUIRE, "agent");
      xb_add(&bar[XB_XGEN(b.x)], 1u);
      asm volatile("s_waitcnt vmcnt(0)" ::: "memory");
    } else {
      XB_SPIN(xb_ld(&bar[XB_XGEN(b.x)]) == gen, bar);
      __builtin_amdgcn_fence(__ATOMIC_ACQUIRE, "agent");
      asm volatile("s_waitcnt vmcnt(0)" ::: "memory");
    }
  }
  __syncthreads();
}

#ifndef PHMASK
#define PHMASK 0xffff
#endif
#define HAS(x) (((PHMASK) >> (x)) & 1)
__global__ void __launch_bounds__(NTHR) fwd_kernel(Params p) {
  extern __shared__ __attribute__((aligned(16))) unsigned char lds_raw[];
  LAS unsigned char* lds = (LAS unsigned char*)lds_raw;
  cg::grid_group grid = cg::this_grid();
  if (threadIdx.x < 4) ((LAS unsigned*)(lds + LDS_BYTES - 16))[threadIdx.x] = 0u;
  __syncthreads();
  const XcdBarrier xb = xcd_barrier_post((unsigned*)(p.ws + WS_BAR), (volatile LAS unsigned*)(lds + LDS_BYTES - 16));
  for (int ph = p.ph_lo; ph < p.ph_hi; ++ph) {
    if (ph > p.ph_lo) { if (ph == p.ph_lo + 1) grid.sync(); else xcd_barrier(xb); }
    int zz = 0; asm volatile("" : "+s"(zz));
    int tx = threadIdx.x; asm volatile("" : "+v"(tx));
    unsigned char* ws = p.ws + zz;
    const float* mods = (const float*)(ws + WS_MODS);
    if (HAS(0) && ph == 0) {
      mods_prepare(p, zz, tx, lds);
      for (int u = blockIdx.x; u < 576; u += gridDim.x) mods_unit(p, zz, tx, lds, u);
      for (int u = blockIdx.x; u < 288; u += gridDim.x) filter_unit(p, zz, tx, lds, u);
      for (int u = blockIdx.x; u < p.nconv_units; u += gridDim.x) conv_unit(p, zz, tx, lds, u);
      rope_tables(p, zz, tx);
      continue;
    }
    if (HAS(1) && ph == 1) { init_phase(p, zz, tx); continue; }
    const int l = (ph - 2) / 11, sub = (ph - 2) % 11;
    const int Mfull = l < 2 ? MT : ML, Mpre = l < 3 ? MT : ML;
    const float* lmods = mods + (size_t)l * 9 * 9216;
    const bf16_t* wl = (const bf16_t*)(ws + (size_t)l * LAYER_W);
    bool is_gemm = false; pg8::Gemm g{nullptr, nullptr, 0, 0, 0}; Epi E{0, 0.f, nullptr, nullptr, nullptr, nullptr, nullptr};
    bf16_t* Hb = (bf16_t*)(ws + WS_H); bf16_t* BIG = (bf16_t*)(ws + WS_BIG); float* X = (float*)(ws + WS_X);
    switch (sub) {
      case 0: is_gemm = true; g = {Hb, wl, Mpre, 2 * DFF, DM}; E.mode = EPI_SWIGLU; E.p0 = BIG; break;
      case 1: is_gemm = true; g = {BIG, wl + (size_t)2 * DFF * DM, Mpre, DM, DFF}; E.mode = EPI_RES; E.p0 = X; E.f0 = lmods + 2 * 1024; E.coef = 0.5f; break;
      case 2: if (HAS(2)) ln_phase(p, zz, tx, Mpre, p.in[zz + 6] + (l * 3 + 0) * 1024, p.in[zz + 7] + (l * 3 + 0) * 1024, lmods + 3 * 1024, lmods + 4 * 1024, false); break;
      case 3: is_gemm = true;
        if (l == 0) { g = {Hb, (const bf16_t*)(ws + W_DA_QKV), Mpre, 3072, DM}; E.mode = EPI_DA; E.p0 = BIG; E.p1 = (unsigned char*)BIG + SZ_TOK1K; E.p2 = (unsigned char*)BIG + 2 * SZ_TOK1K; E.f0 = (const float*)(ws + WS_ROPE_DA); }
        else if (l == 1) { g = {Hb, (const bf16_t*)(ws + W_HY_IN), Mpre, 3072, DM}; E.mode = EPI_HY; E.p0 = BIG; }
        else if (l == 2) { g = {Hb, (const bf16_t*)(ws + W_RT_IN), Mpre, 6144, DM}; E.mode = EPI_RT; E.p0 = BIG; E.p1 = (unsigned char*)BIG + SZ_TOK1K; E.p2 = (unsigned char*)BIG + 2 * SZ_TOK1K; E.p3 = (unsigned char*)BIG + 4 * SZ_TOK1K; E.f0 = (const float*)(ws + WS_ROPE_RT); }
        else { g = {Hb, (const bf16_t*)(ws + W_SC_IN), Mpre, 3072, DM}; E.mode = EPI_SC; E.p0 = BIG; E.p1 = (unsigned char*)BIG + SZ_TOK1K; }
        break;
      case 4:
        if (HAS(4) && l == 0) da_attn_phase(p, zz, tx, lds); else if (HAS(5) && l == 1) hy_conv_phase(p, zz, tx, lds); else if (HAS(6) && l == 2) rt_attn_phase(p, zz, tx, lds); else if (HAS(7) && l == 3) sc_core_phase(p, zz, tx);
        break;
      case 5: if (HAS(8) && l == 1) hy_transpose_phase(p, zz, tx, lds); break;
      case 6: is_gemm = true; E.mode = EPI_RES; E.p0 = X; E.f0 = lmods + 5 * 1024; E.coef = 1.0f;
        if (l == 0) g = {Hb, (const bf16_t*)(ws + W_DA_O), Mfull, DM, DM};
        else if (l == 1) g = {Hb, (const bf16_t*)(ws + W_HY_O), Mfull, DM, DM};
        else if (l == 2) g = {(const bf16_t*)((unsigned char*)BIG + 4 * SZ_TOK1K), (const bf16_t*)(ws + W_RT_O), Mfull, DM, 2048};
        else g = {Hb, (const bf16_t*)(ws + W_SC_O), Mfull, DM, DM};
        break;
      case 7: if (HAS(2)) ln_phase(p, zz, tx, Mfull, p.in[zz + 6] + (l * 3 + 1) * 1024, p.in[zz + 7] + (l * 3 + 1) * 1024, lmods + 6 * 1024, lmods + 7 * 1024, false); break;
      case 8: is_gemm = true; g = {Hb, wl + (size_t)(2 * DFF * DM + DM * DFF), Mfull, 2 * DFF, DM}; E.mode = EPI_SWIGLU; E.p0 = BIG; break;
      case 9: is_gemm = true; g = {BIG, wl + (size_t)(2 * DFF * DM + DM * DFF + 2 * DFF * DM), Mfull, DM, DFF}; E.mode = EPI_RES; E.p0 = X; E.f0 = lmods + 8 * 1024; E.coef = 0.5f; break;
      default:
        if (HAS(2)) ln_phase(p, zz, tx, Mfull, p.in[zz + 6] + (l * 3 + 2) * 1024, p.in[zz + 7] + (l * 3 + 2) * 1024, lmods + 9 * 9216, lmods + 9 * 9216 + 1024, l == 3); break;
    }
    if (HAS(3) && is_gemm) { pg8::StaticOrder S; S.init(g.M, g.N, (int)gridDim.x, (int)blockIdx.x); pg8::gemm_phase<Epi>(tx, lds, g, S, E); }
  }
}

extern "C" void kernel_launch(void* const* d_in, const int* in_sizes, int n_in, void* d_out, int out_size, void* d_ws, size_t ws_size, hipStream_t stream) {
  static int grid = 0;
  if (grid == 0) {
    if (n_in != 35 || ws_size < WS_END) { fprintf(stderr, "kernel_launch: need 35 inputs and %zu bytes of workspace; got %d, %zu\n", (size_t)WS_END, n_in, ws_size); grid = -1; return; }
    int dev = 0, cus = 0, per_cu = 0;
    hipGetDevice(&dev); hipDeviceGetAttribute(&cus, hipDeviceAttributeMultiprocessorCount, dev);
    if (hipFuncSetAttribute((const void*)fwd_kernel, hipFuncAttributeMaxDynamicSharedMemorySize, LDS_BYTES) != hipSuccess) { fprintf(stderr, "kernel_launch: hipFuncSetAttribute failed\n"); grid = -1; return; }
    if (hipOccupancyMaxActiveBlocksPerMultiprocessor(&per_cu, (const void*)fwd_kernel, NTHR, LDS_BYTES) != hipSuccess || per_cu < 1) { fprintf(stderr, "kernel_launch: occupancy query gave %d\n", per_cu); per_cu = 1; }
    (void)hipGetLastError();
    grid = cus * per_cu;
    fprintf(stderr, "kernel_launch: grid %d (%d CUs x %d)\n", grid, cus, per_cu);
  }
  if (grid < 0) return;
  Params p{};
  for (int i = 0; i < 35; ++i) p.in[i] = (const float*)d_in[i];
  p.out = (float*)d_out; p.ws = (unsigned char*)d_ws;
  unsigned char* ws = (unsigned char*)d_ws;
  int nj = 0, ustart = 0;
  auto add = [&](const float* src, size_t dst_off, int K, int N, int kind) { WJob& j = p.jobs[nj++]; j.src = src; j.dst = (bf16_t*)(ws + dst_off); j.K = K; j.N = N; j.srcN = N; j.kind = kind; j.ustart = ustart; j.pad = 0; ustart += (N / 32) * (K / 128); };
  for (int l = 0; l < 4; ++l) {
    const size_t base = (size_t)l * LAYER_W;
    add(p.in[8] + (size_t)l * DM * 2 * DFF, base, DM, 2 * DFF, 1);
    add(p.in[9] + (size_t)l * DFF * DM, base + SZ_WI, DFF, DM, 0);
    add(p.in[10] + (size_t)l * DM * 2 * DFF, base + SZ_WI + SZ_WO, DM, 2 * DFF, 1);
    add(p.in[11] + (size_t)l * DFF * DM, base + 2 * SZ_WI + SZ_WO, DFF, DM, 0);
  }
  add(p.in[12], W_DA_QKV, DM, 3072, 2); add(p.in[13], W_DA_O, DM, DM, 0);
  add(p.in[16], W_HY_IN, DM, 3072, 0);  add(p.in[27], W_HY_O, DM, DM, 0);
  add(p.in[28], W_RT_IN, DM, 6144, 0);  add(p.in[31], W_RT_O, 2048, DM, 0);
  add(p.in[32], W_SC_IN, DM, 3072, 3);  add(p.in[34], W_SC_O, DM, DM, 0);
  p.nconv_units = ustart; p.ph_lo = 0; p.ph_hi = 2 + 4 * 11; p.pad = 0;
  if (hipMemsetAsync(ws + WS_BAR, 0, 16384, stream) != hipSuccess) { fprintf(stderr, "kernel_launch: memset failed\n"); return; }
  void* args[] = {&p};
  hipError_t e = hipLaunchCooperativeKernel((const void*)fwd_kernel, dim3(grid), dim3(NTHR), args, LDS_BYTES, stream);
  if (e != hipSuccess) fprintf(stderr, "kernel_launch: cooperative launch failed: %s (grid %d)\n", hipGetErrorString(e), grid);
}
```

```cpp
#include <hip/hip_runtime.h>
#include <hip/hip_cooperative_groups.h>
#include <cstdio>
namespace cg = cooperative_groups;

#define LAS __attribute__((address_space(3)))
#define DI __device__ __forceinline__
typedef unsigned short bf16_t;
typedef short bf16x8 __attribute__((ext_vector_type(8)));
typedef short s16x4 __attribute__((ext_vector_type(4)));
typedef float f32x4 __attribute__((ext_vector_type(4)));
typedef float f32x2 __attribute__((ext_vector_type(2)));
typedef float f32x16 __attribute__((ext_vector_type(16)));
typedef unsigned u32x4 __attribute__((ext_vector_type(4)));
typedef unsigned u32x2 __attribute__((ext_vector_type(2)));

constexpr int ML = 16384, MC = 2048, MT = 18432, DM = 1024, DFF = 2816;
constexpr int NTHR = 512;
constexpr int LDS_BYTES = 140 * 1024;
constexpr float ALPHA = 1.681792830507429f;
constexpr float LN_EPS = 1e-5f;
constexpr float LOG2E = 1.4426950408889634f;

constexpr size_t al256(size_t x) { return (x + 255) & ~(size_t)255; }
constexpr size_t SZ_WI = (size_t)2 * DFF * DM * 2, SZ_WO = (size_t)DM * DFF * 2;
constexpr size_t LAYER_W = 2 * (SZ_WI + SZ_WO);
constexpr size_t WS_WMIX = 4 * LAYER_W;
constexpr size_t W_DA_QKV = WS_WMIX, W_DA_O = W_DA_QKV + (size_t)3072 * 1024 * 2, W_HY_IN = W_DA_O + (size_t)1024 * 1024 * 2,
                 W_HY_O = W_HY_IN + (size_t)3072 * 1024 * 2, W_RT_IN = W_HY_O + (size_t)1024 * 1024 * 2, W_RT_O = W_RT_IN + (size_t)6144 * 1024 * 2,
                 W_SC_IN = W_RT_O + (size_t)1024 * 2048 * 2, W_SC_O = W_SC_IN + (size_t)3072 * 1024 * 2, W_END = W_SC_O + (size_t)1024 * 1024 * 2;
constexpr size_t WS_MODS = al256(W_END);
constexpr size_t WS_ROPE_DA = al256(WS_MODS + (size_t)4 * 9 * 9216 * 4);
constexpr size_t WS_ROPE_RT = al256(WS_ROPE_DA + (size_t)2048 * 32 * 8);
constexpr int RL_STRIDE = 4104, RC_STRIDE = 520;
constexpr size_t WS_HYRL = al256(WS_ROPE_RT + (size_t)2048 * 128 * 8);
constexpr size_t WS_HYRC = al256(WS_HYRL + (size_t)1024 * RL_STRIDE * 2);
constexpr size_t WS_X = al256(WS_HYRC + (size_t)1024 * RC_STRIDE * 2);
constexpr size_t WS_H = al256(WS_X + (size_t)MT * DM * 4);
constexpr size_t WS_BIG = al256(WS_H + (size_t)MT * DM * 2);
constexpr size_t SZ_TOK1K = (size_t)MT * 1024 * 2;
constexpr size_t BIG_BYTES = 6 * SZ_TOK1K;
constexpr size_t WS_XBUF = al256(WS_BIG + BIG_BYTES);
constexpr size_t WS_BAR = al256(WS_XBUF + (size_t)72 * 256 * 4 * 8);
constexpr size_t WS_CNT = WS_BAR + 16384;
constexpr size_t ZERO_BYTES = 16384 + (size_t)12 * 72 * 256;
constexpr size_t WS_CAT = WS_BAR + ZERO_BYTES;
constexpr size_t WS_END = WS_CAT + 256;

struct WJob { const float* src; bf16_t* dst; int K, N, srcN, kind, ustart, pad; };
struct Params {
  const float* in[35];
  float* out;
  unsigned char* ws;
  WJob jobs[24];
  int nconv_units, ph_lo, ph_hi, pad;
};

DI float bf2f(bf16_t h) { return __uint_as_float(((unsigned)h) << 16); }
typedef __bf16 bf16x2_t __attribute__((ext_vector_type(2)));
DI unsigned pk_bf16(float lo, float hi) { const f32x2 v = {lo, hi}; const bf16x2_t b = __builtin_convertvector(v, bf16x2_t); return __builtin_bit_cast(unsigned, b); }
DI bf16_t f2bf(float f) { return (bf16_t)(pk_bf16(f, 0.f) & 0xffffu); }
DI float fast_exp2(float x) { return __builtin_amdgcn_exp2f(x); }
DI float silu_f(float a) { return a * __builtin_amdgcn_rcpf(1.0f + __expf(-a)); }
DI float wave_sum(float v) {
#pragma unroll
  for (int o = 32; o >= 1; o >>= 1) v += __shfl_xor(v, o);
  return v;
}
DI f32x4 ld_bf4(const bf16_t* p) { u32x2 w = *(const u32x2*)p; return (f32x4){__uint_as_float(w.x << 16), __uint_as_float(w.x & 0xffff0000u), __uint_as_float(w.y << 16), __uint_as_float(w.y & 0xffff0000u)}; }
DI void ld_bf8(const bf16_t* p, f32x4& a, f32x4& b) { const u32x4 w = *(const u32x4*)p;
  a = (f32x4){__uint_as_float(w.x << 16), __uint_as_float(w.x & 0xffff0000u), __uint_as_float(w.y << 16), __uint_as_float(w.y & 0xffff0000u)};
  b = (f32x4){__uint_as_float(w.z << 16), __uint_as_float(w.z & 0xffff0000u), __uint_as_float(w.w << 16), __uint_as_float(w.w & 0xffff0000u)}; }
DI void st_bf8(bf16_t* p, f32x4 a, f32x4 b) { u32x4 w; w.x = pk_bf16(a[0], a[1]); w.y = pk_bf16(a[2], a[3]); w.z = pk_bf16(b[0], b[1]); w.w = pk_bf16(b[2], b[3]); *(u32x4*)p = w; }
DI void st_bf4(bf16_t* p, f32x4 v) { u32x2 w; w.x = pk_bf16(v[0], v[1]); w.y = pk_bf16(v[2], v[3]); *(u32x2*)p = w; }

namespace pg8 {
constexpr int BM = 256, BK = 64, HALF = 128, HTB = HALF * BK * 2, STAGE_BYTES = 8 * HTB, NXCD = 8, WGM = 8;
DI int lds_byte(int r, int c) { const int st = (r >> 4) * 2 + (c >> 5), rr = r & 15, cc = c & 31, ob = rr * 64 + cc * 2; return st * 1024 + (ob ^ (((ob >> 9) & 1) << 5)); }
DI void stage_rc(int b, int& R, int& C) { const int st = b / 1024, sb = b % 1024, swz = sb ^ (((sb >> 9) & 1) << 5); R = (st >> 1) * 16 + swz / 64; C = (st & 1) * 32 + (swz % 64) / 2; }
struct Unit { int pm, pn; };
struct Gemm { const bf16_t* A; const bf16_t* Bt; int M, N, K, ld, msplit, koff; };
struct StaticOrder {
  int nM, nN, nwg, G, c, panel;
  DI void init(int M, int N, int G_, int c_) { nM = M / BM; nN = N / BM; nwg = nM * nN; G = G_; c = c_; panel = -1; }
  DI bool next(int i, Unit& u) const {
    if (panel >= 0) { const int L = panel * G + c; if (i > 0 || L >= nwg) return false; u.pm = L >> 2; u.pn = L & 3; return true; }
    const long L = (long)i * G + c; if (L >= nwg) return false;
    int wgid = (int)L; { const int q = nwg / NXCD, r = nwg % NXCD, xcd = wgid % NXCD, off = wgid / NXCD; wgid = (xcd < r ? xcd * (q + 1) : r * (q + 1) + (xcd - r) * q) + off; }
    const int nig = WGM * nN, gid = wgid / nig, fm = gid * WGM, gsz = (nM - fm) < WGM ? (nM - fm) : WGM;
    u.pm = fm + ((wgid % nig) % gsz); u.pn = (wgid % nig) / gsz; return true;
  }
};

template <class Epi>
DI void gemm_phase(const Params& p, int tx, LAS unsigned char* lds, const Gemm g, const StaticOrder& S, const Epi& E) {
  const int tid = tx, wid = __builtin_amdgcn_readfirstlane(tid >> 6), lane = tid & 63, wr = wid >> 2, wc = wid & 3, fr = lane & 15, fq = lane >> 4;
  const int K = g.K, nt = K / BK;
  unsigned voffA[2];
#pragma unroll
  for (int i = 0; i < 2; ++i) { int R, C; stage_rc(tid * 16 + i * 8192, R, C); voffA[i] = (unsigned)(R * g.ld + C) * 2u; }
  const size_t kstep = (size_t)(BK * 2);
  const size_t hstep = (size_t)HALF * g.ld * 2;
  const size_t tstep = 2 * hstep;
  const unsigned ldsw = (unsigned)wid * 1024u;
  const int aoff = lds_byte(wr * 64 + fr, fq * 8), boff = lds_byte(wc * 32 + fr, fq * 8);
#define PG8_SA(b, h) (((b) * 2 + (h)) * HTB)
#define PG8_SB(b, h) ((4 + (b) * 2 + (h)) * HTB)
#define PG8_STAGE(bufoff, gbase) do { _Pragma("unroll") for (int _i = 0; _i < 2; ++_i) \
    __builtin_amdgcn_global_load_lds((const unsigned*)((const char*)(gbase) + voffA[_i]), (LAS unsigned*)(lds + (bufoff) + ldsw + _i * 8192), 16, 0, 0); } while (0)
#define PG8_LDA(dst, b, h) do { _Pragma("unroll") for (int m = 0; m < 4; ++m) _Pragma("unroll") for (int k = 0; k < 2; ++k) dst[m][k] = *(const LAS bf16x8*)(lds + PG8_SA(b, h) + aoff + m * 2048 + k * 1024); } while (0)
#define PG8_LDB(dst, b, h) do { _Pragma("unroll") for (int n = 0; n < 2; ++n) _Pragma("unroll") for (int k = 0; k < 2; ++k) dst[n][k] = *(const LAS bf16x8*)(lds + PG8_SB(b, h) + boff + n * 2048 + k * 1024); } while (0)
#define PG8_MMA(ai, bj, At, Bt) do { __builtin_amdgcn_s_setprio(1); _Pragma("unroll") for (int m = 0; m < 4; ++m) _Pragma("unroll") for (int n = 0; n < 2; ++n) _Pragma("unroll") for (int k = 0; k < 2; ++k) \
    acc[ai][bj][m][n] = __builtin_amdgcn_mfma_f32_16x16x32_bf16(Bt[n][k], At[m][k], acc[ai][bj][m][n], 0, 0, 0); __builtin_amdgcn_s_setprio(0); } while (0)
#define PG8_WAIT_V(n) asm volatile("s_waitcnt vmcnt(" #n ")" ::: "memory")
#define PG8_WAIT_L(n) asm volatile("s_waitcnt lgkmcnt(" #n ")" ::: "memory")
#define PG8_BAR __builtin_amdgcn_s_barrier()
#define PG8_SCHED __builtin_amdgcn_sched_barrier(0)
  Unit cur, nxt; int ui = 0;
  if (!S.next(0, cur)) return;
  f32x4 acc[2][2][4][2];
#pragma unroll
  for (int a = 0; a < 2; ++a)
#pragma unroll
    for (int b = 0; b < 2; ++b)
#pragma unroll
      for (int m = 0; m < 4; ++m)
#pragma unroll
        for (int n = 0; n < 2; ++n) acc[a][b][m][n] = (f32x4){0.f, 0.f, 0.f, 0.f};
  bf16x8 At[4][2], B0[2][2], B1[2][2];
#define PG8_APTR(u_) ((const char*)g.A + (size_t)((u_).pm % g.msplit) * tstep + (size_t)((u_).pm / g.msplit) * g.koff * 2)
#define PG8_BPTR(u_) ((const char*)g.Bt + (size_t)(u_).pn * tstep + (size_t)((u_).pm / g.msplit) * g.koff * 2)
  const char* cA = PG8_APTR(cur); const char* cB = PG8_BPTR(cur);
  PG8_STAGE(PG8_SB(0, 0), cB); PG8_STAGE(PG8_SA(0, 0), cA); PG8_STAGE(PG8_SB(0, 1), cB + hstep); PG8_STAGE(PG8_SA(0, 1), cA + hstep);
  if (wr == 1) PG8_BAR;
  PG8_WAIT_V(4); PG8_BAR;
  PG8_STAGE(PG8_SB(1, 0), cB + kstep); PG8_STAGE(PG8_SA(1, 0), cA + kstep); PG8_STAGE(PG8_SB(1, 1), cB + hstep + kstep);
  PG8_WAIT_V(6); PG8_BAR;
  for (;;) {
    const bool has_next = S.next(ui + 1, nxt);
    const char* nA = has_next ? PG8_APTR(nxt) : cA; const char* nB = has_next ? PG8_BPTR(nxt) : cB;
    for (int t = 0; t < nt; t += 2) {
      const bool last = (t == nt - 2);
      const char* a1 = cA + (size_t)(t + 1) * kstep;
      const char* a2 = last ? nA : cA + (size_t)(t + 2) * kstep; const char* b2 = last ? nB : cB + (size_t)(t + 2) * kstep;
      const char* a3 = a2 + kstep; const char* b3 = b2 + kstep;
      PG8_LDB(B0, 0, 0); PG8_SCHED; PG8_LDA(At, 0, 0); PG8_STAGE(PG8_SA(1, 1), a1 + hstep);
      PG8_WAIT_L(8); PG8_BAR; PG8_WAIT_L(0); PG8_MMA(0, 0, At, B0); PG8_BAR; PG8_SCHED;
      PG8_LDB(B1, 0, 1); PG8_STAGE(PG8_SB(0, 0), b2);
      PG8_BAR; PG8_WAIT_L(0); PG8_MMA(0, 1, At, B1); PG8_BAR;
      PG8_LDA(At, 0, 1); PG8_STAGE(PG8_SA(0, 0), a2);
      PG8_BAR; PG8_WAIT_L(0); PG8_MMA(1, 0, At, B0); PG8_BAR; PG8_SCHED;
      PG8_STAGE(PG8_SB(0, 1), b2 + hstep);
      PG8_WAIT_V(6); PG8_BAR; PG8_MMA(1, 1, At, B1); PG8_BAR;
      PG8_LDB(B0, 1, 0); PG8_SCHED; PG8_LDA(At, 1, 0); PG8_STAGE(PG8_SA(0, 1), a2 + hstep);
      PG8_WAIT_L(8); PG8_BAR; PG8_WAIT_L(0); PG8_MMA(0, 0, At, B0); PG8_BAR; PG8_SCHED;
      PG8_LDB(B1, 1, 1); PG8_STAGE(PG8_SB(1, 0), b3);
      PG8_BAR; PG8_WAIT_L(0); PG8_MMA(0, 1, At, B1); PG8_BAR;
      PG8_LDA(At, 1, 1); PG8_STAGE(PG8_SA(1, 0), a3);
      PG8_BAR; PG8_WAIT_L(0); PG8_MMA(1, 0, At, B0); PG8_BAR; PG8_SCHED;
      PG8_STAGE(PG8_SB(1, 1), b3 + hstep);
      PG8_WAIT_V(6); PG8_BAR; PG8_MMA(1, 1, At, B1); PG8_BAR;
    }
    E(acc, cur, wr, wc, fr, fq);
    if (!has_next) break;
#pragma unroll
    for (int a = 0; a < 2; ++a)
#pragma unroll
      for (int b = 0; b < 2; ++b)
#pragma unroll
        for (int m = 0; m < 4; ++m)
#pragma unroll
          for (int n = 0; n < 2; ++n) acc[a][b][m][n] = (f32x4){0.f, 0.f, 0.f, 0.f};
    cur = nxt; cA = nA; cB = nB; ++ui;
  }
  PG8_WAIT_V(0);
  if (wr == 0) PG8_BAR;
  PG8_BAR;
#undef PG8_APTR
#undef PG8_BPTR
#undef PG8_SA
#undef PG8_SB
#undef PG8_STAGE
#undef PG8_LDA
#undef PG8_LDB
#undef PG8_MMA
#undef PG8_WAIT_V
#undef PG8_WAIT_L
#undef PG8_BAR
#undef PG8_SCHED
}
}

enum { EPI_SWIGLU = 0, EPI_RES = 1, EPI_DA = 2, EPI_HY = 3, EPI_RT = 4, EPI_SC = 5, EPI_PART = 6 };
struct Epi {
  int mode, l, lnk, fusedln, final, zz; float coef; unsigned char* ws;
  DI const float* gatep() const { return (const float*)(ws + WS_MODS) + (size_t)l * 9 * 9216 + (lnk == 0 ? 2 : (lnk == 1 ? 5 : 8)) * 1024; }
  DI void store_t(bf16_t* T, int colbase, const f32x4 (&acc)[2][2][4][2], int rowbase, int wr, int wc, int fr, int fq) const {
#pragma unroll
    for (int ai = 0; ai < 2; ++ai)
#pragma unroll
      for (int m = 0; m < 4; ++m) {
        const int row = rowbase + ai * 128 + wr * 64 + m * 16 + fr;
#pragma unroll
        for (int bj = 0; bj < 2; ++bj)
#pragma unroll
          for (int n = 0; n < 2; ++n) {
            const int col = colbase + bj * 128 + wc * 32 + n * 16 + fq * 4;
            const unsigned w0 = pk_bf16(acc[ai][bj][m][n][0], acc[ai][bj][m][n][1]), w1 = pk_bf16(acc[ai][bj][m][n][2], acc[ai][bj][m][n][3]);
            T[(size_t)(col + 0) * MT + row] = (bf16_t)(w0 & 0xffffu); T[(size_t)(col + 1) * MT + row] = (bf16_t)(w0 >> 16);
            T[(size_t)(col + 2) * MT + row] = (bf16_t)(w1 & 0xffffu); T[(size_t)(col + 3) * MT + row] = (bf16_t)(w1 >> 16);
          }
      }
  }
  DI void operator()(const f32x4 (&acc)[2][2][4][2], const pg8::Unit& u, int wr, int wc, int fr, int fq) const {
    const int rowbase = u.pm * 256;
    unsigned char* const BIGp = ws + WS_BIG;
    void* const p0 = mode == EPI_RES ? (void*)(ws + WS_X) : (void*)BIGp; void* const p1 = BIGp + SZ_TOK1K; void* const p2 = BIGp + 2 * SZ_TOK1K; void* const p3 = BIGp + 4 * SZ_TOK1K;
    const float* const f0 = mode == EPI_RES ? gatep() : (const float*)(ws + (mode == EPI_DA ? WS_ROPE_DA : WS_ROPE_RT));
    if (mode == EPI_SWIGLU) {
      bf16_t* O = (bf16_t*)p0;
#pragma unroll
      for (int ai = 0; ai < 2; ++ai)
#pragma unroll
        for (int m = 0; m < 4; ++m) {
          bf16_t* rowp = O + (size_t)(rowbase + ai * 128 + wr * 64 + m * 16 + fr) * DFF + u.pn * 128 + wc * 32 + 8 * fq;
          f32x4 v[2];
#pragma unroll
          for (int n = 0; n < 2; ++n) { const f32x4 a = acc[ai][0][m][n], g = acc[ai][1][m][n];
#pragma unroll
            for (int j = 0; j < 4; ++j) v[n][j] = silu_f(a[j]) * g[j]; }
          u32x4 w; w.x = pk_bf16(v[0][0], v[0][1]); w.y = pk_bf16(v[0][2], v[0][3]); w.z = pk_bf16(v[1][0], v[1][1]); w.w = pk_bf16(v[1][2], v[1][3]);
          *(u32x4*)rowp = w;
        }
    } else if (mode == EPI_RES) {
      bf16_t* X = (bf16_t*)p0; const int mb = u.pm < 64 ? (u.pm >> 3) : 8;
      const int col0 = u.pn * 256 + wc * 32 + 8 * fq;
      f32x4 gv[2][2];
#pragma unroll
      for (int bj = 0; bj < 2; ++bj)
#pragma unroll
        for (int n = 0; n < 2; ++n) gv[bj][n] = *(const f32x4*)(f0 + (size_t)mb * 9216 + col0 + bj * 128 + n * 4) * coef;
#pragma unroll
      for (int ai = 0; ai < 2; ++ai)
#pragma unroll
        for (int m = 0; m < 4; ++m) {
          bf16_t* rowp = X + (size_t)(rowbase + ai * 128 + wr * 64 + m * 16 + fr) * DM + col0;
#pragma unroll
          for (int bj = 0; bj < 2; ++bj) { f32x4 x0, x1; ld_bf8(rowp + bj * 128, x0, x1);
            st_bf8(rowp + bj * 128, x0 * ALPHA + gv[bj][0] * acc[ai][bj][m][0], x1 * ALPHA + gv[bj][1] * acc[ai][bj][m][1]); }
        }
    } else if (mode == EPI_DA) {
      if (u.pn < 8) {
        bf16_t* base = (bf16_t*)(u.pn < 4 ? p0 : p1); const float sc = u.pn < 4 ? 0.125f * LOG2E : 1.0f; const int tcol = (u.pn & 3) * 256 + wc * 64;
        const bool lat = u.pm < 64; const f32x2* rope = (const f32x2*)f0;
#pragma unroll
        for (int ai = 0; ai < 2; ++ai)
#pragma unroll
          for (int m = 0; m < 4; ++m) {
            const int row = rowbase + ai * 128 + wr * 64 + m * 16 + fr, t = row & 2047;
            f32x4 o1[2], o2[2];
#pragma unroll
            for (int n = 0; n < 2; ++n) {
              const int dd = 8 * fq + 4 * n; const f32x4 x1 = acc[ai][0][m][n], x2 = acc[ai][1][m][n];
              if (lat) {
#pragma unroll
                for (int j = 0; j < 4; ++j) { const f32x2 cs = rope[t * 32 + dd + j]; o1[n][j] = (x1[j] * cs.x - x2[j] * cs.y) * sc; o2[n][j] = (x1[j] * cs.y + x2[j] * cs.x) * sc; }
              } else { o1[n] = x1 * sc; o2[n] = x2 * sc; }
            }
            { bf16_t* q = base + (size_t)row * 1024 + tcol + 8 * fq; st_bf8(q, o1[0], o1[1]); st_bf8(q + 32, o2[0], o2[1]); }
          }
      } else store_t((bf16_t*)p2, (u.pn - 8) * 256, acc, rowbase, wr, wc, fr, fq);
    } else if (mode == EPI_HY) {
      store_t((bf16_t*)p0, u.pn * 256, acc, rowbase, wr, wc, fr, fq);
    } else if (mode == EPI_RT) {
      if (u.pn < 8) {
        bf16_t* base = (bf16_t*)(u.pn < 4 ? p0 : p1); const float sc = u.pn < 4 ? 1.0f : 0.0625f; const int tcol = (u.pn & 3) * 256 + wc * 32;
        const bool lat = u.pm < 64; const f32x2* rope = (const f32x2*)f0;
#pragma unroll
        for (int ai = 0; ai < 2; ++ai)
#pragma unroll
          for (int m = 0; m < 4; ++m) {
            const int row = rowbase + ai * 128 + wr * 64 + m * 16 + fr, t = row & 2047;
            f32x4 o1[2], o2[2];
#pragma unroll
            for (int n = 0; n < 2; ++n) {
              const int dd = wc * 32 + 8 * fq + 4 * n; const f32x4 x1 = acc[ai][0][m][n], x2 = acc[ai][1][m][n];
              if (lat) {
#pragma unroll
                for (int j = 0; j < 4; ++j) { const f32x2 cs = rope[t * 128 + dd + j]; o1[n][j] = (x1[j] * cs.x - x2[j] * cs.y) * sc; o2[n][j] = (x1[j] * cs.y + x2[j] * cs.x) * sc; }
              } else { o1[n] = x1 * sc; o2[n] = x2 * sc; }
            }
            { bf16_t* q = base + (size_t)row * 1024 + tcol + 8 * fq; st_bf8(q, o1[0], o1[1]); st_bf8(q + 128, o2[0], o2[1]); }
          }
        (void)tcol;
      } else if (u.pn < 16) store_t((bf16_t*)p2, (u.pn - 8) * 256, acc, rowbase, wr, wc, fr, fq);
      else {
        bf16_t* G = (bf16_t*)p3;
#pragma unroll
        for (int ai = 0; ai < 2; ++ai)
#pragma unroll
          for (int m = 0; m < 4; ++m) {
            bf16_t* rowp = G + (size_t)(rowbase + ai * 128 + wr * 64 + m * 16 + fr) * 2048 + (u.pn - 16) * 256 + wc * 32 + 8 * fq;
#pragma unroll
            for (int bj = 0; bj < 2; ++bj) { f32x4 v[2];
#pragma unroll
              for (int n = 0; n < 2; ++n)
#pragma unroll
                for (int j = 0; j < 4; ++j) v[n][j] = silu_f(acc[ai][bj][m][n][j]);
              st_bf8(rowp + bj * 128, v[0], v[1]); }
          }
      }
    } else if (mode == EPI_PART) {
      float* P = (float*)(BIGp + 5 * SZ_TOK1K); const int col0 = u.pn * 256 + wc * 32 + 8 * fq;
#pragma unroll
      for (int ai = 0; ai < 2; ++ai)
#pragma unroll
        for (int m = 0; m < 4; ++m) { float* rowp = P + (size_t)(rowbase + ai * 128 + wr * 64 + m * 16 + fr) * DM + col0;
#pragma unroll
          for (int bj = 0; bj < 2; ++bj)
#pragma unroll
            for (int n = 0; n < 2; ++n) *(f32x4*)(rowp + bj * 128 + n * 4) = acc[ai][bj][m][n]; }
    } else {
      if (u.pn < 4) {
        bf16_t* BG = (bf16_t*)p0;
#pragma unroll
        for (int ai = 0; ai < 2; ++ai)
#pragma unroll
          for (int m = 0; m < 4; ++m) {
            bf16_t* rowp = BG + (size_t)(rowbase + ai * 128 + wr * 64 + m * 16 + fr) * 1024 + u.pn * 256 + wc * 32 + 8 * fq;
#pragma unroll
            for (int bj = 0; bj < 2; ++bj) st_bf8(rowp + bj * 128, acc[ai][bj][m][0], acc[ai][bj][m][1]);
          }
      } else {
        bf16_t* CU = (bf16_t*)p1;
#pragma unroll
        for (int ai = 0; ai < 2; ++ai)
#pragma unroll
          for (int m = 0; m < 4; ++m) {
            bf16_t* rowp = CU + (size_t)(rowbase + ai * 128 + wr * 64 + m * 16 + fr) * 1024 + (u.pn - 4) * 128 + wc * 32 + 8 * fq;
            st_bf8(rowp, acc[ai][0][m][0] * acc[ai][1][m][0], acc[ai][0][m][1] * acc[ai][1][m][1]);
          }
      }
    }
  }
};

DI int map_col(int kind, int rho) {
  if (kind == 1) { const int t = rho >> 8, r = rho & 255; return r < 128 ? 128 * t + r : DFF + 128 * t + (r - 128); }
  if (kind == 2) { if (rho >= 2048) return rho; const int base = rho & ~255, r = rho & 255; const int bj = r >> 7, hm = (r & 127) >> 5, dd = r & 31; return base + hm * 64 + bj * 32 + dd; }
  if (kind == 3) { if (rho < 1024) return rho; const int t = (rho - 1024) >> 8, r = (rho - 1024) & 255; return r < 128 ? 1024 + 128 * t + r : 2048 + 128 * t + (r - 128); }
  return rho;
}

DI void conv_units(const Params& p, int zz, int tx, int ulo, int uhi, int wgi, int nwgs) {
  const int wid = tx >> 6, lane = tx & 63, cg = lane & 7, kb8 = lane >> 3;
  const int nw = nwgs * 8;
  for (int u = ulo + wgi * 8 + wid; u < uhi; u += nw) {
    int j = 0;
#pragma unroll 1
    for (int k = 1; k < 24; ++k) if (u >= p.jobs[k + zz].ustart) j = k;
    const WJob jb = p.jobs[j + zz];
    const int lu = u - jb.ustart, nkb = jb.K >> 8, rb = lu / nkb, kb = lu - rb * nkb;
    const int rho0 = rb * 32, k0 = kb * 256 + 8 * kb8, scol = map_col(jb.kind, rho0) + ((jb.kind == 1 || jb.kind == 4 || jb.kind == 3 || (jb.kind == 2 && rho0 < 2048) || (jb.kind == 5 && (rho0 < 2048 || rho0 >= 4096))) ? 8 * (cg & 3) + 4 * (cg >> 2) : 4 * cg);
    const float* src = jb.src + (size_t)k0 * jb.srcN + scol;
    bf16_t* dst = jb.dst + (size_t)(rho0 + 4 * cg) * jb.K + k0;
    const size_t rs = (size_t)jb.srcN;
#pragma unroll 2
    for (int it = 0; it < 4; ++it) {
      f32x4 v[8];
#pragma unroll
      for (int q = 0; q < 8; ++q) v[q] = *(const f32x4*)(src + (size_t)(it * 64 + q) * rs);
#pragma unroll
      for (int e = 0; e < 4; ++e) { u32x4 w; w.x = pk_bf16(v[0][e], v[1][e]); w.y = pk_bf16(v[2][e], v[3][e]); w.z = pk_bf16(v[4][e], v[5][e]); w.w = pk_bf16(v[6][e], v[7][e]);
        *(u32x4*)(dst + (size_t)e * jb.K + it * 64) = w; }
    }
  }
}

DI void mods_prepare(const Params& p, int zz, int tx, LAS unsigned char* lds) {
  LAS float* sc = (LAS float*)lds;
  for (int idx = tx; idx < 9216; idx += NTHR) { const int r = idx >> 10, k = idx & 1023; const float v = r < 8 ? p.in[zz + 1][r * 1024 + k] : p.in[zz + 3][k]; sc[idx] = v / (1.0f + __expf(-v)); }
  __syncthreads();
}
DI void mods_unit(const Params& p, int zz, int tx, LAS unsigned char* lds, int u) {
  LAS float* sc = (LAS float*)lds; LAS float* part = (LAS float*)(lds + 36864);
  const int l = u / 36, cb = u - l * 36, wid = tx >> 6, lane = tx & 63, col = cb * 256 + lane * 4;
  const float* W = p.in[zz + 4] + (size_t)l * 1024 * 9216 + col;
  f32x4 acc[9];
#pragma unroll
  for (int r = 0; r < 9; ++r) acc[r] = (f32x4){0.f, 0.f, 0.f, 0.f};
#pragma unroll 8
  for (int k = wid * 128; k < wid * 128 + 128; ++k) {
    const f32x4 w = *(const f32x4*)(W + (size_t)k * 9216);
#pragma unroll
    for (int r = 0; r < 9; ++r) acc[r] += w * sc[r * 1024 + k];
  }
#pragma unroll
  for (int r = 0; r < 9; ++r) *(LAS f32x4*)(part + (wid * 9 + r) * 256 + lane * 4) = acc[r];
  __syncthreads();
  float* mods = (float*)((p.ws + zz) + WS_MODS);
  for (int idx = tx; idx < 9 * 256; idx += NTHR) {
    const int r = idx >> 8, cl = idx & 255; float s = p.in[zz + 5][l * 9216 + cb * 256 + cl];
#pragma unroll
    for (int w = 0; w < 8; ++w) s += part[(w * 9 + r) * 256 + cl];
    mods[(size_t)(l * 9 + r) * 9216 + cb * 256 + cl] = s;
  }
  __syncthreads();
}

DI void filter_unit(const Params& p, int zz, int tx, LAS unsigned char* lds, int u) {
  const bool lat = u < 256; const int n = lat ? 2048 : 256, p0 = lat ? u * 8 : (u - 256) * 8, tid = tx;
  LAS float* z = (LAS float*)lds;
  LAS float* h1 = z + 8 * 33;
  LAS float* h2 = h1 + 8 * 64;
  const float* w1 = p.in[zz + 19]; const float* b1 = p.in[zz + 20]; const float* f1 = p.in[zz + 21]; const float* w2 = p.in[zz + 22]; const float* b2 = p.in[zz + 23]; const float* f2 = p.in[zz + 24];
  const float* w3 = p.in[zz + 25]; const float* dsk = p.in[zz + 26];
  if (tid < 8 * 33) { const int pos = tid / 33, f = tid - pos * 33; const int pp = p0 + pos; const float t = (float)pp / (float)(n - 1), w = 6.283185307179586f * (float)pp / (float)n;
    float v; if (f == 0) v = t; else { const int k = (f - 1) & 15; const float fr = 1e-4f + (float)k * ((15.0f - 1e-4f) / 15.0f); v = f <= 16 ? __cosf(fr * w) : -__sinf(fr * w); }
    z[tid] = v; }
  __syncthreads();
  { const int pos = tid >> 6, o = tid & 63; float s = b1[o];
#pragma unroll 3
    for (int f = 0; f < 33; ++f) s += z[pos * 33 + f] * w1[f * 64 + o];
    h1[tid] = __sinf(f1[o] * s); }
  __syncthreads();
  { const int pos = tid >> 6, o = tid & 63; float s = b2[o];
#pragma unroll 4
    for (int k = 0; k < 64; ++k) s += h1[pos * 64 + k] * w2[k * 64 + o];
    h2[tid] = __sinf(f2[o] * s); }
  __syncthreads();
  { const int cc = tid * 4; f32x4 a[8];
#pragma unroll
    for (int q = 0; q < 8; ++q) a[q] = (f32x4){0.f, 0.f, 0.f, 0.f};
#pragma unroll 16
    for (int k = 0; k < 64; ++k) { const f32x4 w = *(const f32x4*)(w3 + (size_t)k * 2048 + cc);
#pragma unroll
      for (int q = 0; q < 8; ++q) a[q] += w * h2[q * 64 + k]; }
    const bool bwd = cc >= 1024; const int c0 = cc & 1023;
    const float mind = -3.0701134573253944f, maxd = -15.350567286626972f;
    bf16_t* R = (bf16_t*)((p.ws + zz) + (lat ? WS_HYRL : WS_HYRC)); const int rs = lat ? RL_STRIDE : RC_STRIDE;
#pragma unroll
    for (int q = 0; q < 8; ++q) { const int pp = p0 + q; const float t = (float)pp / (float)(n - 1);
#pragma unroll
      for (int e = 0; e < 4; ++e) { const int c = c0 + e; const float dl = fabsf(mind + (maxd - mind) * ((float)c / 1023.0f));
        float v = a[q][e] * __expf(-t * dl);
        if (!bwd) { if (pp == 0) v += dsk[c]; R[(size_t)c * rs + (n - pp)] = f2bf(v); }
        else if (pp > 0) R[(size_t)c * rs + (n + pp)] = f2bf(v); } }
    if (p0 == 0) { for (int idx = tid; idx < 1024 * 9; idx += NTHR) { const int c = idx / 9, e = idx - c * 9; R[(size_t)c * rs + (e == 0 ? 0 : 2 * n + e - 1)] = 0; } }
  }
  __syncthreads();
}

DI void rope_tables(const Params& p, int zz, int tx) {
  f32x2* rd = (f32x2*)((p.ws + zz) + WS_ROPE_DA); f32x2* rr = (f32x2*)((p.ws + zz) + WS_ROPE_RT);
  const int gsz = gridDim.x * NTHR, gid = blockIdx.x * NTHR + tx;
  for (int idx = gid; idx < 2048 * 32; idx += gsz) { const int t = idx >> 5, d = idx & 31; const int k = d & 15; const float inv = exp2f(-(float)k / 16.0f * 13.287712379549449f);
    const float ang = (float)(d < 16 ? (t >> 6) : (t & 63)) * inv; rd[idx] = (f32x2){__cosf(ang), __sinf(ang)}; }
  for (int idx = gid; idx < 2048 * 128; idx += gsz) { const int t = idx >> 7, d = idx & 127; const int k = d & 63; const float inv = exp2f(-(float)k / 64.0f * 13.287712379549449f);
    const float ang = (float)(d < 64 ? (t >> 6) : (t & 63)) * inv; rr[idx] = (f32x2){__cosf(ang), __sinf(ang)}; }
}

DI void init_phase(const Params& p, int zz, int tx) {
  bf16_t* X = (bf16_t*)((p.ws + zz) + WS_X); bf16_t* H = (bf16_t*)((p.ws + zz) + WS_H); const float* mods = (const float*)((p.ws + zz) + WS_MODS);
  const int wid = tx >> 6, lane = tx & 63;
  for (int row = blockIdx.x * 8 + wid; row < MT; row += gridDim.x * 8) {
    const float* src = row < ML ? p.in[zz + 0] + (size_t)row * DM : p.in[zz + 2] + (size_t)(row - ML) * DM; const int mb = row < ML ? row >> 11 : 8;
#pragma unroll
    for (int k = 0; k < 2; ++k) { const int col = k * 512 + lane * 8; const f32x4 va = *(const f32x4*)(src + col), vb = *(const f32x4*)(src + col + 4);
      st_bf8(X + (size_t)row * DM + col, va, vb);
      const float* mr = mods + (size_t)mb * 9216 + col;
      const f32x4 sha = *(const f32x4*)(mr), shb = *(const f32x4*)(mr + 4), sca = *(const f32x4*)(mr + 1024), scb = *(const f32x4*)(mr + 1024 + 4);
      st_bf8(H + (size_t)row * DM + col, va * (sca + 1.0f) + sha, vb * (scb + 1.0f) + shb); }
  }
}

DI void ln_phase(const Params& p, int zz, int tx, int M, const float* g, const float* bta, const float* shift, const float* scale, bool final, const float* part, const float* pgate) {
  bf16_t* X = (bf16_t*)((p.ws + zz) + WS_X); bf16_t* H = (bf16_t*)((p.ws + zz) + WS_H);
  const int wid = tx >> 6, lane = tx & 63, stride = gridDim.x * 8;
  f32x4 g4[4], b4[4];
#pragma unroll
  for (int q = 0; q < 4; ++q) { const int col = (q >> 1) * 512 + lane * 8 + (q & 1) * 4; g4[q] = *(const f32x4*)(g + col); b4[q] = *(const f32x4*)(bta + col); }
  for (int row0 = blockIdx.x * 8 + wid; row0 < M; row0 += 2 * stride) {
    const int row1 = row0 + stride; const bool has1 = row1 < M;
    bf16_t* xr0 = X + (size_t)row0 * DM + lane * 8; bf16_t* xr1 = X + (size_t)(has1 ? row1 : row0) * DM + lane * 8;
    f32x4 v0[4], v1[4]; float s0 = 0.f, s1 = 0.f;
    ld_bf8(xr0, v0[0], v0[1]); ld_bf8(xr0 + 512, v0[2], v0[3]); ld_bf8(xr1, v1[0], v1[1]); ld_bf8(xr1 + 512, v1[2], v1[3]);
    if (part != nullptr && row0 >= ML) {
      const float* q0 = part + (size_t)(row0 - ML) * DM; const float* q1 = part + (size_t)((has1 ? row1 : row0) - ML) * DM;
#pragma unroll
      for (int q = 0; q < 4; ++q) { const int col = (q >> 1) * 512 + lane * 8 + (q & 1) * 4; const f32x4 gt = *(const f32x4*)(pgate + col) * 0.5f;
        v0[q] = v0[q] * ALPHA + gt * (*(const f32x4*)(q0 + col) + *(const f32x4*)(q0 + (size_t)2048 * DM + col));
        v1[q] = v1[q] * ALPHA + gt * (*(const f32x4*)(q1 + col) + *(const f32x4*)(q1 + (size_t)2048 * DM + col)); }
    }
#pragma unroll
    for (int k = 0; k < 4; ++k) { s0 += (v0[k][0] + v0[k][1]) + (v0[k][2] + v0[k][3]); s1 += (v1[k][0] + v1[k][1]) + (v1[k][2] + v1[k][3]); }
#pragma unroll
    for (int o = 32; o >= 1; o >>= 1) { s0 += __shfl_xor(s0, o); s1 += __shfl_xor(s1, o); }
    const float mean0 = s0 * (1.0f / 1024.0f), mean1 = s1 * (1.0f / 1024.0f); float q0s = 0.f, q1s = 0.f;
#pragma unroll
    for (int k = 0; k < 4; ++k) { const f32x4 d0 = v0[k] - mean0, d1 = v1[k] - mean1; q0s += (d0[0] * d0[0] + d0[1] * d0[1]) + (d0[2] * d0[2] + d0[3] * d0[3]); q1s += (d1[0] * d1[0] + d1[1] * d1[1]) + (d1[2] * d1[2] + d1[3] * d1[3]); }
#pragma unroll
    for (int o = 32; o >= 1; o >>= 1) { q0s += __shfl_xor(q0s, o); q1s += __shfl_xor(q1s, o); }
    const float rstd0 = rsqrtf(q0s * (1.0f / 1024.0f) + LN_EPS), rstd1 = rsqrtf(q1s * (1.0f / 1024.0f) + LN_EPS);
#pragma unroll
    for (int rr = 0; rr < 2; ++rr) {
      if (rr == 1 && !has1) break;
      const int row = rr ? row1 : row0; const int mb = row < ML ? row >> 11 : 8; bf16_t* xr = rr ? xr1 : xr0; const float mean = rr ? mean1 : mean0, rstd = rr ? rstd1 : rstd0;
      f32x4 y[4];
#pragma unroll
      for (int q = 0; q < 4; ++q) y[q] = ((rr ? v1[q] : v0[q]) - mean) * rstd * g4[q] + b4[q];
      if (final) {
#pragma unroll
        for (int q = 0; q < 4; ++q) *(f32x4*)((p.out + zz) + (size_t)row * DM + (q >> 1) * 512 + lane * 8 + (q & 1) * 4) = y[q];
      } else {
        st_bf8(xr, y[0], y[1]); st_bf8(xr + 512, y[2], y[3]);
        f32x4 h[4];
#pragma unroll
        for (int q = 0; q < 4; ++q) { const int col = (q >> 1) * 512 + lane * 8 + (q & 1) * 4; const f32x4 sh = *(const f32x4*)(shift + (size_t)mb * 9216 + col), sc = *(const f32x4*)(scale + (size_t)mb * 9216 + col); h[q] = y[q] * (sc + 1.0f) + sh; }
        bf16_t* hp = H + (size_t)row * DM + lane * 8; st_bf8(hp, h[0], h[1]); st_bf8(hp + 512, h[2], h[3]);
      }
    }
  }
}

DI void sc_core_phase(const Params& p, int zz, int tx) {
  const bf16_t* BG = (const bf16_t*)((p.ws + zz) + WS_BIG); const bf16_t* CU = (const bf16_t*)((p.ws + zz) + WS_BIG + SZ_TOK1K); bf16_t* H = (bf16_t*)((p.ws + zz) + WS_H); const float* cw = p.in[zz + 33];
  for (int idx = blockIdx.x * NTHR + tx; idx < ML * 128; idx += gridDim.x * NTHR) {
    const int row = idx >> 7, c8 = (idx & 127) * 8, t = row & 2047; const size_t o = (size_t)row * 1024 + c8;
    f32x4 c0a, c0b, cma, cmb, cpa, cpb, bga, bgb;
    const f32x4 z4 = (f32x4){0.f, 0.f, 0.f, 0.f};
    ld_bf8(CU + o, c0a, c0b); ld_bf8(BG + o, bga, bgb);
    if (t > 0) ld_bf8(CU + o - 1024, cma, cmb); else { cma = z4; cmb = z4; }
    if (t < 2047) ld_bf8(CU + o + 1024, cpa, cpb); else { cpa = z4; cpb = z4; }
    const f32x4 w0a = *(const f32x4*)(cw + c8), w0b = *(const f32x4*)(cw + c8 + 4), w1a = *(const f32x4*)(cw + 1024 + c8), w1b = *(const f32x4*)(cw + 1024 + c8 + 4), w2a = *(const f32x4*)(cw + 2048 + c8), w2b = *(const f32x4*)(cw + 2048 + c8 + 4);
    st_bf8(H + o, bga * (w0a * cma + w1a * c0a + w2a * cpa), bgb * (w0b * cmb + w1b * c0b + w2b * cpb));
  }
}

DI void hy_transpose_phase(const Params& p, int zz, int tx, LAS unsigned char* lds) {
  const bf16_t* ZT = (const bf16_t*)((p.ws + zz) + WS_BIG + 3 * SZ_TOK1K); bf16_t* H = (bf16_t*)((p.ws + zz) + WS_H); LAS bf16_t* T = (LAS bf16_t*)lds;
  const int tid = tx;
  for (int u = blockIdx.x; u < 16 * 288; u += gridDim.x) {
    const int ct = u & 15, tt = u >> 4, c0 = ct * 64, tok0 = tt * 64;
    { const int r = tid >> 3, ch = tid & 7; *(LAS u32x4*)(T + r * 72 + ch * 8) = *(const u32x4*)(ZT + (size_t)(c0 + r) * MT + tok0 + ch * 8); }
    __syncthreads();
    { const int tok = tid >> 3, cc = (tid & 7) * 8; unsigned w[4];
#pragma unroll
      for (int k = 0; k < 4; ++k) w[k] = (unsigned)T[(cc + 2 * k) * 72 + tok] | ((unsigned)T[(cc + 2 * k + 1) * 72 + tok] << 16);
      *(u32x4*)(H + (size_t)(tok0 + tok) * 1024 + c0 + cc) = (u32x4){w[0], w[1], w[2], w[3]}; }
    __syncthreads();
  }
}

DI void da_attn_phase(const Params& p, int zz, int tx, LAS unsigned char* lds) {
  const bf16_t* Q = (const bf16_t*)((p.ws + zz) + WS_BIG); const bf16_t* Kb = (const bf16_t*)((p.ws + zz) + WS_BIG + SZ_TOK1K); const bf16_t* VT = (const bf16_t*)((p.ws + zz) + WS_BIG + 2 * SZ_TOK1K);
  bf16_t* AO = (bf16_t*)((p.ws + zz) + WS_H);
  const int tid = tx, wid = tid >> 6, lane = tid & 63, fr = lane & 15, fq = lane >> 4;
  const float* lam = p.in[zz + 14]; const float* subln = p.in[zz + 15];
  const float lam_init = 0.2f;
  const float lam_full = __expf(wave_sum(lam[lane] * lam[64 + lane])) - __expf(wave_sum(lam[128 + lane] * lam[192 + lane])) + lam_init;
  const int vcu = (gridDim.x % 8 == 0) ? (int)((blockIdx.x % 8) * (gridDim.x / 8) + blockIdx.x / 8) : (int)blockIdx.x;
  if (__builtin_amdgcn_readfirstlane(tx) >= 256) __builtin_amdgcn_s_setprio(1);
  for (int it = vcu; it < 1024 + 128; it += gridDim.x) {
    const bool isctx = it >= 1024; int b, h, qrow0, nkt;
    if (!isctx) { b = it >> 7; h = (it >> 4) & 7; qrow0 = b * 2048 + (it & 15) * 128; nkt = 36; }
    else { const int j = it - 1024; b = j >> 4; h = (j >> 1) & 7; qrow0 = ML + b * 256 + (j & 1) * 128; nkt = 4; }
    bf16x8 qf[2][2];
    { const bf16_t* qp = Q + (size_t)(qrow0 + wid * 16 + fr) * 1024 + h * 128 + fq * 8;
#pragma unroll
      for (int m = 0; m < 2; ++m)
#pragma unroll
        for (int ks = 0; ks < 2; ++ks) qf[m][ks] = *(const bf16x8*)(qp + m * 64 + ks * 32); }
    f32x4 O[2][8]; float mrun[2] = {-1e30f, -1e30f}, lsum[2] = {0.f, 0.f};
#pragma unroll
    for (int m = 0; m < 2; ++m)
#pragma unroll
      for (int et = 0; et < 8; ++et) O[m][et] = (f32x4){0.f, 0.f, 0.f, 0.f};
    u32x4 kreg[2], vreg[2];
#define DA_TOK(kt_) (((isctx) || (kt_) < 4) ? ML + b * 256 + (kt_) * 64 : b * 2048 + ((kt_) - 4) * 64)
#define DA_FETCH(kt_) do { const int tok0_ = DA_TOK(kt_); _Pragma("unroll") for (int i = 0; i < 2; ++i) { const int id = tid + NTHR * i; \
      kreg[i] = *(const u32x4*)(Kb + (size_t)(tok0_ + (id >> 4)) * 1024 + h * 128 + (id & 15) * 8); \
      vreg[i] = *(const u32x4*)(VT + (size_t)(h * 128 + (id >> 3)) * MT + tok0_ + (id & 7) * 8); } } while (0)
#define DA_PUT(buf_) do { LAS bf16_t* Kw = (LAS bf16_t*)(lds + (buf_) * 38912); LAS bf16_t* Vw = (LAS bf16_t*)(lds + (buf_) * 38912 + 18432); \
      _Pragma("unroll") for (int i = 0; i < 2; ++i) { const int id = tid + NTHR * i; \
        *(LAS u32x4*)(Kw + (id >> 4) * 144 + (id & 15) * 8) = kreg[i]; \
        const int cc = id & 7; LAS bf16_t* vp = Vw + (id >> 3) * 80 + 32 * (cc >> 2) + 16 * (cc & 1) + 4 * ((cc >> 1) & 1);     \
        *(LAS u32x2*)vp = (u32x2){vreg[i].x, vreg[i].y}; *(LAS u32x2*)(vp + 8) = (u32x2){vreg[i].z, vreg[i].w}; } } while (0)
    DA_FETCH(0);
    __syncthreads();
    DA_PUT(0);
    if (nkt > 1) DA_FETCH(1);
    __syncthreads();
    for (int kt = 0; kt < nkt; ++kt) {
      const LAS bf16_t* Ks = (const LAS bf16_t*)(lds + (kt & 1) * 38912); const LAS bf16_t* Vs = (const LAS bf16_t*)(lds + (kt & 1) * 38912 + 18432);
      f32x4 s[2][4];
#pragma unroll
      for (int m = 0; m < 2; ++m)
#pragma unroll
        for (int kk = 0; kk < 4; ++kk) { f32x4 a4 = (f32x4){0.f, 0.f, 0.f, 0.f};
#pragma unroll
          for (int ks = 0; ks < 2; ++ks) { const bf16x8 kf = *(const LAS bf16x8*)(Ks + (kk * 16 + fr) * 144 + m * 64 + ks * 32 + fq * 8); a4 = __builtin_amdgcn_mfma_f32_16x16x32_bf16(kf, qf[m][ks], a4, 0, 0, 0); }
          s[m][kk] = a4; }
      float mxl[2];
#pragma unroll
      for (int m = 0; m < 2; ++m) {
        float mx = fmaxf(fmaxf(s[m][0][0], s[m][0][1]), s[m][0][2]);
        mx = fmaxf(fmaxf(mx, s[m][0][3]), s[m][1][0]);
#pragma unroll
        for (int kk = 1; kk < 4; ++kk) {
          if (kk > 1) mx = fmaxf(fmaxf(mx, s[m][kk][0]), s[m][kk][1]); else mx = fmaxf(mx, s[m][kk][1]);
          mx = fmaxf(fmaxf(mx, s[m][kk][2]), s[m][kk][3]); }
        mxl[m] = mx; }
      if (__builtin_amdgcn_ballot_w64((mxl[0] > mrun[0] + 8.0f) || (mxl[1] > mrun[1] + 8.0f)) != 0ull) {
#pragma unroll
        for (int m = 0; m < 2; ++m) {
          float mx = mxl[m]; mx = fmaxf(mx, __shfl_xor(mx, 16)); mx = fmaxf(mx, __shfl_xor(mx, 32));
          const float mnew = fmaxf(mrun[m], mx), corr = fast_exp2(mrun[m] - mnew); mrun[m] = mnew; lsum[m] *= corr;
#pragma unroll
          for (int et = 0; et < 8; ++et) O[m][et] *= corr;
        }
      }
#pragma unroll
      for (int m = 0; m < 2; ++m) { float ps = 0.f;
#pragma unroll
        for (int kk = 0; kk < 4; ++kk)
#pragma unroll
          for (int j = 0; j < 4; ++j) { const float e = fast_exp2(s[m][kk][j] - mrun[m]); s[m][kk][j] = e; ps += e; }
        lsum[m] += ps; }
#pragma unroll
      for (int s2 = 0; s2 < 2; ++s2) {
        bf16x8 pf[2];
#pragma unroll
        for (int m = 0; m < 2; ++m) { u32x4 w; w.x = pk_bf16(s[m][2 * s2][0], s[m][2 * s2][1]); w.y = pk_bf16(s[m][2 * s2][2], s[m][2 * s2][3]); w.z = pk_bf16(s[m][2 * s2 + 1][0], s[m][2 * s2 + 1][1]); w.w = pk_bf16(s[m][2 * s2 + 1][2], s[m][2 * s2 + 1][3]); pf[m] = __builtin_bit_cast(bf16x8, w); }
#pragma unroll
        for (int et = 0; et < 8; ++et) {
          const bf16x8 vf = *(const LAS bf16x8*)(Vs + (et * 16 + fr) * 80 + 32 * s2 + 8 * fq);
          O[0][et] = __builtin_amdgcn_mfma_f32_16x16x32_bf16(vf, pf[0], O[0][et], 0, 0, 0);
          O[1][et] = __builtin_amdgcn_mfma_f32_16x16x32_bf16(vf, pf[1], O[1][et], 0, 0, 0);
        }
      }
      if (kt + 1 < nkt) { DA_PUT((kt + 1) & 1); if (kt + 2 < nkt) DA_FETCH(kt + 2); }
      __syncthreads();
    }
#undef DA_PUT
    float inv[2];
#pragma unroll
    for (int m = 0; m < 2; ++m) { float l = lsum[m]; l += __shfl_xor(l, 16); l += __shfl_xor(l, 32); inv[m] = 1.0f / l; }
    float ss = 0.f;
#pragma unroll
    for (int et = 0; et < 8; ++et)
#pragma unroll
      for (int j = 0; j < 4; ++j) { const float o = O[0][et][j] * inv[0] - lam_full * (O[1][et][j] * inv[1]); O[0][et][j] = o; ss += o * o; }
    ss += __shfl_xor(ss, 16); ss += __shfl_xor(ss, 32);
    const float rn = rsqrtf(ss * (1.0f / 128.0f) + LN_EPS) * (1.0f - lam_init);
    bf16_t* op = AO + (size_t)(qrow0 + wid * 16 + fr) * 1024 + h * 128 + 4 * fq;
#pragma unroll
    for (int et = 0; et < 8; ++et) { const f32x4 g = *(const f32x4*)(subln + et * 16 + 4 * fq); st_bf4(op + et * 16, O[0][et] * g * rn); }
  }
  __builtin_amdgcn_s_setprio(0);
}

#ifndef PVD
#define PVD 2
#endif
DI void rt_attn_phase(const Params& p, int zz, int tx, LAS unsigned char* lds) {
  const bf16_t* Q = (const bf16_t*)((p.ws + zz) + WS_BIG); const bf16_t* Kb = (const bf16_t*)((p.ws + zz) + WS_BIG + SZ_TOK1K); const bf16_t* VT = (const bf16_t*)((p.ws + zz) + WS_BIG + 2 * SZ_TOK1K);
  bf16_t* G = (bf16_t*)((p.ws + zz) + WS_BIG + 4 * SZ_TOK1K);
  const int tid = tx, wid = tid >> 6, lane = tid & 63, fr = lane & 15, fq = lane >> 4;
  const float* dl = p.in[zz + 29]; const float* gn = p.in[zz + 30];
  LAS bf16_t* Ks = (LAS bf16_t*)lds;
  LAS bf16_t* Vs = (LAS bf16_t*)(lds + 17408);
  const int vcu = (gridDim.x % 8 == 0) ? (int)((blockIdx.x % 8) * (gridDim.x / 8) + blockIdx.x / 8) : (int)blockIdx.x;
  if (__builtin_amdgcn_readfirstlane(tx) >= 256) __builtin_amdgcn_s_setprio(1);
  for (int it = vcu; it < 512; it += gridDim.x) {
    const int b = it >> 6, h = (it >> 4) & 3, qb = it & 15, qrow0 = b * 2048 + qb * 128;
    const float lgf = log2f(1.0f / (1.0f + expf(-dl[h]))), lgb = log2f(1.0f / (1.0f + expf(-dl[4 + h])));
    const int tq = qb * 128 + wid * 16 + fr;
    LAS bf16_t* Qs = (LAS bf16_t*)(lds + 66560);
    __syncthreads();
#pragma unroll
    for (int i = 0; i < 8; ++i) { const int id = tid + NTHR * i, r = id >> 5, cc = id & 31; *(LAS u32x4*)(Qs + r * 272 + cc * 8) = *(const u32x4*)(Q + (size_t)(qrow0 + r) * 1024 + h * 256 + cc * 8); }
    const LAS bf16_t* qsp = Qs + (wid * 16 + fr) * 272 + fq * 8;
    f32x4 O[32];
#pragma unroll
    for (int et = 0; et < 32; ++et) O[et] = (f32x4){0.f, 0.f, 0.f, 0.f};
    u32x4 kreg[2], vreg[4];
#define RT_TOK(kt_) ((kt_) < 8 ? ML + b * 256 + (kt_) * 32 : b * 2048 + ((kt_) - 8) * 32)
#define RT_FETCH(kt_) do { const int tok0_ = RT_TOK(kt_); _Pragma("unroll") for (int i = 0; i < 2; ++i) { const int id = tidl + NTHR * i; \
      kreg[i] = *(const u32x4*)(Kb + (size_t)(tok0_ + (id >> 5)) * 1024 + h * 256 + (id & 31) * 8); } \
    _Pragma("unroll") for (int i = 0; i < 4; ++i) { const int id = tidl + NTHR * i; \
      vreg[i] = *(const u32x4*)(VT + (size_t)(h * 512 + (id >> 2)) * MT + tok0_ + (id & 3) * 8); } } while (0)
    { int tidl = tid; RT_FETCH(0); }
    for (int kt = 0; kt < 72; ++kt) {
      int tidl = tid; asm volatile("" : "+v"(tidl));
      const bool kctx = kt < 8; const int spos = kctx ? kt * 32 : (kt - 8) * 32;
      __syncthreads();
#pragma unroll
      for (int i = 0; i < 2; ++i) { const int id = tidl + NTHR * i; *(LAS u32x4*)(Ks + (id >> 5) * 272 + (id & 31) * 8) = kreg[i]; }
#pragma unroll
      for (int i = 0; i < 4; ++i) { const int id = tidl + NTHR * i, cc = id & 3; LAS bf16_t* vp = Vs + (id >> 2) * 48 + 16 * (cc & 1) + 4 * (cc >> 1);
        *(LAS u32x2*)vp = (u32x2){vreg[i].x, vreg[i].y}; *(LAS u32x2*)(vp + 8) = (u32x2){vreg[i].z, vreg[i].w}; }
      __syncthreads();
      if (kt + 1 < 72) RT_FETCH(kt + 1);
      f32x4 s[2];
#pragma unroll
      for (int kk = 0; kk < 2; ++kk) { f32x4 a4 = (f32x4){0.f, 0.f, 0.f, 0.f};
#pragma unroll
        for (int ks = 0; ks < 8; ++ks) { const bf16x8 kf = *(const LAS bf16x8*)(Ks + (kk * 16 + fr) * 272 + ks * 32 + fq * 8); a4 = __builtin_amdgcn_mfma_f32_16x16x32_bf16(kf, *(const LAS bf16x8*)(qsp + ks * 32), a4, 0, 0, 0); }
        s[kk] = a4; }
#pragma unroll
      for (int kk = 0; kk < 2; ++kk)
#pragma unroll
        for (int j = 0; j < 4; ++j) { const int si = spos + kk * 16 + 4 * fq + j; float D;
          const int d = tq - si;
          if (kctx) D = fast_exp2((float)(256 + d) * lgf) + fast_exp2((float)(2048 - d) * lgb);
          else { const float e = fast_exp2((float)(d < 0 ? -d : d) * (d > 0 ? lgf : lgb)); D = d == 0 ? 2.0f : e; }
          s[kk][j] *= D; }
      u32x4 w; w.x = pk_bf16(s[0][0], s[0][1]); w.y = pk_bf16(s[0][2], s[0][3]); w.z = pk_bf16(s[1][0], s[1][1]); w.w = pk_bf16(s[1][2], s[1][3]);
      const bf16x8 pf = __builtin_bit_cast(bf16x8, w);
      { const LAS bf16_t* vb = Vs + fr * 48 + 8 * fq;
        bf16x8 va = *(const LAS bf16x8*)(vb), vc = *(const LAS bf16x8*)(vb + 16 * 48);
#pragma unroll
        for (int et = 0; et < 32; et += 2) {
          O[et] = __builtin_amdgcn_mfma_f32_16x16x32_bf16(va, pf, O[et], 0, 0, 0);
          if (et + 2 < 32) va = *(const LAS bf16x8*)(vb + (et + 2) * 16 * 48);
          O[et + 1] = __builtin_amdgcn_mfma_f32_16x16x32_bf16(vc, pf, O[et + 1], 0, 0, 0);
          if (et + 3 < 32) vc = *(const LAS bf16x8*)(vb + (et + 3) * 16 * 48);
        } }
    }
    float sm = 0.f;
#pragma unroll
    for (int et = 0; et < 32; ++et) sm += (O[et][0] + O[et][1]) + (O[et][2] + O[et][3]);
    sm += __shfl_xor(sm, 16); sm += __shfl_xor(sm, 32);
    const float mean = sm * (1.0f / 512.0f); float q = 0.f;
#pragma unroll
    for (int et = 0; et < 32; ++et) { const f32x4 d = O[et] - mean; q += (d[0] * d[0] + d[1] * d[1]) + (d[2] * d[2] + d[3] * d[3]); }
    q += __shfl_xor(q, 16); q += __shfl_xor(q, 32);
    const float rstd = rsqrtf(q * (1.0f / 512.0f) + LN_EPS);
    bf16_t* gp = G + (size_t)(qrow0 + wid * 16 + fr) * 2048 + h * 512 + 4 * fq;
#pragma unroll
    for (int et = 0; et < 32; ++et) { const f32x4 gg = ld_bf4(gp + et * 16); const f32x4 gw = *(const f32x4*)(gn + h * 512 + et * 16 + 4 * fq); st_bf4(gp + et * 16, (O[et] - mean) * rstd * gw * gg); }
  }
  __builtin_amdgcn_s_setprio(0);
}

template <int SEQ>
DI void hy_conv_channel(const Params& p, int zz, int tx, LAS unsigned char* lds, int c, int tokbase, const bf16_t* Rrow) {
  constexpr int WROW = ((SEQ + 448 + 127) / 128) * 128, NB = SEQ / 32, NG = SEQ / 128, CAW = 2 * SEQ, CAS = CAW + 16;
#define WOFF(b_) ((b_) * WROW + ((b_) & 3) * 8)
  const bf16_t* UT = (const bf16_t*)((p.ws + zz) + WS_BIG); bf16_t* ZT = (bf16_t*)((p.ws + zz) + WS_BIG + 3 * SZ_TOK1K);
  LAS bf16_t* CA = (LAS bf16_t*)lds;
  LAS bf16_t* WT = (LAS bf16_t*)(lds + 65792);
  LAS bf16_t* X0 = (LAS bf16_t*)(lds + 107008);
  const int tid = tx, wid = tid >> 6, lane = tid & 63;
  __syncthreads();
  for (int ch = tid; ch < CAW / 8; ch += NTHR) {
    const u32x4 d0 = *(const u32x4*)(Rrow + ch * 8), d1 = *(const u32x4*)(Rrow + ch * 8 + 8);
    const unsigned D[8] = {d0.x, d0.y, d0.z, d0.w, d1.x, d1.y, d1.z, d1.w};
#pragma unroll
    for (int a = 0; a < 8; ++a) { u32x4 w;
      if ((a & 1) == 0) { w.x = D[a / 2]; w.y = D[a / 2 + 1]; w.z = D[a / 2 + 2]; w.w = D[a / 2 + 3]; }
      else { const int j = a / 2; w.x = __builtin_amdgcn_alignbit(D[j + 1], D[j], 16); w.y = __builtin_amdgcn_alignbit(D[j + 2], D[j + 1], 16); w.z = __builtin_amdgcn_alignbit(D[j + 3], D[j + 2], 16); w.w = __builtin_amdgcn_alignbit(D[j + 4], D[j + 3], 16); }
      *(LAS u32x4*)(CA + a * CAS + ch * 8) = w; }
  }
  for (int idx = tid; idx < 8 * 448; idx += NTHR) { const int b = idx / 448, e = idx - b * 448; WT[WOFF(b) + (e < 224 ? e : SEQ + e)] = 0; }
  const float* cw = p.in[zz + 17]; const float* cb = p.in[zz + 18];
  float w0[3], w1[3], w2[3], bs[3];
#pragma unroll
  for (int pt = 0; pt < 3; ++pt) { const int cc = pt * 1024 + c; w0[pt] = cw[cc]; w1[pt] = cw[3072 + cc]; w2[pt] = cw[6144 + cc]; bs[pt] = cb[cc]; }
  for (int idx = tid; idx < SEQ; idx += NTHR) {
    const int b = idx / (SEQ / 8), ch = idx - b * (SEQ / 8), t0 = ch * 8; const size_t tok = (size_t)tokbase + (size_t)b * SEQ + t0;
    float r[3][8];
#pragma unroll
    for (int pt = 0; pt < 3; ++pt) { const bf16_t* src = UT + (size_t)(pt * 1024 + c) * MT + tok; const u32x4 v = *(const u32x4*)src;
      float in[10]; in[0] = t0 > 0 ? bf2f(src[-1]) : 0.f; in[9] = t0 + 8 < SEQ ? bf2f(src[8]) : 0.f;
      in[1] = __uint_as_float(v.x << 16); in[2] = __uint_as_float(v.x & 0xffff0000u); in[3] = __uint_as_float(v.y << 16); in[4] = __uint_as_float(v.y & 0xffff0000u);
      in[5] = __uint_as_float(v.z << 16); in[6] = __uint_as_float(v.z & 0xffff0000u); in[7] = __uint_as_float(v.w << 16); in[8] = __uint_as_float(v.w & 0xffff0000u);
#pragma unroll
      for (int k = 0; k < 8; ++k) r[pt][k] = w0[pt] * in[k] + w1[pt] * in[k + 1] + w2[pt] * in[k + 2] + bs[pt]; }
    u32x4 wv, xv;
    wv.x = pk_bf16(r[1][0] * r[2][0], r[1][1] * r[2][1]); wv.y = pk_bf16(r[1][2] * r[2][2], r[1][3] * r[2][3]); wv.z = pk_bf16(r[1][4] * r[2][4], r[1][5] * r[2][5]); wv.w = pk_bf16(r[1][6] * r[2][6], r[1][7] * r[2][7]);
    xv.x = pk_bf16(r[0][0], r[0][1]); xv.y = pk_bf16(r[0][2], r[0][3]); xv.z = pk_bf16(r[0][4], r[0][5]); xv.w = pk_bf16(r[0][6], r[0][7]);
    *(LAS u32x4*)(WT + WOFF(b) + 224 + t0) = wv; *(LAS u32x4*)(X0 + b * SEQ + t0) = xv;
  }
  __syncthreads();
  if (2 * wid < NG) {
    const int i = lane & 31, hh = lane >> 5, Iq = i >> 3, bb = i & 7;
    f32x16 acc0, acc1;
#pragma unroll
    for (int r = 0; r < 16; ++r) { acc0[r] = 0.f; acc1[r] = 0.f; }
    for (int d = 8 * wid - (NB - 1); d <= 8 * wid + 7; ++d) {
#pragma unroll
      for (int ks = 0; ks < 2; ++ks) {
        const int x0i = SEQ - (32 * d + i - 16 * ks - 8 * hh), a = x0i & 7;
        const bf16x8 A = *(const LAS bf16x8*)(CA + a * CAS + (x0i - a));
        const int jtok = 224 + (8 * wid + Iq - d) * 32 + 16 * ks + 8 * hh;
        const bf16x8 B0 = *(const LAS bf16x8*)(WT + WOFF(bb) + jtok), B1 = *(const LAS bf16x8*)(WT + WOFF(bb) + jtok + 128);
        acc0 = __builtin_amdgcn_mfma_f32_32x32x16_bf16(A, B0, acc0, 0, 0, 0);
        acc1 = __builtin_amdgcn_mfma_f32_32x32x16_bf16(A, B1, acc1, 0, 0, 0);
      }
    }
#pragma unroll
    for (int g = 0; g < 2; ++g)
#pragma unroll
      for (int rg = 0; rg < 4; ++rg) {
        const int t0 = (8 * wid + 4 * g + Iq) * 32 + 8 * rg + 4 * hh;
        const u32x2 xw = *(const LAS u32x2*)(X0 + bb * SEQ + t0);
        const f32x4 xf = (f32x4){__uint_as_float(xw.x << 16), __uint_as_float(xw.x & 0xffff0000u), __uint_as_float(xw.y << 16), __uint_as_float(xw.y & 0xffff0000u)};
        f32x4 y; if (g == 0) y = (f32x4){acc0[4 * rg], acc0[4 * rg + 1], acc0[4 * rg + 2], acc0[4 * rg + 3]}; else y = (f32x4){acc1[4 * rg], acc1[4 * rg + 1], acc1[4 * rg + 2], acc1[4 * rg + 3]};
        st_bf4(ZT + (size_t)c * MT + tokbase + bb * SEQ + t0, y * xf);
      }
  }
}
#undef WOFF

DI void hy_conv_phase(const Params& p, int zz, int tx, LAS unsigned char* lds) {
  const bf16_t* RL = (const bf16_t*)((p.ws + zz) + WS_HYRL); const bf16_t* RC = (const bf16_t*)((p.ws + zz) + WS_HYRC);
  for (int c = blockIdx.x; c < 1024; c += gridDim.x) {
    hy_conv_channel<2048>(p, zz, tx, lds, c, 0, RL + (size_t)c * RL_STRIDE);
    hy_conv_channel<256>(p, zz, tx, lds, c, ML, RC + (size_t)c * RC_STRIDE);
  }
}


DI void post_ln(const Params& p, int zz, int tx, LAS unsigned char* lds, int pm, int pn, int l, int lnk, bool final) {
  unsigned char* ws = p.ws + zz;
  float* X = (float*)(ws + WS_X); bf16_t* H = (bf16_t*)(ws + WS_H);
  const float* lmods = (const float*)(ws + WS_MODS) + (size_t)l * 9 * 9216;
  const float* lg = p.in[zz + 6] + (l * 3 + lnk) * 1024; const float* lb = p.in[zz + 7] + (l * 3 + lnk) * 1024;
  const float* sh = lnk == 0 ? lmods + 3 * 1024 : (lnk == 1 ? lmods + 6 * 1024 : lmods + 9 * 9216); const float* sc = sh + 1024;
  unsigned long long* xbuf = (unsigned long long*)(ws + WS_XBUF); unsigned* cnt = (unsigned*)(ws + WS_CNT) + (size_t)((l * 3 + lnk) * 72 + pm) * 64;
  LAS f32x2* S = (LAS f32x2*)lds;
  const int wid = tx >> 6, lane = tx & 63, lgp = lane >> 4, li = lane & 15, mb = pm < 64 ? (pm >> 3) : 8;
  asm volatile("s_waitcnt vmcnt(0)" ::: "memory");
  __syncthreads();
  const size_t tile0 = (size_t)(pm * 256) * DM + pn * 256 + li * 4;
#pragma unroll 1
  for (int hb = 0; hb < 2; ++hb) {
    f32x4 v[4][4];
#pragma unroll
    for (int i4 = 0; i4 < 4; ++i4) { const float* zr = X + tile0 + (size_t)(wid * 32 + (hb * 4 + i4) * 4 + lgp) * DM;
#pragma unroll
      for (int k = 0; k < 4; ++k) v[i4][k] = *(const f32x4*)(zr + k * 64); }
#pragma unroll
    for (int i4 = 0; i4 < 4; ++i4) {
      const int r = wid * 32 + (hb * 4 + i4) * 4 + lgp; float s = 0.f;
#pragma unroll
      for (int k = 0; k < 4; ++k) s += (v[i4][k][0] + v[i4][k][1]) + (v[i4][k][2] + v[i4][k][3]);
      s += __shfl_xor(s, 1); s += __shfl_xor(s, 2); s += __shfl_xor(s, 4); s += __shfl_xor(s, 8);
      const float mt = s * (1.0f / 256.0f); float q = 0.f;
#pragma unroll
      for (int k = 0; k < 4; ++k) { const f32x4 d = v[i4][k] - mt; q += (d[0] * d[0] + d[1] * d[1]) + (d[2] * d[2] + d[3] * d[3]); }
      q += __shfl_xor(q, 1); q += __shfl_xor(q, 2); q += __shfl_xor(q, 4); q += __shfl_xor(q, 8);
      if (li == 0) __hip_atomic_store(xbuf + ((size_t)(pm * 256 + r) * 4 + pn), ((unsigned long long)__float_as_uint(q) << 32) | __float_as_uint(mt), __ATOMIC_RELAXED, __HIP_MEMORY_SCOPE_AGENT);
    }
  }
  asm volatile("s_waitcnt vmcnt(0)" ::: "memory");
  if (lane == 0) __hip_atomic_fetch_add(cnt, 1u, __ATOMIC_RELAXED, __HIP_MEMORY_SCOPE_AGENT);
  if (wid == 0) {
    const unsigned long long t0 = __builtin_amdgcn_s_memrealtime();
    for (;;) {
      if ((unsigned)__builtin_amdgcn_readfirstlane(__hip_atomic_load(cnt, __ATOMIC_RELAXED, __HIP_MEMORY_SCOPE_AGENT)) >= 32u) break;
      if (__builtin_amdgcn_s_memrealtime() - t0 > 2000000ull) break;
      __builtin_amdgcn_s_sleep(2);
    }
  }
  __syncthreads();
  if (tx < 256) {
    const unsigned long long* slot = xbuf + (size_t)(pm * 256 + tx) * 4; float mt[4], m2[4]; float ms = 0.f;
#pragma unroll
    for (int t = 0; t < 4; ++t) { const unsigned long long w = __hip_atomic_load(slot + t, __ATOMIC_RELAXED, __HIP_MEMORY_SCOPE_AGENT); mt[t] = __uint_as_float((unsigned)w); m2[t] = __uint_as_float((unsigned)(w >> 32)); ms += mt[t]; }
    const float mean = ms * 0.25f; float q = 0.f;
#pragma unroll
    for (int t = 0; t < 4; ++t) { const float dm = mt[t] - mean; q += m2[t] + 256.0f * dm * dm; }
    S[tx] = (f32x2){mean, rsqrtf(q * (1.0f / 1024.0f) + LN_EPS)};
  }
  __syncthreads();
  f32x4 g4[4], b4[4], sc4[4], sh4[4];
#pragma unroll
  for (int k = 0; k < 4; ++k) { const int col = pn * 256 + li * 4 + k * 64; g4[k] = *(const f32x4*)(lg + col); b4[k] = *(const f32x4*)(lb + col);
    if (!final) { sc4[k] = *(const f32x4*)(sc + (size_t)mb * 9216 + col) + 1.0f; sh4[k] = *(const f32x4*)(sh + (size_t)mb * 9216 + col); } else { sc4[k] = g4[k]; sh4[k] = g4[k]; } }
#pragma unroll 1
  for (int hb = 0; hb < 2; ++hb) {
    f32x4 v[4][4];
#pragma unroll
    for (int i4 = 0; i4 < 4; ++i4) { const float* zr = X + tile0 + (size_t)(wid * 32 + (hb * 4 + i4) * 4 + lgp) * DM;
#pragma unroll
      for (int k = 0; k < 4; ++k) v[i4][k] = *(const f32x4*)(zr + k * 64); }
#pragma unroll
    for (int i4 = 0; i4 < 4; ++i4) {
      const int r = wid * 32 + (hb * 4 + i4) * 4 + lgp; const size_t off = tile0 + (size_t)r * DM; const f32x2 sr = S[r];
#pragma unroll
      for (int k = 0; k < 4; ++k) { const f32x4 y = (v[i4][k] - sr.x) * sr.y * g4[k] + b4[k];
        if (final) *(f32x4*)(p.out + zz + off + k * 64) = y;
        else { *(f32x4*)(X + off + k * 64) = y; st_bf4(H + off + k * 64, y * sc4[k] + sh4[k]); } }
    }
  }
  __syncthreads();
}

#define XB_TMO      128
#define XB_XCNT(j)  (256  + 64 * (j))
#define XB_XSUB(j)  (1280 + 64 * (j))
#define XB_XGEN(j)  (2304 + 64 * (j))
#define XB_TOP      3328
#define XB_TOPGEN   3392
#define XCD_BAR_WORDS 3456
#define XB_SPIN_CAP (1u << 18)
DI unsigned xb_ld(unsigned* p)              { return __hip_atomic_load(p, __ATOMIC_RELAXED, __HIP_MEMORY_SCOPE_AGENT); }
DI unsigned xb_add(unsigned* p, unsigned v) { return __hip_atomic_fetch_add(p, v, __ATOMIC_RELAXED, __HIP_MEMORY_SCOPE_AGENT); }
DI unsigned xb_xcc_id() { return (unsigned)__builtin_amdgcn_s_getreg((3 << 11) | 20) & 0xFu; }
#define XB_SPIN(cond, bar) do { unsigned _sp = 0; while (cond) { __builtin_amdgcn_s_sleep(1); \
    if ((++_sp & 255u) == 0u) { if (xb_ld(&(bar)[XB_TMO])) break; if (_sp > XB_SPIN_CAP) { atomicAdd(&(bar)[XB_TMO], 1u); break; } } } } while (0)
struct XcdBarrier { unsigned* bar; unsigned x; volatile LAS unsigned* st; };
DI XcdBarrier xcd_barrier_post(unsigned* bar, volatile LAS unsigned* st) {
  XcdBarrier b; b.bar = bar; b.x = xb_xcc_id(); b.st = st;
  if (threadIdx.x == 0) (void)xb_add(&bar[XB_XCNT(b.x)], 1u);
  return b;
}
DI void xcd_barrier_complete(unsigned* bar, unsigned x, unsigned& nloc, unsigned& nx) {
  const unsigned G = gridDim.x * gridDim.y * gridDim.z;
  unsigned sum, cnt, mine, sp = 0u;
  for (;;) {
    sum = 0u; cnt = 0u; mine = 0u;
#pragma unroll
    for (unsigned j = 0; j < 16; ++j) { const unsigned c = xb_ld(&bar[XB_XCNT(j)]); sum += c; cnt += (c > 0u) ? 1u : 0u; mine = (j == x) ? c : mine; }
    if (sum == G) break;
    __builtin_amdgcn_s_sleep(1);
    if ((++sp & 255u) == 0u) { if (xb_ld(&bar[XB_TMO])) break; if (sp > XB_SPIN_CAP) { atomicAdd(&bar[XB_TMO], 1u); break; } }
  }
  nloc = mine > 0u ? mine : 1u; nx = cnt > 0u ? cnt : 1u;
}
DI void xcd_barrier(const XcdBarrier& b) {
  asm volatile("s_waitcnt vmcnt(0)" ::: "memory");
  __syncthreads();
  if (threadIdx.x == 0) {
    unsigned* bar = b.bar;
    __builtin_amdgcn_s_waitcnt(0);
    unsigned nloc = b.st[0], nx = b.st[1];
    if (nloc == 0u) { xcd_barrier_complete(bar, b.x, nloc, nx); b.st[0] = nloc; b.st[1] = nx; }
    const unsigned old = xb_add(&bar[XB_XSUB(b.x)], 1u);
    const unsigned gen = old / nloc;
    if (old + 1u == (gen + 1u) * nloc) {
      __builtin_amdgcn_fence(__ATOMIC_RELEASE, "agent");
      asm volatile("s_waitcnt vmcnt(0)" ::: "memory");
      const unsigned og = xb_add(&bar[XB_TOP], 1u);
      const unsigned tg = og / nx;
      if (og + 1u == (tg + 1u) * nx) xb_add(&bar[XB_TOPGEN], 1u);
      else XB_SPIN(xb_ld(&bar[XB_TOPGEN]) == tg, bar);
      __builtin_amdgcn_fence(__ATOMIC_ACQUIRE, "agent");
      xb_add(&bar[XB_XGEN(b.x)], 1u);
      asm volatile("s_waitcnt vmcnt(0)" ::: "memory");
    } else {
      XB_SPIN(xb_ld(&bar[XB_XGEN(b.x)]) == gen, bar);
      __builtin_amdgcn_fence(__ATOMIC_ACQUIRE, "agent");
      asm volatile("s_waitcnt vmcnt(0)" ::: "memory");
    }
  }
  __syncthreads();
}

#ifndef PHMASK
#define PHMASK 0xffff
#endif
#define HAS(x) (((PHMASK) >> (x)) & 1)
#ifndef FUSE_LN
#define FUSE_LN 0
#endif
__global__ void __launch_bounds__(NTHR) fwd_kernel(Params p) {
  extern __shared__ __attribute__((aligned(16))) unsigned char lds_raw[];
  LAS unsigned char* lds = (LAS unsigned char*)lds_raw;
  cg::grid_group grid = cg::this_grid();
  if (threadIdx.x < 4) ((LAS unsigned*)(lds + LDS_BYTES - 16))[threadIdx.x] = 0u;
  __syncthreads();
  const XcdBarrier xb = xcd_barrier_post((unsigned*)(p.ws + WS_BAR), (volatile LAS unsigned*)(lds + LDS_BYTES - 16));
  const int G = (int)gridDim.x;
  const bool fuse = FUSE_LN && (G % 4 == 0);
  int nbar = 0; bool started = false;
  for (int ph = p.ph_lo; ph < p.ph_hi; ++ph) {
    const int l = ph >= 2 ? (ph - 2) / 11 : 0, sub = ph >= 2 ? (ph - 2) % 11 : -1;
    if (sub == 5 && l != 1) continue;
    if (fuse && (sub == 2 || sub == 7 || sub == 10)) continue;
    if (started) { if (p.ph_lo < 0) grid.sync();
      xcd_barrier(xb); ++nbar; }
    started = true;
#ifdef TPROBE
    if (blockIdx.x == 0 && threadIdx.x == 0) {
      const unsigned tnow = (unsigned)__builtin_amdgcn_s_memrealtime();
      volatile unsigned* cat = (volatile unsigned*)(p.ws + WS_CAT);
      const unsigned pc = cat[33];
      if (pc != 0u) cat[pc - 1u] += tnow - cat[32];
      cat[32] = tnow;
      cat[33] = 1u + (unsigned)(ph == 0 ? 0 : (ph == 1 ? 1 : (sub == 0 || sub == 8 ? 2 : (sub == 1 || sub == 9 ? 3 : (sub == 2 || sub == 7 || sub == 10 ? 4 : (sub == 3 ? 5 : (sub == 4 ? 6 + l : (sub == 5 ? 10 : 11))))))));
    }
#endif
    int zz = 0; asm volatile("" : "+s"(zz));
    int tx = threadIdx.x; asm volatile("" : "+v"(tx));
    unsigned char* ws = p.ws + zz;
    const float* mods = (const float*)(ws + WS_MODS);
    if (HAS(0) && ph == 0) {
      if (G - 1 - (int)blockIdx.x < 144) mods_prepare(p, zz, tx, lds);
      for (int u = G - 1 - (int)blockIdx.x; u < 144; u += G) mods_unit(p, zz, tx, lds, u);
      for (int u = blockIdx.x; u < 256; u += G) filter_unit(p, zz, tx, lds, u);
      { const int w2 = (G >= 256) ? (int)blockIdx.x - 80 : (int)blockIdx.x; for (int u = 256 + w2; w2 >= 0 && u < 288; u += G) filter_unit(p, zz, tx, lds, u); }
      conv_units(p, zz, tx, 0, G > 64 ? p.jobs[6 + zz].ustart : p.nconv_units, (int)blockIdx.x, G);
      rope_tables(p, zz, tx);
      continue;
    }
    if (HAS(1) && ph == 1) { init_phase(p, zz, tx); continue; }
    const int Mfull = l < 2 ? MT : ML, Mpre = l < 3 ? MT : ML;
    const float* lmods = mods + (size_t)l * 9 * 9216;
    const bf16_t* wl = (const bf16_t*)(ws + (size_t)l * LAYER_W);
    bool is_gemm = false; pg8::Gemm g{nullptr, nullptr, 0, 0, 0, 0, 1 << 20, 0}; int e_mode = 0, e_lnk = -1, e_fused = 0, e_final = 0; float e_coef = 0.f;
    bf16_t* Hb = (bf16_t*)(ws + WS_H); bf16_t* BIG = (bf16_t*)(ws + WS_BIG); float* X = (float*)(ws + WS_X);
    switch (sub) {
      case 0: is_gemm = true; g = {Hb, wl, Mpre, 2 * DFF, DM, DM, 1 << 20, 0}; e_mode = EPI_SWIGLU; break;
      case 1: is_gemm = true; g = {BIG, wl + (size_t)2 * DFF * DM, Mpre, DM, DFF, DFF, 1 << 20, 0}; e_mode = EPI_RES; e_coef = 0.5f; e_lnk = 0; break;
      case 2: if (HAS(2)) ln_phase(p, zz, tx, Mpre, p.in[zz + 6] + (l * 3 + 0) * 1024, p.in[zz + 7] + (l * 3 + 0) * 1024, lmods + 3 * 1024, lmods + 4 * 1024, false, Mpre == MT ? (const float*)((unsigned char*)BIG + 5 * SZ_TOK1K) : nullptr, lmods + 8 * 9216 + 2 * 1024); break;
      case 3: is_gemm = true;
        if (l == 0) { g = {Hb, (const bf16_t*)(ws + W_DA_QKV), Mpre, 3072, DM, DM, 1 << 20, 0}; e_mode = EPI_DA; }
        else if (l == 1) { g = {Hb, (const bf16_t*)(ws + W_HY_IN), Mpre, 3072, DM, DM, 1 << 20, 0}; e_mode = EPI_HY; }
        else if (l == 2) { g = {Hb, (const bf16_t*)(ws + W_RT_IN), Mpre, 6144, DM, DM, 1 << 20, 0}; e_mode = EPI_RT; }
        else { g = {Hb, (const bf16_t*)(ws + W_SC_IN), Mpre, 3072, DM, DM, 1 << 20, 0}; e_mode = EPI_SC; }
        break;
      case 4:
        if (HAS(4) && l == 0) da_attn_phase(p, zz, tx, lds); else if (HAS(5) && l == 1) hy_conv_phase(p, zz, tx, lds); else if (HAS(6) && l == 2) rt_attn_phase(p, zz, tx, lds); else if (HAS(7) && l == 3) sc_core_phase(p, zz, tx);
        break;
      case 5: if (HAS(8) && l == 1) hy_transpose_phase(p, zz, tx, lds); break;
      case 6: is_gemm = true; e_mode = EPI_RES; e_coef = 1.0f; e_lnk = 1;
        if (l == 0) g = {Hb, (const bf16_t*)(ws + W_DA_O), Mfull, DM, DM, DM, 1 << 20, 0};
        else if (l == 1) g = {Hb, (const bf16_t*)(ws + W_HY_O), Mfull, DM, DM, DM, 1 << 20, 0};
        else if (l == 2) g = {(const bf16_t*)((unsigned char*)BIG + 4 * SZ_TOK1K), (const bf16_t*)(ws + W_RT_O), Mfull, DM, 2048, 2048, 1 << 20, 0};
        else g = {Hb, (const bf16_t*)(ws + W_SC_O), Mfull, DM, DM, DM, 1 << 20, 0};
        break;
      case 7: if (HAS(2)) ln_phase(p, zz, tx, Mfull, p.in[zz + 6] + (l * 3 + 1) * 1024, p.in[zz + 7] + (l * 3 + 1) * 1024, lmods + 6 * 1024, lmods + 7 * 1024, false, nullptr, nullptr); break;
      case 8: is_gemm = true; g = {Hb, wl + (size_t)(2 * DFF * DM + DM * DFF), Mfull, 2 * DFF, DM, DM, 1 << 20, 0}; e_mode = EPI_SWIGLU; break;
      case 9: is_gemm = true; g = {BIG, wl + (size_t)(2 * DFF * DM + DM * DFF + 2 * DFF * DM), Mfull, DM, DFF, DFF, 1 << 20, 0}; e_mode = EPI_RES; e_coef = 0.5f; e_lnk = 2; break;
      default:
        if (HAS(2)) ln_phase(p, zz, tx, Mfull, p.in[zz + 6] + (l * 3 + 2) * 1024, p.in[zz + 7] + (l * 3 + 2) * 1024, lmods + 9 * 9216, lmods + 9 * 9216 + 1024, l == 3, Mfull == MT ? (const float*)((unsigned char*)BIG + 5 * SZ_TOK1K) : nullptr, lmods + 8 * 9216 + 8 * 1024); break;
    }
    if (HAS(3) && is_gemm) {
      int c = (int)blockIdx.x, nr = 1;
      if (fuse && e_lnk >= 0) {
        e_fused = 1; e_final = (l == 3 && e_lnk == 2) ? 1 : 0;
        if (G % 8 == 0) c = (c % 8) * (G / 8) + c / 8;
        nr = (g.M / 64 + G - 1) / G;
      }
      const bool ksplit = !e_fused && e_mode == EPI_RES && g.K == DFF && g.M == MT;
      if (ksplit) { nr = 2; g.M = ML; }
      for (int r = 0; r < nr; ++r) {
        if (ksplit && r == 1 && (int)blockIdx.x >= 64 && G > 64) {
          const int w = 2 * l + (sub == 9 ? 1 : 0);
          int ja = 0, jb = 0, jc = 0, jd = 0;
          if (w == 0) { ja = 6; jb = 9; } else if (w == 1) { ja = 9; jb = 12; } else if (w == 2) { ja = 12; jb = 15; } else if (w == 3) { ja = 15; jb = 18; jc = 21; jd = 24; } else if (w == 4) { ja = 18; jb = 21; }
          if (jb > ja) conv_units(p, zz, tx, p.jobs[ja + zz].ustart, p.jobs[jb + zz].ustart, (int)blockIdx.x - 64, G - 64);
          if (jd > jc) conv_units(p, zz, tx, p.jobs[jc + zz].ustart, p.nconv_units, (int)blockIdx.x - 64, G - 64);
        }
        if (ksplit && r == 1) { g.A = g.A + (size_t)ML * DFF; g.M = 2 * MC; g.K = DFF / 2; g.msplit = MC / 256; g.koff = DFF / 2; e_mode = EPI_PART; }
        pg8::StaticOrder S; S.init(g.M, g.N, G, c); S.panel = e_fused ? r : -1; const Epi E{e_mode, l, e_lnk, e_fused, e_final, zz, e_coef, ws}; pg8::gemm_phase<Epi>(p, tx, lds, g, S, E);
        if (e_fused) { const int L = r * G + c; if (L < (g.M / 64)) post_ln(p, zz, tx, lds, L >> 2, L & 3, l, e_lnk, e_final != 0); }
      }
    }
  }
#ifdef TPROBE
  if (blockIdx.x == 0 && threadIdx.x == 0) {
    const unsigned long long t0 = __builtin_amdgcn_s_memrealtime(); const unsigned long long w = ((const unsigned*)(p.ws + WS_CAT))[TPROBE_A];
    while (__builtin_amdgcn_s_memrealtime() - t0 < w) __builtin_amdgcn_s_sleep(8);
  }
#endif
}

extern "C" void kernel_launch(void* const* d_in, const int* in_sizes, int n_in, void* d_out, int out_size, void* d_ws, size_t ws_size, hipStream_t stream) {
  static int grid = 0;
  if (grid == 0) {
    if (n_in != 35 || ws_size < WS_END) { fprintf(stderr, "kernel_launch: need 35 inputs and %zu bytes of workspace; got %d, %zu\n", (size_t)WS_END, n_in, ws_size); grid = -1; return; }
    int dev = 0, cus = 0, per_cu = 0;
    hipGetDevice(&dev); hipDeviceGetAttribute(&cus, hipDeviceAttributeMultiprocessorCount, dev);
    if (hipFuncSetAttribute((const void*)fwd_kernel, hipFuncAttributeMaxDynamicSharedMemorySize, LDS_BYTES) != hipSuccess) { fprintf(stderr, "kernel_launch: hipFuncSetAttribute failed\n"); grid = -1; return; }
    if (hipOccupancyMaxActiveBlocksPerMultiprocessor(&per_cu, (const void*)fwd_kernel, NTHR, LDS_BYTES) != hipSuccess || per_cu < 1) { fprintf(stderr, "kernel_launch: occupancy query gave %d\n", per_cu); per_cu = 1; }
    (void)hipGetLastError();
    grid = cus * per_cu;
    fprintf(stderr, "kernel_launch: grid %d (%d CUs x %d)\n", grid, cus, per_cu);
  }
  if (grid < 0) return;
  Params p{};
  for (int i = 0; i < 35; ++i) p.in[i] = (const float*)d_in[i];
  p.out = (float*)d_out; p.ws = (unsigned char*)d_ws;
  unsigned char* ws = (unsigned char*)d_ws;
  int nj = 0, ustart = 0;
  auto add = [&](const float* src, size_t dst_off, int K, int N, int kind) { WJob& j = p.jobs[nj++]; j.src = src; j.dst = (bf16_t*)(ws + dst_off); j.K = K; j.N = N; j.srcN = N; j.kind = kind; j.ustart = ustart; j.pad = 0; ustart += (N / 32) * (K / 256); };
  const int mix_in_idx[4] = {12, 16, 28, 32}, mix_o_idx[4] = {13, 27, 31, 34};
  const size_t mix_in_off[4] = {W_DA_QKV, W_HY_IN, W_RT_IN, W_SC_IN}, mix_o_off[4] = {W_DA_O, W_HY_O, W_RT_O, W_SC_O};
  const int mix_in_n[4] = {3072, 3072, 6144, 3072}, mix_in_kind[4] = {2, 0, 5, 3}, mix_o_k[4] = {DM, DM, 2048, DM};
  for (int l = 0; l < 4; ++l) {
    const size_t base = (size_t)l * LAYER_W;
    add(p.in[8] + (size_t)l * DM * 2 * DFF, base, DM, 2 * DFF, 1);
    add(p.in[9] + (size_t)l * DFF * DM, base + SZ_WI, DFF, DM, 4);
    add(p.in[10] + (size_t)l * DM * 2 * DFF, base + SZ_WI + SZ_WO, DM, 2 * DFF, 1);
    add(p.in[11] + (size_t)l * DFF * DM, base + 2 * SZ_WI + SZ_WO, DFF, DM, 4);
    add(p.in[mix_in_idx[l]], mix_in_off[l], DM, mix_in_n[l], mix_in_kind[l]);
    add(p.in[mix_o_idx[l]], mix_o_off[l], mix_o_k[l], DM, 4);
  }
  p.nconv_units = ustart; p.ph_lo = 0; p.ph_hi = 2 + 4 * 11; p.pad = 0;
  if (hipMemsetAsync(ws + WS_BAR, 0, ZERO_BYTES + 256, stream) != hipSuccess) { fprintf(stderr, "kernel_launch: memset failed\n"); return; }
  void* args[] = {&p};
  hipError_t e = hipLaunchCooperativeKernel((const void*)fwd_kernel, dim3(grid), dim3(NTHR), args, LDS_BYTES, stream);
  if (e != hipSuccess) fprintf(stderr, "kernel_launch: cooperative launch failed: %s (grid %d)\n", hipGetErrorString(e), grid);
}
```

```cpp
#include <hip/hip_runtime.h>
#include <hip/hip_cooperative_groups.h>
#include <cstdio>
namespace cg = cooperative_groups;

#define LAS __attribute__((address_space(3)))
#define DI __device__ __forceinline__
typedef unsigned short bf16_t;
typedef short bf16x8 __attribute__((ext_vector_type(8)));
typedef short s16x4 __attribute__((ext_vector_type(4)));
typedef float f32x4 __attribute__((ext_vector_type(4)));
typedef float f32x2 __attribute__((ext_vector_type(2)));
typedef float f32x16 __attribute__((ext_vector_type(16)));
typedef unsigned u32x4 __attribute__((ext_vector_type(4)));
typedef unsigned u32x2 __attribute__((ext_vector_type(2)));

constexpr int ML = 16384, MC = 2048, MT = 18432, DM = 1024, DFF = 2816;
constexpr int NTHR = 512;
constexpr int LDS_BYTES = 140 * 1024;
constexpr float ALPHA = 1.681792830507429f;
constexpr float LN_EPS = 1e-5f;
constexpr float LOG2E = 1.4426950408889634f;

constexpr size_t al256(size_t x) { return (x + 255) & ~(size_t)255; }
constexpr size_t SZ_WI = (size_t)2 * DFF * DM * 2, SZ_WO = (size_t)DM * DFF * 2;
constexpr size_t LAYER_W = 2 * (SZ_WI + SZ_WO);
constexpr size_t WS_WMIX = 4 * LAYER_W;
constexpr size_t W_DA_QKV = WS_WMIX, W_DA_O = W_DA_QKV + (size_t)3072 * 1024 * 2, W_HY_IN = W_DA_O + (size_t)1024 * 1024 * 2,
                 W_HY_O = W_HY_IN + (size_t)3072 * 1024 * 2, W_RT_IN = W_HY_O + (size_t)1024 * 1024 * 2, W_RT_O = W_RT_IN + (size_t)6144 * 1024 * 2,
                 W_SC_IN = W_RT_O + (size_t)1024 * 2048 * 2, W_SC_O = W_SC_IN + (size_t)3072 * 1024 * 2, W_END = W_SC_O + (size_t)1024 * 1024 * 2;
constexpr size_t WS_MODS = al256(W_END);
constexpr size_t WS_ROPE_DA = al256(WS_MODS + (size_t)4 * 9 * 9216 * 4);
constexpr size_t WS_ROPE_RT = al256(WS_ROPE_DA + (size_t)2048 * 32 * 8);
constexpr int RL_STRIDE = 4104, RC_STRIDE = 520;
constexpr size_t WS_HYRL = al256(WS_ROPE_RT + (size_t)2048 * 128 * 8);
constexpr size_t WS_HYRC = al256(WS_HYRL + (size_t)1024 * RL_STRIDE * 2);
constexpr size_t WS_X = al256(WS_HYRC + (size_t)1024 * RC_STRIDE * 2);
constexpr size_t WS_H = al256(WS_X + (size_t)MT * DM * 4);
constexpr size_t WS_BIG = al256(WS_H + (size_t)MT * DM * 2);
constexpr size_t SZ_TOK1K = (size_t)MT * 1024 * 2;
constexpr size_t BIG_BYTES = 6 * SZ_TOK1K;
constexpr size_t WS_XBUF = al256(WS_BIG + BIG_BYTES);
constexpr size_t WS_BAR = al256(WS_XBUF + (size_t)72 * 256 * 4 * 8);
constexpr size_t WS_CNT = WS_BAR + 16384;
constexpr size_t ZERO_BYTES = 16384 + (size_t)12 * 72 * 256;
constexpr size_t WS_CAT = WS_BAR + ZERO_BYTES;
constexpr size_t WS_END = WS_CAT + 256;

struct WJob { const float* src; bf16_t* dst; int K, N, srcN, kind, ustart, pad; };
struct Params {
  const float* in[35];
  float* out;
  unsigned char* ws;
  WJob jobs[24];
  int nconv_units, ph_lo, ph_hi, pad;
};

DI float bf2f(bf16_t h) { return __uint_as_float(((unsigned)h) << 16); }
typedef __bf16 bf16x2_t __attribute__((ext_vector_type(2)));
DI unsigned pk_bf16(float lo, float hi) { const f32x2 v = {lo, hi}; const bf16x2_t b = __builtin_convertvector(v, bf16x2_t); return __builtin_bit_cast(unsigned, b); }
DI bf16_t f2bf(float f) { return (bf16_t)(pk_bf16(f, 0.f) & 0xffffu); }
DI float fast_exp2(float x) { return __builtin_amdgcn_exp2f(x); }
DI float silu_f(float a) { return a * __builtin_amdgcn_rcpf(1.0f + __expf(-a)); }
DI float wave_sum(float v) {
#pragma unroll
  for (int o = 32; o >= 1; o >>= 1) v += __shfl_xor(v, o);
  return v;
}
DI f32x4 ld_bf4(const bf16_t* p) { u32x2 w = *(const u32x2*)p; return (f32x4){__uint_as_float(w.x << 16), __uint_as_float(w.x & 0xffff0000u), __uint_as_float(w.y << 16), __uint_as_float(w.y & 0xffff0000u)}; }
DI void ld_bf8(const bf16_t* p, f32x4& a, f32x4& b) { const u32x4 w = *(const u32x4*)p;
  a = (f32x4){__uint_as_float(w.x << 16), __uint_as_float(w.x & 0xffff0000u), __uint_as_float(w.y << 16), __uint_as_float(w.y & 0xffff0000u)};
  b = (f32x4){__uint_as_float(w.z << 16), __uint_as_float(w.z & 0xffff0000u), __uint_as_float(w.w << 16), __uint_as_float(w.w & 0xffff0000u)}; }
DI void st_bf8(bf16_t* p, f32x4 a, f32x4 b) { u32x4 w; w.x = pk_bf16(a[0], a[1]); w.y = pk_bf16(a[2], a[3]); w.z = pk_bf16(b[0], b[1]); w.w = pk_bf16(b[2], b[3]); *(u32x4*)p = w; }
DI void st_bf4(bf16_t* p, f32x4 v) { u32x2 w; w.x = pk_bf16(v[0], v[1]); w.y = pk_bf16(v[2], v[3]); *(u32x2*)p = w; }

namespace pg8 {
constexpr int BM = 256, BK = 64, HALF = 128, HTB = HALF * BK * 2, STAGE_BYTES = 8 * HTB, NXCD = 8, WGM = 8;
DI int lds_byte(int r, int c) { const int st = (r >> 4) * 2 + (c >> 5), rr = r & 15, cc = c & 31, ob = rr * 64 + cc * 2; return st * 1024 + (ob ^ (((ob >> 9) & 1) << 5)); }
DI void stage_rc(int b, int& R, int& C) { const int st = b / 1024, sb = b % 1024, swz = sb ^ (((sb >> 9) & 1) << 5); R = (st >> 1) * 16 + swz / 64; C = (st & 1) * 32 + (swz % 64) / 2; }
struct Unit { int pm, pn; };
struct Gemm { const bf16_t* A; const bf16_t* Bt; int M, N, K, ld, msplit, koff; };
struct StaticOrder {
  int nM, nN, nwg, G, c, panel;
  DI void init(int M, int N, int G_, int c_) { nM = M / BM; nN = N / BM; nwg = nM * nN; G = G_; c = c_; panel = -1; }
  DI bool next(int i, Unit& u) const {
    if (panel >= 0) { const int L = panel * G + c; if (i > 0 || L >= nwg) return false; u.pm = L >> 2; u.pn = L & 3; return true; }
    const long L = (long)i * G + c; if (L >= nwg) return false;
    int wgid = (int)L; { const int q = nwg / NXCD, r = nwg % NXCD, xcd = wgid % NXCD, off = wgid / NXCD; wgid = (xcd < r ? xcd * (q + 1) : r * (q + 1) + (xcd - r) * q) + off; }
    const int nig = WGM * nN, gid = wgid / nig, fm = gid * WGM, gsz = (nM - fm) < WGM ? (nM - fm) : WGM;
    u.pm = fm + ((wgid % nig) % gsz); u.pn = (wgid % nig) / gsz; return true;
  }
};

template <class Epi>
DI void gemm_phase(const Params& p, int tx, LAS unsigned char* lds, const Gemm g, const StaticOrder& S, const Epi& E) {
  const int tid = tx, wid = __builtin_amdgcn_readfirstlane(tid >> 6), lane = tid & 63, wr = wid >> 2, wc = wid & 3, fr = lane & 15, fq = lane >> 4;
  const int K = g.K, nt = K / BK;
  unsigned voffA[2];
#pragma unroll
  for (int i = 0; i < 2; ++i) { int R, C; stage_rc(tid * 16 + i * 8192, R, C); voffA[i] = (unsigned)(R * g.ld + C) * 2u; }
  const size_t kstep = (size_t)(BK * 2);
  const size_t hstep = (size_t)HALF * g.ld * 2;
  const size_t tstep = 2 * hstep;
  const unsigned ldsw = (unsigned)wid * 1024u;
  const int aoff = lds_byte(wr * 64 + fr, fq * 8), boff = lds_byte(wc * 32 + fr, fq * 8);
#define PG8_SA(b, h) (((b) * 2 + (h)) * HTB)
#define PG8_SB(b, h) ((4 + (b) * 2 + (h)) * HTB)
#define PG8_STAGE(bufoff, gbase) do { _Pragma("unroll") for (int _i = 0; _i < 2; ++_i) \
    __builtin_amdgcn_global_load_lds((const unsigned*)((const char*)(gbase) + voffA[_i]), (LAS unsigned*)(lds + (bufoff) + ldsw + _i * 8192), 16, 0, 0); } while (0)
#define PG8_LDA(dst, b, h) do { _Pragma("unroll") for (int m = 0; m < 4; ++m) _Pragma("unroll") for (int k = 0; k < 2; ++k) dst[m][k] = *(const LAS bf16x8*)(lds + PG8_SA(b, h) + aoff + m * 2048 + k * 1024); } while (0)
#define PG8_LDB(dst, b, h) do { _Pragma("unroll") for (int n = 0; n < 2; ++n) _Pragma("unroll") for (int k = 0; k < 2; ++k) dst[n][k] = *(const LAS bf16x8*)(lds + PG8_SB(b, h) + boff + n * 2048 + k * 1024); } while (0)
#define PG8_MMA(ai, bj, At, Bt) do { __builtin_amdgcn_s_setprio(1); _Pragma("unroll") for (int m = 0; m < 4; ++m) _Pragma("unroll") for (int n = 0; n < 2; ++n) _Pragma("unroll") for (int k = 0; k < 2; ++k) \
    acc[ai][bj][m][n] = __builtin_amdgcn_mfma_f32_16x16x32_bf16(Bt[n][k], At[m][k], acc[ai][bj][m][n], 0, 0, 0); __builtin_amdgcn_s_setprio(0); } while (0)
#define PG8_WAIT_V(n) asm volatile("s_waitcnt vmcnt(" #n ")" ::: "memory")
#define PG8_WAIT_L(n) asm volatile("s_waitcnt lgkmcnt(" #n ")" ::: "memory")
#define PG8_BAR __builtin_amdgcn_s_barrier()
#define PG8_SCHED __builtin_amdgcn_sched_barrier(0)
  Unit cur, nxt; int ui = 0;
  if (!S.next(0, cur)) return;
  f32x4 acc[2][2][4][2];
#pragma unroll
  for (int a = 0; a < 2; ++a)
#pragma unroll
    for (int b = 0; b < 2; ++b)
#pragma unroll
      for (int m = 0; m < 4; ++m)
#pragma unroll
        for (int n = 0; n < 2; ++n) acc[a][b][m][n] = (f32x4){0.f, 0.f, 0.f, 0.f};
  bf16x8 At[4][2], B0[2][2], B1[2][2];
#define PG8_APTR(u_) ((const char*)g.A + (size_t)((u_).pm % g.msplit) * tstep + (size_t)((u_).pm / g.msplit) * g.koff * 2)
#define PG8_BPTR(u_) ((const char*)g.Bt + (size_t)(u_).pn * tstep + (size_t)((u_).pm / g.msplit) * g.koff * 2)
  const char* cA = PG8_APTR(cur); const char* cB = PG8_BPTR(cur);
  PG8_STAGE(PG8_SB(0, 0), cB); PG8_STAGE(PG8_SA(0, 0), cA); PG8_STAGE(PG8_SB(0, 1), cB + hstep); PG8_STAGE(PG8_SA(0, 1), cA + hstep);
  if (wr == 1) PG8_BAR;
  PG8_WAIT_V(4); PG8_BAR;
  PG8_STAGE(PG8_SB(1, 0), cB + kstep); PG8_STAGE(PG8_SA(1, 0), cA + kstep); PG8_STAGE(PG8_SB(1, 1), cB + hstep + kstep);
  PG8_WAIT_V(6); PG8_BAR;
  for (;;) {
    const bool has_next = S.next(ui + 1, nxt);
    const char* nA = has_next ? PG8_APTR(nxt) : cA; const char* nB = has_next ? PG8_BPTR(nxt) : cB;
    for (int t = 0; t < nt; t += 2) {
      const bool last = (t == nt - 2);
      const char* a1 = cA + (size_t)(t + 1) * kstep;
      const char* a2 = last ? nA : cA + (size_t)(t + 2) * kstep; const char* b2 = last ? nB : cB + (size_t)(t + 2) * kstep;
      const char* a3 = a2 + kstep; const char* b3 = b2 + kstep;
      PG8_LDB(B0, 0, 0); PG8_SCHED; PG8_LDA(At, 0, 0); PG8_STAGE(PG8_SA(1, 1), a1 + hstep);
      PG8_WAIT_L(8); PG8_BAR; PG8_WAIT_L(0); PG8_MMA(0, 0, At, B0); PG8_BAR; PG8_SCHED;
      PG8_LDB(B1, 0, 1); PG8_STAGE(PG8_SB(0, 0), b2);
      PG8_BAR; PG8_WAIT_L(0); PG8_MMA(0, 1, At, B1); PG8_BAR;
      PG8_LDA(At, 0, 1); PG8_STAGE(PG8_SA(0, 0), a2);
      PG8_BAR; PG8_WAIT_L(0); PG8_MMA(1, 0, At, B0); PG8_BAR; PG8_SCHED;
      PG8_STAGE(PG8_SB(0, 1), b2 + hstep);
      PG8_WAIT_V(6); PG8_BAR; PG8_MMA(1, 1, At, B1); PG8_BAR;
      PG8_LDB(B0, 1, 0); PG8_SCHED; PG8_LDA(At, 1, 0); PG8_STAGE(PG8_SA(0, 1), a2 + hstep);
      PG8_WAIT_L(8); PG8_BAR; PG8_WAIT_L(0); PG8_MMA(0, 0, At, B0); PG8_BAR; PG8_SCHED;
      PG8_LDB(B1, 1, 1); PG8_STAGE(PG8_SB(1, 0), b3);
      PG8_BAR; PG8_WAIT_L(0); PG8_MMA(0, 1, At, B1); PG8_BAR;
      PG8_LDA(At, 1, 1); PG8_STAGE(PG8_SA(1, 0), a3);
      PG8_BAR; PG8_WAIT_L(0); PG8_MMA(1, 0, At, B0); PG8_BAR; PG8_SCHED;
      PG8_STAGE(PG8_SB(1, 1), b3 + hstep);
      PG8_WAIT_V(6); PG8_BAR; PG8_MMA(1, 1, At, B1); PG8_BAR;
    }
    E(acc, cur, wr, wc, fr, fq);
    if (!has_next) break;
#pragma unroll
    for (int a = 0; a < 2; ++a)
#pragma unroll
      for (int b = 0; b < 2; ++b)
#pragma unroll
        for (int m = 0; m < 4; ++m)
#pragma unroll
          for (int n = 0; n < 2; ++n) acc[a][b][m][n] = (f32x4){0.f, 0.f, 0.f, 0.f};
    cur = nxt; cA = nA; cB = nB; ++ui;
  }
  PG8_WAIT_V(0);
  if (wr == 0) PG8_BAR;
  PG8_BAR;
#undef PG8_APTR
#undef PG8_BPTR
#undef PG8_SA
#undef PG8_SB
#undef PG8_STAGE
#undef PG8_LDA
#undef PG8_LDB
#undef PG8_MMA
#undef PG8_WAIT_V
#undef PG8_WAIT_L
#undef PG8_BAR
#undef PG8_SCHED
}
}

enum { EPI_SWIGLU = 0, EPI_RES = 1, EPI_DA = 2, EPI_HY = 3, EPI_RT = 4, EPI_SC = 5, EPI_PART = 6 };
struct Epi {
  int mode, l, lnk, fusedln, final, zz; float coef; unsigned char* ws;
  DI const float* gatep() const { return (const float*)(ws + WS_MODS) + (size_t)l * 9 * 9216 + (lnk == 0 ? 2 : (lnk == 1 ? 5 : 8)) * 1024; }
  DI void store_t(bf16_t* T, int colbase, const f32x4 (&acc)[2][2][4][2], int rowbase, int wr, int wc, int fr, int fq) const {
#pragma unroll
    for (int ai = 0; ai < 2; ++ai)
#pragma unroll
      for (int m = 0; m < 4; ++m) {
        const int row = rowbase + ai * 128 + wr * 64 + m * 16 + fr;
#pragma unroll
        for (int bj = 0; bj < 2; ++bj)
#pragma unroll
          for (int n = 0; n < 2; ++n) {
            const int col = colbase + bj * 128 + wc * 32 + n * 16 + fq * 4;
            const unsigned w0 = pk_bf16(acc[ai][bj][m][n][0], acc[ai][bj][m][n][1]), w1 = pk_bf16(acc[ai][bj][m][n][2], acc[ai][bj][m][n][3]);
            T[(size_t)(col + 0) * MT + row] = (bf16_t)(w0 & 0xffffu); T[(size_t)(col + 1) * MT + row] = (bf16_t)(w0 >> 16);
            T[(size_t)(col + 2) * MT + row] = (bf16_t)(w1 & 0xffffu); T[(size_t)(col + 3) * MT + row] = (bf16_t)(w1 >> 16);
          }
      }
  }
  DI void operator()(const f32x4 (&acc)[2][2][4][2], const pg8::Unit& u, int wr, int wc, int fr, int fq) const {
    const int rowbase = u.pm * 256;
    unsigned char* const BIGp = ws + WS_BIG;
    void* const p0 = mode == EPI_RES ? (void*)(ws + WS_X) : (void*)BIGp; void* const p1 = BIGp + SZ_TOK1K; void* const p2 = BIGp + 2 * SZ_TOK1K; void* const p3 = BIGp + 4 * SZ_TOK1K;
    const float* const f0 = mode == EPI_RES ? gatep() : (const float*)(ws + (mode == EPI_DA ? WS_ROPE_DA : WS_ROPE_RT));
    if (mode == EPI_SWIGLU) {
      bf16_t* O = (bf16_t*)p0;
#pragma unroll
      for (int ai = 0; ai < 2; ++ai)
#pragma unroll
        for (int m = 0; m < 4; ++m) {
          bf16_t* rowp = O + (size_t)(rowbase + ai * 128 + wr * 64 + m * 16 + fr) * DFF + u.pn * 128 + wc * 32 + 8 * fq;
          f32x4 v[2];
#pragma unroll
          for (int n = 0; n < 2; ++n) { const f32x4 a = acc[ai][0][m][n], g = acc[ai][1][m][n];
#pragma unroll
            for (int j = 0; j < 4; ++j) v[n][j] = silu_f(a[j]) * g[j]; }
          u32x4 w; w.x = pk_bf16(v[0][0], v[0][1]); w.y = pk_bf16(v[0][2], v[0][3]); w.z = pk_bf16(v[1][0], v[1][1]); w.w = pk_bf16(v[1][2], v[1][3]);
          *(u32x4*)rowp = w;
        }
    } else if (mode == EPI_RES) {
      bf16_t* X = (bf16_t*)p0; const int mb = u.pm < 64 ? (u.pm >> 3) : 8;
      const int col0 = u.pn * 256 + wc * 32 + 8 * fq;
      f32x4 gv[2][2];
#pragma unroll
      for (int bj = 0; bj < 2; ++bj)
#pragma unroll
        for (int n = 0; n < 2; ++n) gv[bj][n] = *(const f32x4*)(f0 + (size_t)mb * 9216 + col0 + bj * 128 + n * 4) * coef;
#pragma unroll
      for (int ai = 0; ai < 2; ++ai)
#pragma unroll
        for (int m = 0; m < 4; ++m) {
          bf16_t* rowp = X + (size_t)(rowbase + ai * 128 + wr * 64 + m * 16 + fr) * DM + col0;
#pragma unroll
          for (int bj = 0; bj < 2; ++bj) { f32x4 x0, x1; ld_bf8(rowp + bj * 128, x0, x1);
            st_bf8(rowp + bj * 128, x0 * ALPHA + gv[bj][0] * acc[ai][bj][m][0], x1 * ALPHA + gv[bj][1] * acc[ai][bj][m][1]); }
        }
    } else if (mode == EPI_DA) {
      if (u.pn < 8) {
        bf16_t* base = (bf16_t*)(u.pn < 4 ? p0 : p1); const float sc = u.pn < 4 ? 0.125f * LOG2E : 1.0f; const int tcol = (u.pn & 3) * 256 + wc * 64;
        const bool lat = u.pm < 64; const f32x2* rope = (const f32x2*)f0;
#pragma unroll
        for (int ai = 0; ai < 2; ++ai)
#pragma unroll
          for (int m = 0; m < 4; ++m) {
            const int row = rowbase + ai * 128 + wr * 64 + m * 16 + fr, t = row & 2047;
            f32x4 o1[2], o2[2];
#pragma unroll
            for (int n = 0; n < 2; ++n) {
              const int dd = 8 * fq + 4 * n; const f32x4 x1 = acc[ai][0][m][n], x2 = acc[ai][1][m][n];
              if (lat) {
#pragma unroll
                for (int j = 0; j < 4; ++j) { const f32x2 cs = rope[t * 32 + dd + j]; o1[n][j] = (x1[j] * cs.x - x2[j] * cs.y) * sc; o2[n][j] = (x1[j] * cs.y + x2[j] * cs.x) * sc; }
              } else { o1[n] = x1 * sc; o2[n] = x2 * sc; }
            }
            { bf16_t* q = base + (size_t)row * 1024 + tcol + 8 * fq; st_bf8(q, o1[0], o1[1]); st_bf8(q + 32, o2[0], o2[1]); }
          }
      } else store_t((bf16_t*)p2, (u.pn - 8) * 256, acc, rowbase, wr, wc, fr, fq);
    } else if (mode == EPI_HY) {
      store_t((bf16_t*)p0, u.pn * 256, acc, rowbase, wr, wc, fr, fq);
    } else if (mode == EPI_RT) {
      if (u.pn < 8) {
        bf16_t* base = (bf16_t*)(u.pn < 4 ? p0 : p1); const float sc = u.pn < 4 ? 1.0f : 0.0625f; const int tcol = (u.pn & 3) * 256 + wc * 32;
        const bool lat = u.pm < 64; const f32x2* rope = (const f32x2*)f0;
#pragma unroll
        for (int ai = 0; ai < 2; ++ai)
#pragma unroll
          for (int m = 0; m < 4; ++m) {
            const int row = rowbase + ai * 128 + wr * 64 + m * 16 + fr, t = row & 2047;
            f32x4 o1[2], o2[2];
#pragma unroll
            for (int n = 0; n < 2; ++n) {
              const int dd = wc * 32 + 8 * fq + 4 * n; const f32x4 x1 = acc[ai][0][m][n], x2 = acc[ai][1][m][n];
              if (lat) {
#pragma unroll
                for (int j = 0; j < 4; ++j) { const f32x2 cs = rope[t * 128 + dd + j]; o1[n][j] = (x1[j] * cs.x - x2[j] * cs.y) * sc; o2[n][j] = (x1[j] * cs.y + x2[j] * cs.x) * sc; }
              } else { o1[n] = x1 * sc; o2[n] = x2 * sc; }
            }
            { bf16_t* q = base + (size_t)row * 1024 + tcol + 8 * fq; st_bf8(q, o1[0], o1[1]); st_bf8(q + 128, o2[0], o2[1]); }
          }
        (void)tcol;
      } else if (u.pn < 16) store_t((bf16_t*)p2, (u.pn - 8) * 256, acc, rowbase, wr, wc, fr, fq);
      else {
        bf16_t* G = (bf16_t*)p3;
#pragma unroll
        for (int ai = 0; ai < 2; ++ai)
#pragma unroll
          for (int m = 0; m < 4; ++m) {
            bf16_t* rowp = G + (size_t)(rowbase + ai * 128 + wr * 64 + m * 16 + fr) * 2048 + (u.pn - 16) * 256 + wc * 32 + 8 * fq;
#pragma unroll
            for (int bj = 0; bj < 2; ++bj) { f32x4 v[2];
#pragma unroll
              for (int n = 0; n < 2; ++n)
#pragma unroll
                for (int j = 0; j < 4; ++j) v[n][j] = silu_f(acc[ai][bj][m][n][j]);
              st_bf8(rowp + bj * 128, v[0], v[1]); }
          }
      }
    } else if (mode == EPI_PART) {
      float* P = (float*)(BIGp + 5 * SZ_TOK1K); const int col0 = u.pn * 256 + wc * 32 + 8 * fq;
#pragma unroll
      for (int ai = 0; ai < 2; ++ai)
#pragma unroll
        for (int m = 0; m < 4; ++m) { float* rowp = P + (size_t)(rowbase + ai * 128 + wr * 64 + m * 16 + fr) * DM + col0;
#pragma unroll
          for (int bj = 0; bj < 2; ++bj)
#pragma unroll
            for (int n = 0; n < 2; ++n) *(f32x4*)(rowp + bj * 128 + n * 4) = acc[ai][bj][m][n]; }
    } else {
      if (u.pn < 4) {
        bf16_t* BG = (bf16_t*)p0;
#pragma unroll
        for (int ai = 0; ai < 2; ++ai)
#pragma unroll
          for (int m = 0; m < 4; ++m) {
            bf16_t* rowp = BG + (size_t)(rowbase + ai * 128 + wr * 64 + m * 16 + fr) * 1024 + u.pn * 256 + wc * 32 + 8 * fq;
#pragma unroll
            for (int bj = 0; bj < 2; ++bj) st_bf8(rowp + bj * 128, acc[ai][bj][m][0], acc[ai][bj][m][1]);
          }
      } else {
        bf16_t* CU = (bf16_t*)p1;
#pragma unroll
        for (int ai = 0; ai < 2; ++ai)
#pragma unroll
          for (int m = 0; m < 4; ++m) {
            bf16_t* rowp = CU + (size_t)(rowbase + ai * 128 + wr * 64 + m * 16 + fr) * 1024 + (u.pn - 4) * 128 + wc * 32 + 8 * fq;
            st_bf8(rowp, acc[ai][0][m][0] * acc[ai][1][m][0], acc[ai][0][m][1] * acc[ai][1][m][1]);
          }
      }
    }
  }
};

DI int map_col(int kind, int rho) {
  if (kind == 1) { const int t = rho >> 8, r = rho & 255; return r < 128 ? 128 * t + r : DFF + 128 * t + (r - 128); }
  if (kind == 2) { if (rho >= 2048) return rho; const int base = rho & ~255, r = rho & 255; const int bj = r >> 7, hm = (r & 127) >> 5, dd = r & 31; return base + hm * 64 + bj * 32 + dd; }
  if (kind == 3) { if (rho < 1024) return rho; const int t = (rho - 1024) >> 8, r = (rho - 1024) & 255; return r < 128 ? 1024 + 128 * t + r : 2048 + 128 * t + (r - 128); }
  return rho;
}

DI void conv_units(const Params& p, int zz, int tx, int ulo, int uhi, int wgi, int nwgs) {
  const int wid = tx >> 6, lane = tx & 63, cg = lane & 7, kb8 = lane >> 3;
  const int nw = nwgs * 8;
  for (int u = ulo + wgi * 8 + wid; u < uhi; u += nw) {
    int j = 0;
#pragma unroll 1
    for (int k = 1; k < 24; ++k) if (u >= p.jobs[k + zz].ustart) j = k;
    const WJob jb = p.jobs[j + zz];
    const int lu = u - jb.ustart, nkb = jb.K >> 8, rb = lu / nkb, kb = lu - rb * nkb;
    const int rho0 = rb * 32, k0 = kb * 256 + 8 * kb8, scol = map_col(jb.kind, rho0) + ((jb.kind == 1 || jb.kind == 4 || jb.kind == 3 || (jb.kind == 2 && rho0 < 2048) || (jb.kind == 5 && (rho0 < 2048 || rho0 >= 4096))) ? 8 * (cg & 3) + 4 * (cg >> 2) : 4 * cg);
    const float* src = jb.src + (size_t)k0 * jb.srcN + scol;
    bf16_t* dst = jb.dst + (size_t)(rho0 + 4 * cg) * jb.K + k0;
    const size_t rs = (size_t)jb.srcN;
#pragma unroll 2
    for (int it = 0; it < 4; ++it) {
      f32x4 v[8];
#pragma unroll
      for (int q = 0; q < 8; ++q) v[q] = __builtin_nontemporal_load((const f32x4*)(src + (size_t)(it * 64 + q) * rs));
#pragma unroll
      for (int e = 0; e < 4; ++e) { u32x4 w; w.x = pk_bf16(v[0][e], v[1][e]); w.y = pk_bf16(v[2][e], v[3][e]); w.z = pk_bf16(v[4][e], v[5][e]); w.w = pk_bf16(v[6][e], v[7][e]);
        *(u32x4*)(dst + (size_t)e * jb.K + it * 64) = w; }
    }
  }
}

DI void mods_prepare(const Params& p, int zz, int tx, LAS unsigned char* lds) {
  LAS float* sc = (LAS float*)lds;
  for (int idx = tx; idx < 9216; idx += NTHR) { const int r = idx >> 10, k = idx & 1023; const float v = r < 8 ? p.in[zz + 1][r * 1024 + k] : p.in[zz + 3][k]; sc[idx] = v / (1.0f + __expf(-v)); }
  __syncthreads();
}
DI void mods_unit(const Params& p, int zz, int tx, LAS unsigned char* lds, int u) {
  LAS float* sc = (LAS float*)lds; LAS float* part = (LAS float*)(lds + 36864);
  const int l = u / 36, cb = u - l * 36, wid = tx >> 6, lane = tx & 63, col = cb * 256 + lane * 4;
  const float* W = p.in[zz + 4] + (size_t)l * 1024 * 9216 + col;
  f32x4 acc[9];
#pragma unroll
  for (int r = 0; r < 9; ++r) acc[r] = (f32x4){0.f, 0.f, 0.f, 0.f};
#pragma unroll 8
  for (int k = wid * 128; k < wid * 128 + 128; ++k) {
    const f32x4 w = __builtin_nontemporal_load((const f32x4*)(W + (size_t)k * 9216));
#pragma unroll
    for (int r = 0; r < 9; ++r) acc[r] += w * sc[r * 1024 + k];
  }
#pragma unroll
  for (int r = 0; r < 9; ++r) *(LAS f32x4*)(part + (wid * 9 + r) * 256 + lane * 4) = acc[r];
  __syncthreads();
  float* mods = (float*)((p.ws + zz) + WS_MODS);
  for (int idx = tx; idx < 9 * 256; idx += NTHR) {
    const int r = idx >> 8, cl = idx & 255; float s = p.in[zz + 5][l * 9216 + cb * 256 + cl];
#pragma unroll
    for (int w = 0; w < 8; ++w) s += part[(w * 9 + r) * 256 + cl];
    mods[(size_t)(l * 9 + r) * 9216 + cb * 256 + cl] = s;
  }
  __syncthreads();
}

DI void filter_unit(const Params& p, int zz, int tx, LAS unsigned char* lds, int u) {
  const bool lat = u < 256; const int n = lat ? 2048 : 256, p0 = lat ? u * 8 : (u - 256) * 8, tid = tx;
  LAS float* z = (LAS float*)lds;
  LAS float* h1 = z + 8 * 33;
  LAS float* h2 = h1 + 8 * 64;
  const float* w1 = p.in[zz + 19]; const float* b1 = p.in[zz + 20]; const float* f1 = p.in[zz + 21]; const float* w2 = p.in[zz + 22]; const float* b2 = p.in[zz + 23]; const float* f2 = p.in[zz + 24];
  const float* w3 = p.in[zz + 25]; const float* dsk = p.in[zz + 26];
  if (tid < 8 * 33) { const int pos = tid / 33, f = tid - pos * 33; const int pp = p0 + pos; const float t = (float)pp / (float)(n - 1), w = 6.283185307179586f * (float)pp / (float)n;
    float v; if (f == 0) v = t; else { const int k = (f - 1) & 15; const float fr = 1e-4f + (float)k * ((15.0f - 1e-4f) / 15.0f); v = f <= 16 ? __cosf(fr * w) : -__sinf(fr * w); }
    z[tid] = v; }
  __syncthreads();
  { const int pos = tid >> 6, o = tid & 63; float s = b1[o];
#pragma unroll 3
    for (int f = 0; f < 33; ++f) s += z[pos * 33 + f] * w1[f * 64 + o];
    h1[tid] = __sinf(f1[o] * s); }
  __syncthreads();
  { const int pos = tid >> 6, o = tid & 63; float s = b2[o];
#pragma unroll 4
    for (int k = 0; k < 64; ++k) s += h1[pos * 64 + k] * w2[k * 64 + o];
    h2[tid] = __sinf(f2[o] * s); }
  __syncthreads();
  { const int cc = tid * 4; f32x4 a[8];
#pragma unroll
    for (int q = 0; q < 8; ++q) a[q] = (f32x4){0.f, 0.f, 0.f, 0.f};
#pragma unroll 16
    for (int k = 0; k < 64; ++k) { const f32x4 w = *(const f32x4*)(w3 + (size_t)k * 2048 + cc);
#pragma unroll
      for (int q = 0; q < 8; ++q) a[q] += w * h2[q * 64 + k]; }
    const bool bwd = cc >= 1024; const int c0 = cc & 1023;
    const float mind = -3.0701134573253944f, maxd = -15.350567286626972f;
    bf16_t* R = (bf16_t*)((p.ws + zz) + (lat ? WS_HYRL : WS_HYRC)); const int rs = lat ? RL_STRIDE : RC_STRIDE;
#pragma unroll
    for (int q = 0; q < 8; ++q) { const int pp = p0 + q; const float t = (float)pp / (float)(n - 1);
#pragma unroll
      for (int e = 0; e < 4; ++e) { const int c = c0 + e; const float dl = fabsf(mind + (maxd - mind) * ((float)c / 1023.0f));
        float v = a[q][e] * __expf(-t * dl);
        if (!bwd) { if (pp == 0) v += dsk[c]; R[(size_t)c * rs + (n - pp)] = f2bf(v); }
        else if (pp > 0) R[(size_t)c * rs + (n + pp)] = f2bf(v); } }
    if (p0 == 0) { for (int idx = tid; idx < 1024 * 9; idx += NTHR) { const int c = idx / 9, e = idx - c * 9; R[(size_t)c * rs + (e == 0 ? 0 : 2 * n + e - 1)] = 0; } }
  }
  __syncthreads();
}

DI void rope_tables(const Params& p, int zz, int tx) {
  f32x2* rd = (f32x2*)((p.ws + zz) + WS_ROPE_DA); f32x2* rr = (f32x2*)((p.ws + zz) + WS_ROPE_RT);
  const int gsz = gridDim.x * NTHR, gid = blockIdx.x * NTHR + tx;
  for (int idx = gid; idx < 2048 * 32; idx += gsz) { const int t = idx >> 5, d = idx & 31; const int k = d & 15; const float inv = exp2f(-(float)k / 16.0f * 13.287712379549449f);
    const float ang = (float)(d < 16 ? (t >> 6) : (t & 63)) * inv; rd[idx] = (f32x2){__cosf(ang), __sinf(ang)}; }
  for (int idx = gid; idx < 2048 * 128; idx += gsz) { const int t = idx >> 7, d = idx & 127; const int k = d & 63; const float inv = exp2f(-(float)k / 64.0f * 13.287712379549449f);
    const float ang = (float)(d < 64 ? (t >> 6) : (t & 63)) * inv; rr[idx] = (f32x2){__cosf(ang), __sinf(ang)}; }
}

DI void init_phase(const Params& p, int zz, int tx) {
  bf16_t* X = (bf16_t*)((p.ws + zz) + WS_X); bf16_t* H = (bf16_t*)((p.ws + zz) + WS_H); const float* mods = (const float*)((p.ws + zz) + WS_MODS);
  const int wid = tx >> 6, lane = tx & 63;
  for (int row = blockIdx.x * 8 + wid; row < MT; row += gridDim.x * 8) {
    const float* src = row < ML ? p.in[zz + 0] + (size_t)row * DM : p.in[zz + 2] + (size_t)(row - ML) * DM; const int mb = row < ML ? row >> 11 : 8;
#pragma unroll
    for (int k = 0; k < 2; ++k) { const int col = k * 512 + lane * 8; const f32x4 va = *(const f32x4*)(src + col), vb = *(const f32x4*)(src + col + 4);
      st_bf8(X + (size_t)row * DM + col, va, vb);
      const float* mr = mods + (size_t)mb * 9216 + col;
      const f32x4 sha = *(const f32x4*)(mr), shb = *(const f32x4*)(mr + 4), sca = *(const f32x4*)(mr + 1024), scb = *(const f32x4*)(mr + 1024 + 4);
      st_bf8(H + (size_t)row * DM + col, va * (sca + 1.0f) + sha, vb * (scb + 1.0f) + shb); }
  }
}

DI void ln_phase(const Params& p, int zz, int tx, int M, const float* g, const float* bta, const float* shift, const float* scale, bool final, const float* part, const float* pgate) {
  bf16_t* X = (bf16_t*)((p.ws + zz) + WS_X); bf16_t* H = (bf16_t*)((p.ws + zz) + WS_H);
  const int wid = tx >> 6, lane = tx & 63, stride = gridDim.x * 8;
  f32x4 g4[4], b4[4];
#pragma unroll
  for (int q = 0; q < 4; ++q) { const int col = (q >> 1) * 512 + lane * 8 + (q & 1) * 4; g4[q] = *(const f32x4*)(g + col); b4[q] = *(const f32x4*)(bta + col); }
  for (int row0 = blockIdx.x * 8 + wid; row0 < M; row0 += 2 * stride) {
    const int row1 = row0 + stride; const bool has1 = row1 < M;
    bf16_t* xr0 = X + (size_t)row0 * DM + lane * 8; bf16_t* xr1 = X + (size_t)(has1 ? row1 : row0) * DM + lane * 8;
    f32x4 v0[4], v1[4]; float s0 = 0.f, s1 = 0.f;
    ld_bf8(xr0, v0[0], v0[1]); ld_bf8(xr0 + 512, v0[2], v0[3]); ld_bf8(xr1, v1[0], v1[1]); ld_bf8(xr1 + 512, v1[2], v1[3]);
    if (part != nullptr && row0 >= ML) {
      const float* q0 = part + (size_t)(row0 - ML) * DM; const float* q1 = part + (size_t)((has1 ? row1 : row0) - ML) * DM;
#pragma unroll
      for (int q = 0; q < 4; ++q) { const int col = (q >> 1) * 512 + lane * 8 + (q & 1) * 4; const f32x4 gt = *(const f32x4*)(pgate + col) * 0.5f;
        v0[q] = v0[q] * ALPHA + gt * (*(const f32x4*)(q0 + col) + *(const f32x4*)(q0 + (size_t)2048 * DM + col));
        v1[q] = v1[q] * ALPHA + gt * (*(const f32x4*)(q1 + col) + *(const f32x4*)(q1 + (size_t)2048 * DM + col)); }
    }
#pragma unroll
    for (int k = 0; k < 4; ++k) { s0 += (v0[k][0] + v0[k][1]) + (v0[k][2] + v0[k][3]); s1 += (v1[k][0] + v1[k][1]) + (v1[k][2] + v1[k][3]); }
#pragma unroll
    for (int o = 32; o >= 1; o >>= 1) { s0 += __shfl_xor(s0, o); s1 += __shfl_xor(s1, o); }
    const float mean0 = s0 * (1.0f / 1024.0f), mean1 = s1 * (1.0f / 1024.0f); float q0s = 0.f, q1s = 0.f;
#pragma unroll
    for (int k = 0; k < 4; ++k) { const f32x4 d0 = v0[k] - mean0, d1 = v1[k] - mean1; q0s += (d0[0] * d0[0] + d0[1] * d0[1]) + (d0[2] * d0[2] + d0[3] * d0[3]); q1s += (d1[0] * d1[0] + d1[1] * d1[1]) + (d1[2] * d1[2] + d1[3] * d1[3]); }
#pragma unroll
    for (int o = 32; o >= 1; o >>= 1) { q0s += __shfl_xor(q0s, o); q1s += __shfl_xor(q1s, o); }
    const float rstd0 = rsqrtf(q0s * (1.0f / 1024.0f) + LN_EPS), rstd1 = rsqrtf(q1s * (1.0f / 1024.0f) + LN_EPS);
#pragma unroll
    for (int rr = 0; rr < 2; ++rr) {
      if (rr == 1 && !has1) break;
      const int row = rr ? row1 : row0; const int mb = row < ML ? row >> 11 : 8; bf16_t* xr = rr ? xr1 : xr0; const float mean = rr ? mean1 : mean0, rstd = rr ? rstd1 : rstd0;
      f32x4 y[4];
#pragma unroll
      for (int q = 0; q < 4; ++q) y[q] = ((rr ? v1[q] : v0[q]) - mean) * rstd * g4[q] + b4[q];
      if (final) {
#pragma unroll
        for (int q = 0; q < 4; ++q) *(f32x4*)((p.out + zz) + (size_t)row * DM + (q >> 1) * 512 + lane * 8 + (q & 1) * 4) = y[q];
      } else {
        st_bf8(xr, y[0], y[1]); st_bf8(xr + 512, y[2], y[3]);
        f32x4 h[4];
#pragma unroll
        for (int q = 0; q < 4; ++q) { const int col = (q >> 1) * 512 + lane * 8 + (q & 1) * 4; const f32x4 sh = *(const f32x4*)(shift + (size_t)mb * 9216 + col), sc = *(const f32x4*)(scale + (size_t)mb * 9216 + col); h[q] = y[q] * (sc + 1.0f) + sh; }
        bf16_t* hp = H + (size_t)row * DM + lane * 8; st_bf8(hp, h[0], h[1]); st_bf8(hp + 512, h[2], h[3]);
      }
    }
  }
}

DI void sc_core_phase(const Params& p, int zz, int tx) {
  const bf16_t* BG = (const bf16_t*)((p.ws + zz) + WS_BIG); const bf16_t* CU = (const bf16_t*)((p.ws + zz) + WS_BIG + SZ_TOK1K); bf16_t* H = (bf16_t*)((p.ws + zz) + WS_H); const float* cw = p.in[zz + 33];
  for (int idx = blockIdx.x * NTHR + tx; idx < ML * 128; idx += gridDim.x * NTHR) {
    const int row = idx >> 7, c8 = (idx & 127) * 8, t = row & 2047; const size_t o = (size_t)row * 1024 + c8;
    f32x4 c0a, c0b, cma, cmb, cpa, cpb, bga, bgb;
    const f32x4 z4 = (f32x4){0.f, 0.f, 0.f, 0.f};
    ld_bf8(CU + o, c0a, c0b); ld_bf8(BG + o, bga, bgb);
    if (t > 0) ld_bf8(CU + o - 1024, cma, cmb); else { cma = z4; cmb = z4; }
    if (t < 2047) ld_bf8(CU + o + 1024, cpa, cpb); else { cpa = z4; cpb = z4; }
    const f32x4 w0a = *(const f32x4*)(cw + c8), w0b = *(const f32x4*)(cw + c8 + 4), w1a = *(const f32x4*)(cw + 1024 + c8), w1b = *(const f32x4*)(cw + 1024 + c8 + 4), w2a = *(const f32x4*)(cw + 2048 + c8), w2b = *(const f32x4*)(cw + 2048 + c8 + 4);
    st_bf8(H + o, bga * (w0a * cma + w1a * c0a + w2a * cpa), bgb * (w0b * cmb + w1b * c0b + w2b * cpb));
  }
}

DI void hy_transpose_phase(const Params& p, int zz, int tx, LAS unsigned char* lds) {
  const bf16_t* ZT = (const bf16_t*)((p.ws + zz) + WS_BIG + 3 * SZ_TOK1K); bf16_t* H = (bf16_t*)((p.ws + zz) + WS_H); LAS bf16_t* T = (LAS bf16_t*)lds;
  const int tid = tx;
  for (int u = blockIdx.x; u < 16 * 288; u += gridDim.x) {
    const int ct = u & 15, tt = u >> 4, c0 = ct * 64, tok0 = tt * 64;
    { const int r = tid >> 3, ch = tid & 7; *(LAS u32x4*)(T + r * 72 + ch * 8) = *(const u32x4*)(ZT + (size_t)(c0 + r) * MT + tok0 + ch * 8); }
    __syncthreads();
    { const int tok = tid >> 3, cc = (tid & 7) * 8; unsigned w[4];
#pragma unroll
      for (int k = 0; k < 4; ++k) w[k] = (unsigned)T[(cc + 2 * k) * 72 + tok] | ((unsigned)T[(cc + 2 * k + 1) * 72 + tok] << 16);
      *(u32x4*)(H + (size_t)(tok0 + tok) * 1024 + c0 + cc) = (u32x4){w[0], w[1], w[2], w[3]}; }
    __syncthreads();
  }
}

DI void da_attn_phase(const Params& p, int zz, int tx, LAS unsigned char* lds) {
  const bf16_t* Q = (const bf16_t*)((p.ws + zz) + WS_BIG); const bf16_t* Kb = (const bf16_t*)((p.ws + zz) + WS_BIG + SZ_TOK1K); const bf16_t* VT = (const bf16_t*)((p.ws + zz) + WS_BIG + 2 * SZ_TOK1K);
  bf16_t* AO = (bf16_t*)((p.ws + zz) + WS_H);
  const int tid = tx, wid = tid >> 6, lane = tid & 63, fr = lane & 15, fq = lane >> 4;
  const float* lam = p.in[zz + 14]; const float* subln = p.in[zz + 15];
  const float lam_init = 0.2f;
  const float lam_full = __expf(wave_sum(lam[lane] * lam[64 + lane])) - __expf(wave_sum(lam[128 + lane] * lam[192 + lane])) + lam_init;
  const int vcu = (gridDim.x % 8 == 0) ? (int)((blockIdx.x % 8) * (gridDim.x / 8) + blockIdx.x / 8) : (int)blockIdx.x;
  if (__builtin_amdgcn_readfirstlane(tx) >= 256) __builtin_amdgcn_s_setprio(1);
  for (int it = vcu; it < 1024 + 128; it += gridDim.x) {
    const bool isctx = it >= 1024; int b, h, qrow0, nkt;
    if (!isctx) { b = it >> 7; h = (it >> 4) & 7; qrow0 = b * 2048 + (it & 15) * 128; nkt = 36; }
    else { const int j = it - 1024; b = j >> 4; h = (j >> 1) & 7; qrow0 = ML + b * 256 + (j & 1) * 128; nkt = 4; }
    bf16x8 qf[2][2];
    { const bf16_t* qp = Q + (size_t)(qrow0 + wid * 16 + fr) * 1024 + h * 128 + fq * 8;
#pragma unroll
      for (int m = 0; m < 2; ++m)
#pragma unroll
        for (int ks = 0; ks < 2; ++ks) qf[m][ks] = *(const bf16x8*)(qp + m * 64 + ks * 32); }
    f32x4 O[2][8]; float mrun[2] = {-1e30f, -1e30f}, lsum[2] = {0.f, 0.f};
#pragma unroll
    for (int m = 0; m < 2; ++m)
#pragma unroll
      for (int et = 0; et < 8; ++et) O[m][et] = (f32x4){0.f, 0.f, 0.f, 0.f};
    u32x4 kreg[2], vreg[2];
#define DA_TOK(kt_) (((isctx) || (kt_) < 4) ? ML + b * 256 + (kt_) * 64 : b * 2048 + ((kt_) - 4) * 64)
#define DA_FETCH(kt_) do { const int tok0_ = DA_TOK(kt_); _Pragma("unroll") for (int i = 0; i < 2; ++i) { const int id = tid + NTHR * i; \
      kreg[i] = *(const u32x4*)(Kb + (size_t)(tok0_ + (id >> 4)) * 1024 + h * 128 + (id & 15) * 8); \
      vreg[i] = *(const u32x4*)(VT + (size_t)(h * 128 + (id >> 3)) * MT + tok0_ + (id & 7) * 8); } } while (0)
#define DA_PUT(buf_) do { LAS bf16_t* Kw = (LAS bf16_t*)(lds + (buf_) * 38912); LAS bf16_t* Vw = (LAS bf16_t*)(lds + (buf_) * 38912 + 18432); \
      _Pragma("unroll") for (int i = 0; i < 2; ++i) { const int id = tid + NTHR * i; \
        *(LAS u32x4*)(Kw + (id >> 4) * 144 + (id & 15) * 8) = kreg[i]; \
        const int cc = id & 7; LAS bf16_t* vp = Vw + (id >> 3) * 80 + 32 * (cc >> 2) + 16 * (cc & 1) + 4 * ((cc >> 1) & 1);     \
        *(LAS u32x2*)vp = (u32x2){vreg[i].x, vreg[i].y}; *(LAS u32x2*)(vp + 8) = (u32x2){vreg[i].z, vreg[i].w}; } } while (0)
    DA_FETCH(0);
    __syncthreads();
    DA_PUT(0);
    if (nkt > 1) DA_FETCH(1);
    __syncthreads();
    for (int kt = 0; kt < nkt; ++kt) {
      const LAS bf16_t* Ks = (const LAS bf16_t*)(lds + (kt & 1) * 38912); const LAS bf16_t* Vs = (const LAS bf16_t*)(lds + (kt & 1) * 38912 + 18432);
      f32x4 s[2][4];
#pragma unroll
      for (int m = 0; m < 2; ++m)
#pragma unroll
        for (int kk = 0; kk < 4; ++kk) { f32x4 a4 = (f32x4){0.f, 0.f, 0.f, 0.f};
#pragma unroll
          for (int ks = 0; ks < 2; ++ks) { const bf16x8 kf = *(const LAS bf16x8*)(Ks + (kk * 16 + fr) * 144 + m * 64 + ks * 32 + fq * 8); a4 = __builtin_amdgcn_mfma_f32_16x16x32_bf16(kf, qf[m][ks], a4, 0, 0, 0); }
          s[m][kk] = a4; }
      float mxl[2];
#pragma unroll
      for (int m = 0; m < 2; ++m) {
        float mx = fmaxf(fmaxf(s[m][0][0], s[m][0][1]), s[m][0][2]);
        mx = fmaxf(fmaxf(mx, s[m][0][3]), s[m][1][0]);
#pragma unroll
        for (int kk = 1; kk < 4; ++kk) {
          if (kk > 1) mx = fmaxf(fmaxf(mx, s[m][kk][0]), s[m][kk][1]); else mx = fmaxf(mx, s[m][kk][1]);
          mx = fmaxf(fmaxf(mx, s[m][kk][2]), s[m][kk][3]); }
        mxl[m] = mx; }
      if (__builtin_amdgcn_ballot_w64((mxl[0] > mrun[0] + 8.0f) || (mxl[1] > mrun[1] + 8.0f)) != 0ull) {
#pragma unroll
        for (int m = 0; m < 2; ++m) {
          float mx = mxl[m]; mx = fmaxf(mx, __shfl_xor(mx, 16)); mx = fmaxf(mx, __shfl_xor(mx, 32));
          const float mnew = fmaxf(mrun[m], mx), corr = fast_exp2(mrun[m] - mnew); mrun[m] = mnew; lsum[m] *= corr;
#pragma unroll
          for (int et = 0; et < 8; ++et) O[m][et] *= corr;
        }
      }
#pragma unroll
      for (int m = 0; m < 2; ++m) { float ps = 0.f;
#pragma unroll
        for (int kk = 0; kk < 4; ++kk)
#pragma unroll
          for (int j = 0; j < 4; ++j) { const float e = fast_exp2(s[m][kk][j] - mrun[m]); s[m][kk][j] = e; ps += e; }
        lsum[m] += ps; }
#pragma unroll
      for (int s2 = 0; s2 < 2; ++s2) {
        bf16x8 pf[2];
#pragma unroll
        for (int m = 0; m < 2; ++m) { u32x4 w; w.x = pk_bf16(s[m][2 * s2][0], s[m][2 * s2][1]); w.y = pk_bf16(s[m][2 * s2][2], s[m][2 * s2][3]); w.z = pk_bf16(s[m][2 * s2 + 1][0], s[m][2 * s2 + 1][1]); w.w = pk_bf16(s[m][2 * s2 + 1][2], s[m][2 * s2 + 1][3]); pf[m] = __builtin_bit_cast(bf16x8, w); }
#pragma unroll
        for (int et = 0; et < 8; ++et) {
          const bf16x8 vf = *(const LAS bf16x8*)(Vs + (et * 16 + fr) * 80 + 32 * s2 + 8 * fq);
          O[0][et] = __builtin_amdgcn_mfma_f32_16x16x32_bf16(vf, pf[0], O[0][et], 0, 0, 0);
          O[1][et] = __builtin_amdgcn_mfma_f32_16x16x32_bf16(vf, pf[1], O[1][et], 0, 0, 0);
        }
      }
      if (kt + 1 < nkt) { DA_PUT((kt + 1) & 1); if (kt + 2 < nkt) DA_FETCH(kt + 2); }
      __syncthreads();
    }
#undef DA_PUT
    float inv[2];
#pragma unroll
    for (int m = 0; m < 2; ++m) { float l = lsum[m]; l += __shfl_xor(l, 16); l += __shfl_xor(l, 32); inv[m] = 1.0f / l; }
    float ss = 0.f;
#pragma unroll
    for (int et = 0; et < 8; ++et)
#pragma unroll
      for (int j = 0; j < 4; ++j) { const float o = O[0][et][j] * inv[0] - lam_full * (O[1][et][j] * inv[1]); O[0][et][j] = o; ss += o * o; }
    ss += __shfl_xor(ss, 16); ss += __shfl_xor(ss, 32);
    const float rn = rsqrtf(ss * (1.0f / 128.0f) + LN_EPS) * (1.0f - lam_init);
    bf16_t* op = AO + (size_t)(qrow0 + wid * 16 + fr) * 1024 + h * 128 + 4 * fq;
#pragma unroll
    for (int et = 0; et < 8; ++et) { const f32x4 g = *(const f32x4*)(subln + et * 16 + 4 * fq); st_bf4(op + et * 16, O[0][et] * g * rn); }
  }
  __builtin_amdgcn_s_setprio(0);
}

#ifndef PVD
#define PVD 2
#endif
DI void rt_attn_phase(const Params& p, int zz, int tx, LAS unsigned char* lds) {
  const bf16_t* Q = (const bf16_t*)((p.ws + zz) + WS_BIG); const bf16_t* Kb = (const bf16_t*)((p.ws + zz) + WS_BIG + SZ_TOK1K); const bf16_t* VT = (const bf16_t*)((p.ws + zz) + WS_BIG + 2 * SZ_TOK1K);
  bf16_t* G = (bf16_t*)((p.ws + zz) + WS_BIG + 4 * SZ_TOK1K);
  const int tid = tx, wid = tid >> 6, lane = tid & 63, fr = lane & 15, fq = lane >> 4;
  const float* dl = p.in[zz + 29]; const float* gn = p.in[zz + 30];
  LAS bf16_t* Ks = (LAS bf16_t*)lds;
  LAS bf16_t* Vs = (LAS bf16_t*)(lds + 17408);
  const int vcu = (gridDim.x % 8 == 0) ? (int)((blockIdx.x % 8) * (gridDim.x / 8) + blockIdx.x / 8) : (int)blockIdx.x;
  if (__builtin_amdgcn_readfirstlane(tx) >= 256) __builtin_amdgcn_s_setprio(1);
  for (int it = vcu; it < 512; it += gridDim.x) {
    const int b = it >> 6, h = (it >> 4) & 3, qb = it & 15, qrow0 = b * 2048 + qb * 128;
    const float lgf = log2f(1.0f / (1.0f + expf(-dl[h]))), lgb = log2f(1.0f / (1.0f + expf(-dl[4 + h])));
    const int tq = qb * 128 + wid * 16 + fr;
    LAS bf16_t* Qs = (LAS bf16_t*)(lds + 66560);
    __syncthreads();
#pragma unroll
    for (int i = 0; i < 8; ++i) { const int id = tid + NTHR * i, r = id >> 5, cc = id & 31; *(LAS u32x4*)(Qs + r * 272 + cc * 8) = *(const u32x4*)(Q + (size_t)(qrow0 + r) * 1024 + h * 256 + cc * 8); }
    const LAS bf16_t* qsp = Qs + (wid * 16 + fr) * 272 + fq * 8;
    f32x4 O[32];
#pragma unroll
    for (int et = 0; et < 32; ++et) O[et] = (f32x4){0.f, 0.f, 0.f, 0.f};
    u32x4 kreg[2], vreg[4];
#define RT_TOK(kt_) ((kt_) < 8 ? ML + b * 256 + (kt_) * 32 : b * 2048 + ((kt_) - 8) * 32)
#define RT_FETCH(kt_) do { const int tok0_ = RT_TOK(kt_); _Pragma("unroll") for (int i = 0; i < 2; ++i) { const int id = tidl + NTHR * i; \
      kreg[i] = *(const u32x4*)(Kb + (size_t)(tok0_ + (id >> 5)) * 1024 + h * 256 + (id & 31) * 8); } \
    _Pragma("unroll") for (int i = 0; i < 4; ++i) { const int id = tidl + NTHR * i; \
      vreg[i] = *(const u32x4*)(VT + (size_t)(h * 512 + (id >> 2)) * MT + tok0_ + (id & 3) * 8); } } while (0)
    { int tidl = tid; RT_FETCH(0); }
    for (int kt = 0; kt < 72; ++kt) {
      int tidl = tid; asm volatile("" : "+v"(tidl));
      const bool kctx = kt < 8; const int spos = kctx ? kt * 32 : (kt - 8) * 32;
      __syncthreads();
#pragma unroll
      for (int i = 0; i < 2; ++i) { const int id = tidl + NTHR * i; *(LAS u32x4*)(Ks + (id >> 5) * 272 + (id & 31) * 8) = kreg[i]; }
#pragma unroll
      for (int i = 0; i < 4; ++i) { const int id = tidl + NTHR * i, cc = id & 3; LAS bf16_t* vp = Vs + (id >> 2) * 48 + 16 * (cc & 1) + 4 * (cc >> 1);
        *(LAS u32x2*)vp = (u32x2){vreg[i].x, vreg[i].y}; *(LAS u32x2*)(vp + 8) = (u32x2){vreg[i].z, vreg[i].w}; }
      __syncthreads();
      if (kt + 1 < 72) RT_FETCH(kt + 1);
      f32x4 s[2];
#pragma unroll
      for (int kk = 0; kk < 2; ++kk) { f32x4 a4 = (f32x4){0.f, 0.f, 0.f, 0.f};
#pragma unroll
        for (int ks = 0; ks < 8; ++ks) { const bf16x8 kf = *(const LAS bf16x8*)(Ks + (kk * 16 + fr) * 272 + ks * 32 + fq * 8); a4 = __builtin_amdgcn_mfma_f32_16x16x32_bf16(kf, *(const LAS bf16x8*)(qsp + ks * 32), a4, 0, 0, 0); }
        s[kk] = a4; }
#pragma unroll
      for (int kk = 0; kk < 2; ++kk)
#pragma unroll
        for (int j = 0; j < 4; ++j) { const int si = spos + kk * 16 + 4 * fq + j; float D;
          const int d = tq - si;
          if (kctx) D = fast_exp2((float)(256 + d) * lgf) + fast_exp2((float)(2048 - d) * lgb);
          else { const float e = fast_exp2((float)(d < 0 ? -d : d) * (d > 0 ? lgf : lgb)); D = d == 0 ? 2.0f : e; }
          s[kk][j] *= D; }
      u32x4 w; w.x = pk_bf16(s[0][0], s[0][1]); w.y = pk_bf16(s[0][2], s[0][3]); w.z = pk_bf16(s[1][0], s[1][1]); w.w = pk_bf16(s[1][2], s[1][3]);
      const bf16x8 pf = __builtin_bit_cast(bf16x8, w);
      { const LAS bf16_t* vb = Vs + fr * 48 + 8 * fq;
        bf16x8 va = *(const LAS bf16x8*)(vb), vc = *(const LAS bf16x8*)(vb + 16 * 48);
#pragma unroll
        for (int et = 0; et < 32; et += 2) {
          O[et] = __builtin_amdgcn_mfma_f32_16x16x32_bf16(va, pf, O[et], 0, 0, 0);
          if (et + 2 < 32) va = *(const LAS bf16x8*)(vb + (et + 2) * 16 * 48);
          O[et + 1] = __builtin_amdgcn_mfma_f32_16x16x32_bf16(vc, pf, O[et + 1], 0, 0, 0);
          if (et + 3 < 32) vc = *(const LAS bf16x8*)(vb + (et + 3) * 16 * 48);
        } }
    }
    float sm = 0.f;
#pragma unroll
    for (int et = 0; et < 32; ++et) sm += (O[et][0] + O[et][1]) + (O[et][2] + O[et][3]);
    sm += __shfl_xor(sm, 16); sm += __shfl_xor(sm, 32);
    const float mean = sm * (1.0f / 512.0f); float q = 0.f;
#pragma unroll
    for (int et = 0; et < 32; ++et) { const f32x4 d = O[et] - mean; q += (d[0] * d[0] + d[1] * d[1]) + (d[2] * d[2] + d[3] * d[3]); }
    q += __shfl_xor(q, 16); q += __shfl_xor(q, 32);
    const float rstd = rsqrtf(q * (1.0f / 512.0f) + LN_EPS);
    bf16_t* gp = G + (size_t)(qrow0 + wid * 16 + fr) * 2048 + h * 512 + 4 * fq;
#pragma unroll
    for (int et = 0; et < 32; ++et) { const f32x4 gg = ld_bf4(gp + et * 16); const f32x4 gw = *(const f32x4*)(gn + h * 512 + et * 16 + 4 * fq); st_bf4(gp + et * 16, (O[et] - mean) * rstd * gw * gg); }
  }
  __builtin_amdgcn_s_setprio(0);
}

template <int SEQ>
DI void hy_conv_channel(const Params& p, int zz, int tx, LAS unsigned char* lds, int c, int tokbase, const bf16_t* Rrow) {
  constexpr int WROW = ((SEQ + 448 + 127) / 128) * 128, NB = SEQ / 32, NG = SEQ / 128, CAW = 2 * SEQ, CAS = CAW + 16;
#define WOFF(b_) ((b_) * WROW + ((b_) & 3) * 8)
  const bf16_t* UT = (const bf16_t*)((p.ws + zz) + WS_BIG); bf16_t* ZT = (bf16_t*)((p.ws + zz) + WS_BIG + 3 * SZ_TOK1K);
  LAS bf16_t* CA = (LAS bf16_t*)lds;
  LAS bf16_t* WT = (LAS bf16_t*)(lds + 65792);
  LAS bf16_t* X0 = (LAS bf16_t*)(lds + 107008);
  const int tid = tx, wid = tid >> 6, lane = tid & 63;
  __syncthreads();
  for (int ch = tid; ch < CAW / 8; ch += NTHR) {
    const u32x4 d0 = *(const u32x4*)(Rrow + ch * 8), d1 = *(const u32x4*)(Rrow + ch * 8 + 8);
    const unsigned D[8] = {d0.x, d0.y, d0.z, d0.w, d1.x, d1.y, d1.z, d1.w};
#pragma unroll
    for (int a = 0; a < 8; ++a) { u32x4 w;
      if ((a & 1) == 0) { w.x = D[a / 2]; w.y = D[a / 2 + 1]; w.z = D[a / 2 + 2]; w.w = D[a / 2 + 3]; }
      else { const int j = a / 2; w.x = __builtin_amdgcn_alignbit(D[j + 1], D[j], 16); w.y = __builtin_amdgcn_alignbit(D[j + 2], D[j + 1], 16); w.z = __builtin_amdgcn_alignbit(D[j + 3], D[j + 2], 16); w.w = __builtin_amdgcn_alignbit(D[j + 4], D[j + 3], 16); }
      *(LAS u32x4*)(CA + a * CAS + ch * 8) = w; }
  }
  for (int idx = tid; idx < 8 * 448; idx += NTHR) { const int b = idx / 448, e = idx - b * 448; WT[WOFF(b) + (e < 224 ? e : SEQ + e)] = 0; }
  const float* cw = p.in[zz + 17]; const float* cb = p.in[zz + 18];
  float w0[3], w1[3], w2[3], bs[3];
#pragma unroll
  for (int pt = 0; pt < 3; ++pt) { const int cc = pt * 1024 + c; w0[pt] = cw[cc]; w1[pt] = cw[3072 + cc]; w2[pt] = cw[6144 + cc]; bs[pt] = cb[cc]; }
  for (int idx = tid; idx < SEQ; idx += NTHR) {
    const int b = idx / (SEQ / 8), ch = idx - b * (SEQ / 8), t0 = ch * 8; const size_t tok = (size_t)tokbase + (size_t)b * SEQ + t0;
    float r[3][8];
#pragma unroll
    for (int pt = 0; pt < 3; ++pt) { const bf16_t* src = UT + (size_t)(pt * 1024 + c) * MT + tok; const u32x4 v = *(const u32x4*)src;
      float in[10]; in[0] = t0 > 0 ? bf2f(src[-1]) : 0.f; in[9] = t0 + 8 < SEQ ? bf2f(src[8]) : 0.f;
      in[1] = __uint_as_float(v.x << 16); in[2] = __uint_as_float(v.x & 0xffff0000u); in[3] = __uint_as_float(v.y << 16); in[4] = __uint_as_float(v.y & 0xffff0000u);
      in[5] = __uint_as_float(v.z << 16); in[6] = __uint_as_float(v.z & 0xffff0000u); in[7] = __uint_as_float(v.w << 16); in[8] = __uint_as_float(v.w & 0xffff0000u);
#pragma unroll
      for (int k = 0; k < 8; ++k) r[pt][k] = w0[pt] * in[k] + w1[pt] * in[k + 1] + w2[pt] * in[k + 2] + bs[pt]; }
    u32x4 wv, xv;
    wv.x = pk_bf16(r[1][0] * r[2][0], r[1][1] * r[2][1]); wv.y = pk_bf16(r[1][2] * r[2][2], r[1][3] * r[2][3]); wv.z = pk_bf16(r[1][4] * r[2][4], r[1][5] * r[2][5]); wv.w = pk_bf16(r[1][6] * r[2][6], r[1][7] * r[2][7]);
    xv.x = pk_bf16(r[0][0], r[0][1]); xv.y = pk_bf16(r[0][2], r[0][3]); xv.z = pk_bf16(r[0][4], r[0][5]); xv.w = pk_bf16(r[0][6], r[0][7]);
    *(LAS u32x4*)(WT + WOFF(b) + 224 + t0) = wv; *(LAS u32x4*)(X0 + b * SEQ + t0) = xv;
  }
  __syncthreads();
  if (2 * wid < NG) {
    const int i = lane & 31, hh = lane >> 5, Iq = i >> 3, bb = i & 7;
    f32x16 acc0, acc1;
#pragma unroll
    for (int r = 0; r < 16; ++r) { acc0[r] = 0.f; acc1[r] = 0.f; }
    for (int d = 8 * wid - (NB - 1); d <= 8 * wid + 7; ++d) {
#pragma unroll
      for (int ks = 0; ks < 2; ++ks) {
        const int x0i = SEQ - (32 * d + i - 16 * ks - 8 * hh), a = x0i & 7;
        const bf16x8 A = *(const LAS bf16x8*)(CA + a * CAS + (x0i - a));
        const int jtok = 224 + (8 * wid + Iq - d) * 32 + 16 * ks + 8 * hh;
        const bf16x8 B0 = *(const LAS bf16x8*)(WT + WOFF(bb) + jtok), B1 = *(const LAS bf16x8*)(WT + WOFF(bb) + jtok + 128);
        acc0 = __builtin_amdgcn_mfma_f32_32x32x16_bf16(A, B0, acc0, 0, 0, 0);
        acc1 = __builtin_amdgcn_mfma_f32_32x32x16_bf16(A, B1, acc1, 0, 0, 0);
      }
    }
#pragma unroll
    for (int g = 0; g < 2; ++g)
#pragma unroll
      for (int rg = 0; rg < 4; ++rg) {
        const int t0 = (8 * wid + 4 * g + Iq) * 32 + 8 * rg + 4 * hh;
        const u32x2 xw = *(const LAS u32x2*)(X0 + bb * SEQ + t0);
        const f32x4 xf = (f32x4){__uint_as_float(xw.x << 16), __uint_as_float(xw.x & 0xffff0000u), __uint_as_float(xw.y << 16), __uint_as_float(xw.y & 0xffff0000u)};
        f32x4 y; if (g == 0) y = (f32x4){acc0[4 * rg], acc0[4 * rg + 1], acc0[4 * rg + 2], acc0[4 * rg + 3]}; else y = (f32x4){acc1[4 * rg], acc1[4 * rg + 1], acc1[4 * rg + 2], acc1[4 * rg + 3]};
        st_bf4(ZT + (size_t)c * MT + tokbase + bb * SEQ + t0, y * xf);
      }
  }
}
#undef WOFF

DI void hy_conv_phase(const Params& p, int zz, int tx, LAS unsigned char* lds) {
  const bf16_t* RL = (const bf16_t*)((p.ws + zz) + WS_HYRL); const bf16_t* RC = (const bf16_t*)((p.ws + zz) + WS_HYRC);
  for (int c = blockIdx.x; c < 1024; c += gridDim.x) {
    hy_conv_channel<2048>(p, zz, tx, lds, c, 0, RL + (size_t)c * RL_STRIDE);
    hy_conv_channel<256>(p, zz, tx, lds, c, ML, RC + (size_t)c * RC_STRIDE);
  }
}


DI void post_ln(const Params& p, int zz, int tx, LAS unsigned char* lds, int pm, int pn, int l, int lnk, bool final) {
  unsigned char* ws = p.ws + zz;
  float* X = (float*)(ws + WS_X); bf16_t* H = (bf16_t*)(ws + WS_H);
  const float* lmods = (const float*)(ws + WS_MODS) + (size_t)l * 9 * 9216;
  const float* lg = p.in[zz + 6] + (l * 3 + lnk) * 1024; const float* lb = p.in[zz + 7] + (l * 3 + lnk) * 1024;
  const float* sh = lnk == 0 ? lmods + 3 * 1024 : (lnk == 1 ? lmods + 6 * 1024 : lmods + 9 * 9216); const float* sc = sh + 1024;
  unsigned long long* xbuf = (unsigned long long*)(ws + WS_XBUF); unsigned* cnt = (unsigned*)(ws + WS_CNT) + (size_t)((l * 3 + lnk) * 72 + pm) * 64;
  LAS f32x2* S = (LAS f32x2*)lds;
  const int wid = tx >> 6, lane = tx & 63, lgp = lane >> 4, li = lane & 15, mb = pm < 64 ? (pm >> 3) : 8;
  asm volatile("s_waitcnt vmcnt(0)" ::: "memory");
  __syncthreads();
  const size_t tile0 = (size_t)(pm * 256) * DM + pn * 256 + li * 4;
#pragma unroll 1
  for (int hb = 0; hb < 2; ++hb) {
    f32x4 v[4][4];
#pragma unroll
    for (int i4 = 0; i4 < 4; ++i4) { const float* zr = X + tile0 + (size_t)(wid * 32 + (hb * 4 + i4) * 4 + lgp) * DM;
#pragma unroll
      for (int k = 0; k < 4; ++k) v[i4][k] = *(const f32x4*)(zr + k * 64); }
#pragma unroll
    for (int i4 = 0; i4 < 4; ++i4) {
      const int r = wid * 32 + (hb * 4 + i4) * 4 + lgp; float s = 0.f;
#pragma unroll
      for (int k = 0; k < 4; ++k) s += (v[i4][k][0] + v[i4][k][1]) + (v[i4][k][2] + v[i4][k][3]);
      s += __shfl_xor(s, 1); s += __shfl_xor(s, 2); s += __shfl_xor(s, 4); s += __shfl_xor(s, 8);
      const float mt = s * (1.0f / 256.0f); float q = 0.f;
#pragma unroll
      for (int k = 0; k < 4; ++k) { const f32x4 d = v[i4][k] - mt; q += (d[0] * d[0] + d[1] * d[1]) + (d[2] * d[2] + d[3] * d[3]); }
      q += __shfl_xor(q, 1); q += __shfl_xor(q, 2); q += __shfl_xor(q, 4); q += __shfl_xor(q, 8);
      if (li == 0) __hip_atomic_store(xbuf + ((size_t)(pm * 256 + r) * 4 + pn), ((unsigned long long)__float_as_uint(q) << 32) | __float_as_uint(mt), __ATOMIC_RELAXED, __HIP_MEMORY_SCOPE_AGENT);
    }
  }
  asm volatile("s_waitcnt vmcnt(0)" ::: "memory");
  if (lane == 0) __hip_atomic_fetch_add(cnt, 1u, __ATOMIC_RELAXED, __HIP_MEMORY_SCOPE_AGENT);
  if (wid == 0) {
    const unsigned long long t0 = __builtin_amdgcn_s_memrealtime();
    for (;;) {
      if ((unsigned)__builtin_amdgcn_readfirstlane(__hip_atomic_load(cnt, __ATOMIC_RELAXED, __HIP_MEMORY_SCOPE_AGENT)) >= 32u) break;
      if (__builtin_amdgcn_s_memrealtime() - t0 > 2000000ull) break;
      __builtin_amdgcn_s_sleep(2);
    }
  }
  __syncthreads();
  if (tx < 256) {
    const unsigned long long* slot = xbuf + (size_t)(pm * 256 + tx) * 4; float mt[4], m2[4]; float ms = 0.f;
#pragma unroll
    for (int t = 0; t < 4; ++t) { const unsigned long long w = __hip_atomic_load(slot + t, __ATOMIC_RELAXED, __HIP_MEMORY_SCOPE_AGENT); mt[t] = __uint_as_float((unsigned)w); m2[t] = __uint_as_float((unsigned)(w >> 32)); ms += mt[t]; }
    const float mean = ms * 0.25f; float q = 0.f;
#pragma unroll
    for (int t = 0; t < 4; ++t) { const float dm = mt[t] - mean; q += m2[t] + 256.0f * dm * dm; }
    S[tx] = (f32x2){mean, rsqrtf(q * (1.0f / 1024.0f) + LN_EPS)};
  }
  __syncthreads();
  f32x4 g4[4], b4[4], sc4[4], sh4[4];
#pragma unroll
  for (int k = 0; k < 4; ++k) { const int col = pn * 256 + li * 4 + k * 64; g4[k] = *(const f32x4*)(lg + col); b4[k] = *(const f32x4*)(lb + col);
    if (!final) { sc4[k] = *(const f32x4*)(sc + (size_t)mb * 9216 + col) + 1.0f; sh4[k] = *(const f32x4*)(sh + (size_t)mb * 9216 + col); } else { sc4[k] = g4[k]; sh4[k] = g4[k]; } }
#pragma unroll 1
  for (int hb = 0; hb < 2; ++hb) {
    f32x4 v[4][4];
#pragma unroll
    for (int i4 = 0; i4 < 4; ++i4) { const float* zr = X + tile0 + (size_t)(wid * 32 + (hb * 4 + i4) * 4 + lgp) * DM;
#pragma unroll
      for (int k = 0; k < 4; ++k) v[i4][k] = *(const f32x4*)(zr + k * 64); }
#pragma unroll
    for (int i4 = 0; i4 < 4; ++i4) {
      const int r = wid * 32 + (hb * 4 + i4) * 4 + lgp; const size_t off = tile0 + (size_t)r * DM; const f32x2 sr = S[r];
#pragma unroll
      for (int k = 0; k < 4; ++k) { const f32x4 y = (v[i4][k] - sr.x) * sr.y * g4[k] + b4[k];
        if (final) *(f32x4*)(p.out + zz + off + k * 64) = y;
        else { *(f32x4*)(X + off + k * 64) = y; st_bf4(H + off + k * 64, y * sc4[k] + sh4[k]); } }
    }
  }
  __syncthreads();
}

#define XB_TMO      128
#define XB_XCNT(j)  (256  + 64 * (j))
#define XB_XSUB(j)  (1280 + 64 * (j))
#define XB_XGEN(j)  (2304 + 64 * (j))
#define XB_TOP      3328
#define XB_TOPGEN   3392
#define XCD_BAR_WORDS 3456
#define XB_SPIN_CAP (1u << 18)
DI unsigned xb_ld(unsigned* p)              { return __hip_atomic_load(p, __ATOMIC_RELAXED, __HIP_MEMORY_SCOPE_AGENT); }
DI unsigned xb_add(unsigned* p, unsigned v) { return __hip_atomic_fetch_add(p, v, __ATOMIC_RELAXED, __HIP_MEMORY_SCOPE_AGENT); }
DI unsigned xb_xcc_id() { return (unsigned)__builtin_amdgcn_s_getreg((3 << 11) | 20) & 0xFu; }
#define XB_SPIN(cond, bar) do { unsigned _sp = 0; while (cond) { __builtin_amdgcn_s_sleep(1); \
    if ((++_sp & 255u) == 0u) { if (xb_ld(&(bar)[XB_TMO])) break; if (_sp > XB_SPIN_CAP) { atomicAdd(&(bar)[XB_TMO], 1u); break; } } } } while (0)
struct XcdBarrier { unsigned* bar; unsigned x; volatile LAS unsigned* st; };
DI XcdBarrier xcd_barrier_post(unsigned* bar, volatile LAS unsigned* st) {
  XcdBarrier b; b.bar = bar; b.x = xb_xcc_id(); b.st = st;
  if (threadIdx.x == 0) (void)xb_add(&bar[XB_XCNT(b.x)], 1u);
  return b;
}
DI void xcd_barrier_complete(unsigned* bar, unsigned x, unsigned& nloc, unsigned& nx) {
  const unsigned G = gridDim.x * gridDim.y * gridDim.z;
  unsigned sum, cnt, mine, sp = 0u;
  for (;;) {
    sum = 0u; cnt = 0u; mine = 0u;
#pragma unroll
    for (unsigned j = 0; j < 16; ++j) { const unsigned c = xb_ld(&bar[XB_XCNT(j)]); sum += c; cnt += (c > 0u) ? 1u : 0u; mine = (j == x) ? c : mine; }
    if (sum == G) break;
    __builtin_amdgcn_s_sleep(1);
    if ((++sp & 255u) == 0u) { if (xb_ld(&bar[XB_TMO])) break; if (sp > XB_SPIN_CAP) { atomicAdd(&bar[XB_TMO], 1u); break; } }
  }
  nloc = mine > 0u ? mine : 1u; nx = cnt > 0u ? cnt : 1u;
}
DI void xcd_barrier(const XcdBarrier& b) {
  asm volatile("s_waitcnt vmcnt(0)" ::: "memory");
  __syncthreads();
  if (threadIdx.x == 0) {
    unsigned* bar = b.bar;
    __builtin_amdgcn_s_waitcnt(0);
    unsigned nloc = b.st[0], nx = b.st[1];
    if (nloc == 0u) { xcd_barrier_complete(bar, b.x, nloc, nx); b.st[0] = nloc; b.st[1] = nx; }
    const unsigned old = xb_add(&bar[XB_XSUB(b.x)], 1u);
    const unsigned gen = old / nloc;
    if (old + 1u == (gen + 1u) * nloc) {
      __builtin_amdgcn_fence(__ATOMIC_RELEASE, "agent");
      asm volatile("s_waitcnt vmcnt(0)" ::: "memory");
      const unsigned og = xb_add(&bar[XB_TOP], 1u);
      const unsigned tg = og / nx;
      if (og + 1u == (tg + 1u) * nx) xb_add(&bar[XB_TOPGEN], 1u);
      else XB_SPIN(xb_ld(&bar[XB_TOPGEN]) == tg, bar);
      __builtin_amdgcn_fence(__ATOMIC_ACQUIRE, "agent");
      xb_add(&bar[XB_XGEN(b.x)], 1u);
      asm volatile("s_waitcnt vmcnt(0)" ::: "memory");
    } else {
      XB_SPIN(xb_ld(&bar[XB_XGEN(b.x)]) == gen, bar);
      __builtin_amdgcn_fence(__ATOMIC_ACQUIRE, "agent");
      asm volatile("s_waitcnt vmcnt(0)" ::: "memory");
    }
  }
  __syncthreads();
}

#ifndef PHMASK
#define PHMASK 0xffff
#endif
#define HAS(x) (((PHMASK) >> (x)) & 1)
#ifndef FUSE_LN
#define FUSE_LN 0
#endif
__global__ void __launch_bounds__(NTHR) fwd_kernel(Params p) {
  extern __shared__ __attribute__((aligned(16))) unsigned char lds_raw[];
  LAS unsigned char* lds = (LAS unsigned char*)lds_raw;
  cg::grid_group grid = cg::this_grid();
  if (threadIdx.x < 4) ((LAS unsigned*)(lds + LDS_BYTES - 16))[threadIdx.x] = 0u;
  __syncthreads();
  const XcdBarrier xb = xcd_barrier_post((unsigned*)(p.ws + WS_BAR), (volatile LAS unsigned*)(lds + LDS_BYTES - 16));
  const int G = (int)gridDim.x;
  const bool fuse = FUSE_LN && (G % 4 == 0);
  int nbar = 0; bool started = false;
  for (int ph = p.ph_lo; ph < p.ph_hi; ++ph) {
    const int l = ph >= 2 ? (ph - 2) / 11 : 0, sub = ph >= 2 ? (ph - 2) % 11 : -1;
    if (sub == 5 && l != 1) continue;
    if (fuse && (sub == 2 || sub == 7 || sub == 10)) continue;
    if (started) { if (p.ph_lo < 0) grid.sync();
      xcd_barrier(xb); ++nbar; }
    started = true;
#ifdef TPROBE
    if (blockIdx.x == 0 && threadIdx.x == 0) {
      const unsigned tnow = (unsigned)__builtin_amdgcn_s_memrealtime();
      volatile unsigned* cat = (volatile unsigned*)(p.ws + WS_CAT);
      const unsigned pc = cat[33];
      if (pc != 0u) cat[pc - 1u] += tnow - cat[32];
      cat[32] = tnow;
      cat[33] = 1u + (unsigned)(ph == 0 ? 0 : (ph == 1 ? 1 : (sub == 0 || sub == 8 ? 2 : (sub == 1 || sub == 9 ? 3 : (sub == 2 || sub == 7 || sub == 10 ? 4 : (sub == 3 ? 5 : (sub == 4 ? 6 + l : (sub == 5 ? 10 : 11))))))));
    }
#endif
    int zz = 0; asm volatile("" : "+s"(zz));
    int tx = threadIdx.x; asm volatile("" : "+v"(tx));
    unsigned char* ws = p.ws + zz;
    const float* mods = (const float*)(ws + WS_MODS);
    if (HAS(0) && ph == 0) {
      if (G - 1 - (int)blockIdx.x < 144) mods_prepare(p, zz, tx, lds);
      for (int u = G - 1 - (int)blockIdx.x; u < 144; u += G) mods_unit(p, zz, tx, lds, u);
      for (int u = blockIdx.x; u < 256; u += G) filter_unit(p, zz, tx, lds, u);
      { const int w2 = (G >= 256) ? (int)blockIdx.x - 80 : (int)blockIdx.x; for (int u = 256 + w2; w2 >= 0 && u < 288; u += G) filter_unit(p, zz, tx, lds, u); }
      conv_units(p, zz, tx, 0, G > 64 ? p.jobs[6 + zz].ustart : p.nconv_units, (int)blockIdx.x, G);
      rope_tables(p, zz, tx);
      continue;
    }
    if (HAS(1) && ph == 1) { init_phase(p, zz, tx); continue; }
    const int Mfull = l < 2 ? MT : ML, Mpre = l < 3 ? MT : ML;
    const float* lmods = mods + (size_t)l * 9 * 9216;
    const bf16_t* wl = (const bf16_t*)(ws + (size_t)l * LAYER_W);
    bool is_gemm = false; pg8::Gemm g{nullptr, nullptr, 0, 0, 0, 0, 1 << 20, 0}; int e_mode = 0, e_lnk = -1, e_fused = 0, e_final = 0; float e_coef = 0.f;
    bf16_t* Hb = (bf16_t*)(ws + WS_H); bf16_t* BIG = (bf16_t*)(ws + WS_BIG); float* X = (float*)(ws + WS_X);
    switch (sub) {
      case 0: is_gemm = true; g = {Hb, wl, Mpre, 2 * DFF, DM, DM, 1 << 20, 0}; e_mode = EPI_SWIGLU; break;
      case 1: is_gemm = true; g = {BIG, wl + (size_t)2 * DFF * DM, Mpre, DM, DFF, DFF, 1 << 20, 0}; e_mode = EPI_RES; e_coef = 0.5f; e_lnk = 0; break;
      case 2: if (HAS(2)) ln_phase(p, zz, tx, Mpre, p.in[zz + 6] + (l * 3 + 0) * 1024, p.in[zz + 7] + (l * 3 + 0) * 1024, lmods + 3 * 1024, lmods + 4 * 1024, false, Mpre == MT ? (const float*)((unsigned char*)BIG + 5 * SZ_TOK1K) : nullptr, lmods + 8 * 9216 + 2 * 1024); break;
      case 3: is_gemm = true;
        if (l == 0) { g = {Hb, (const bf16_t*)(ws + W_DA_QKV), Mpre, 3072, DM, DM, 1 << 20, 0}; e_mode = EPI_DA; }
        else if (l == 1) { g = {Hb, (const bf16_t*)(ws + W_HY_IN), Mpre, 3072, DM, DM, 1 << 20, 0}; e_mode = EPI_HY; }
        else if (l == 2) { g = {Hb, (const bf16_t*)(ws + W_RT_IN), Mpre, 6144, DM, DM, 1 << 20, 0}; e_mode = EPI_RT; }
        else { g = {Hb, (const bf16_t*)(ws + W_SC_IN), Mpre, 3072, DM, DM, 1 << 20, 0}; e_mode = EPI_SC; }
        break;
      case 4:
        if (HAS(4) && l == 0) da_attn_phase(p, zz, tx, lds); else if (HAS(5) && l == 1) hy_conv_phase(p, zz, tx, lds); else if (HAS(6) && l == 2) rt_attn_phase(p, zz, tx, lds); else if (HAS(7) && l == 3) sc_core_phase(p, zz, tx);
        break;
      case 5: if (HAS(8) && l == 1) hy_transpose_phase(p, zz, tx, lds); break;
      case 6: is_gemm = true; e_mode = EPI_RES; e_coef = 1.0f; e_lnk = 1;
        if (l == 0) g = {Hb, (const bf16_t*)(ws + W_DA_O), Mfull, DM, DM, DM, 1 << 20, 0};
        else if (l == 1) g = {Hb, (const bf16_t*)(ws + W_HY_O), Mfull, DM, DM, DM, 1 << 20, 0};
        else if (l == 2) g = {(const bf16_t*)((unsigned char*)BIG + 4 * SZ_TOK1K), (const bf16_t*)(ws + W_RT_O), Mfull, DM, 2048, 2048, 1 << 20, 0};
        else g = {Hb, (const bf16_t*)(ws + W_SC_O), Mfull, DM, DM, DM, 1 << 20, 0};
        break;
      case 7: if (HAS(2)) ln_phase(p, zz, tx, Mfull, p.in[zz + 6] + (l * 3 + 1) * 1024, p.in[zz + 7] + (l * 3 + 1) * 1024, lmods + 6 * 1024, lmods + 7 * 1024, false, nullptr, nullptr); break;
      case 8: is_gemm = true; g = {Hb, wl + (size_t)(2 * DFF * DM + DM * DFF), Mfull, 2 * DFF, DM, DM, 1 << 20, 0}; e_mode = EPI_SWIGLU; break;
      case 9: is_gemm = true; g = {BIG, wl + (size_t)(2 * DFF * DM + DM * DFF + 2 * DFF * DM), Mfull, DM, DFF, DFF, 1 << 20, 0}; e_mode = EPI_RES; e_coef = 0.5f; e_lnk = 2; break;
      default:
        if (HAS(2)) ln_phase(p, zz, tx, Mfull, p.in[zz + 6] + (l * 3 + 2) * 1024, p.in[zz + 7] + (l * 3 + 2) * 1024, lmods + 9 * 9216, lmods + 9 * 9216 + 1024, l == 3, Mfull == MT ? (const float*)((unsigned char*)BIG + 5 * SZ_TOK1K) : nullptr, lmods + 8 * 9216 + 8 * 1024); break;
    }
    if (HAS(3) && is_gemm) {
      int c = (int)blockIdx.x, nr = 1;
      if (fuse && e_lnk >= 0) {
        e_fused = 1; e_final = (l == 3 && e_lnk == 2) ? 1 : 0;
        if (G % 8 == 0) c = (c % 8) * (G / 8) + c / 8;
        nr = (g.M / 64 + G - 1) / G;
      }
      const bool ksplit = !e_fused && e_mode == EPI_RES && g.K == DFF && g.M == MT;
      if (ksplit) { nr = 2; g.M = ML; }
      for (int r = 0; r < nr; ++r) {
        if (ksplit && r == 1 && (int)blockIdx.x >= 64 && G > 64) {
          const int w = 2 * l + (sub == 9 ? 1 : 0);
          int ja = 0, jb = 0, jc = 0, jd = 0;
          if (w == 0) { ja = 6; jb = 9; } else if (w == 1) { ja = 9; jb = 12; } else if (w == 2) { ja = 12; jb = 15; } else if (w == 3) { ja = 15; jb = 18; jc = 21; jd = 24; } else if (w == 4) { ja = 18; jb = 21; }
          if (jb > ja) conv_units(p, zz, tx, p.jobs[ja + zz].ustart, p.jobs[jb + zz].ustart, (int)blockIdx.x - 64, G - 64);
          if (jd > jc) conv_units(p, zz, tx, p.jobs[jc + zz].ustart, p.nconv_units, (int)blockIdx.x - 64, G - 64);
        }
        if (ksplit && r == 1) { g.A = g.A + (size_t)ML * DFF; g.M = 2 * MC; g.K = DFF / 2; g.msplit = MC / 256; g.koff = DFF / 2; e_mode = EPI_PART; }
        pg8::StaticOrder S; S.init(g.M, g.N, G, c); S.panel = e_fused ? r : -1; const Epi E{e_mode, l, e_lnk, e_fused, e_final, zz, e_coef, ws}; pg8::gemm_phase<Epi>(p, tx, lds, g, S, E);
        if (e_fused) { const int L = r * G + c; if (L < (g.M / 64)) post_ln(p, zz, tx, lds, L >> 2, L & 3, l, e_lnk, e_final != 0); }
      }
    }
  }
#ifdef TPROBE
  if (blockIdx.x == 0 && threadIdx.x == 0) {
    const unsigned long long t0 = __builtin_amdgcn_s_memrealtime(); const unsigned long long w = ((const unsigned*)(p.ws + WS_CAT))[TPROBE_A];
    while (__builtin_amdgcn_s_memrealtime() - t0 < w) __builtin_amdgcn_s_sleep(8);
  }
#endif
}

extern "C" void kernel_launch(void* const* d_in, const int* in_sizes, int n_in, void* d_out, int out_size, void* d_ws, size_t ws_size, hipStream_t stream) {
  static int grid = 0;
  if (grid == 0) {
    if (n_in != 35 || ws_size < WS_END) { fprintf(stderr, "kernel_launch: need 35 inputs and %zu bytes of workspace; got %d, %zu\n", (size_t)WS_END, n_in, ws_size); grid = -1; return; }
    int dev = 0, cus = 0, per_cu = 0;
    hipGetDevice(&dev); hipDeviceGetAttribute(&cus, hipDeviceAttributeMultiprocessorCount, dev);
    if (hipFuncSetAttribute((const void*)fwd_kernel, hipFuncAttributeMaxDynamicSharedMemorySize, LDS_BYTES) != hipSuccess) { fprintf(stderr, "kernel_launch: hipFuncSetAttribute failed\n"); grid = -1; return; }
    if (hipOccupancyMaxActiveBlocksPerMultiprocessor(&per_cu, (const void*)fwd_kernel, NTHR, LDS_BYTES) != hipSuccess || per_cu < 1) { fprintf(stderr, "kernel_launch: occupancy query gave %d\n", per_cu); per_cu = 1; }
    (void)hipGetLastError();
    grid = cus * per_cu;
    fprintf(stderr, "kernel_launch: grid %d (%d CUs x %d)\n", grid, cus, per_cu);
  }
  if (grid < 0) return;
  Params p{};
  for (int i = 0; i < 35; ++i) p.in[i] = (const float*)d_in[i];
  p.out = (float*)d_out; p.ws = (unsigned char*)d_ws;
  unsigned char* ws = (unsigned char*)d_ws;
  int nj = 0, ustart = 0;
  auto add = [&](const float* src, size_t dst_off, int K, int N, int kind) { WJob& j = p.jobs[nj++]; j.src = src; j.dst = (bf16_t*)(ws + dst_off); j.K = K; j.N = N; j.srcN = N; j.kind = kind; j.ustart = ustart; j.pad = 0; ustart += (N / 32) * (K / 256); };
  const int mix_in_idx[4] = {12, 16, 28, 32}, mix_o_idx[4] = {13, 27, 31, 34};
  const size_t mix_in_off[4] = {W_DA_QKV, W_HY_IN, W_RT_IN, W_SC_IN}, mix_o_off[4] = {W_DA_O, W_HY_O, W_RT_O, W_SC_O};
  const int mix_in_n[4] = {3072, 3072, 6144, 3072}, mix_in_kind[4] = {2, 0, 5, 3}, mix_o_k[4] = {DM, DM, 2048, DM};
  for (int l = 0; l < 4; ++l) {
    const size_t base = (size_t)l * LAYER_W;
    add(p.in[8] + (size_t)l * DM * 2 * DFF, base, DM, 2 * DFF, 1);
    add(p.in[9] + (size_t)l * DFF * DM, base + SZ_WI, DFF, DM, 4);
    add(p.in[10] + (size_t)l * DM * 2 * DFF, base + SZ_WI + SZ_WO, DM, 2 * DFF, 1);
    add(p.in[11] + (size_t)l * DFF * DM, base + 2 * SZ_WI + SZ_WO, DFF, DM, 4);
    add(p.in[mix_in_idx[l]], mix_in_off[l], DM, mix_in_n[l], mix_in_kind[l]);
    add(p.in[mix_o_idx[l]], mix_o_off[l], mix_o_k[l], DM, 4);
  }
  p.nconv_units = ustart; p.ph_lo = 0; p.ph_hi = 2 + 4 * 11; p.pad = 0;
  if (hipMemsetAsync(ws + WS_BAR, 0, ZERO_BYTES + 256, stream) != hipSuccess) { fprintf(stderr, "kernel_launch: memset failed\n"); return; }
  void* args[] = {&p};
  hipError_t e = hipLaunchCooperativeKernel((const void*)fwd_kernel, dim3(grid), dim3(NTHR), args, LDS_BYTES, stream);
  if (e != hipSuccess) fprintf(stderr, "kernel_launch: cooperative launch failed: %s (grid %d)\n", hipGetErrorString(e), grid);
}
```

```cpp
#include <hip/hip_runtime.h>
#include <hip/hip_cooperative_groups.h>
#include <cstdio>
namespace cg = cooperative_groups;

#define LAS __attribute__((address_space(3)))
#define DI __device__ __forceinline__
typedef unsigned short bf16_t;
typedef short bf16x8 __attribute__((ext_vector_type(8)));
typedef short s16x4 __attribute__((ext_vector_type(4)));
typedef float f32x4 __attribute__((ext_vector_type(4)));
typedef float f32x2 __attribute__((ext_vector_type(2)));
typedef float f32x16 __attribute__((ext_vector_type(16)));
typedef unsigned u32x4 __attribute__((ext_vector_type(4)));
typedef unsigned u32x2 __attribute__((ext_vector_type(2)));

constexpr int ML = 16384, MC = 2048, MT = 18432, DM = 1024, DFF = 2816;
constexpr int NTHR = 512;
constexpr int LDS_BYTES = 140 * 1024;
constexpr float ALPHA = 1.681792830507429f;
constexpr float LN_EPS = 1e-5f;
constexpr float LOG2E = 1.4426950408889634f;

constexpr size_t al256(size_t x) { return (x + 255) & ~(size_t)255; }
constexpr size_t SZ_WI = (size_t)2 * DFF * DM * 2, SZ_WO = (size_t)DM * DFF * 2;
constexpr size_t LAYER_W = 2 * (SZ_WI + SZ_WO);
constexpr size_t WS_WMIX = 4 * LAYER_W;
constexpr size_t W_DA_QKV = WS_WMIX, W_DA_O = W_DA_QKV + (size_t)3072 * 1024 * 2, W_HY_IN = W_DA_O + (size_t)1024 * 1024 * 2,
                 W_HY_O = W_HY_IN + (size_t)3072 * 1024 * 2, W_RT_IN = W_HY_O + (size_t)1024 * 1024 * 2, W_RT_O = W_RT_IN + (size_t)6144 * 1024 * 2,
                 W_SC_IN = W_RT_O + (size_t)1024 * 2048 * 2, W_SC_O = W_SC_IN + (size_t)3072 * 1024 * 2, W_END = W_SC_O + (size_t)1024 * 1024 * 2;
constexpr size_t WS_MODS = al256(W_END);
constexpr size_t WS_ROPE_DA = al256(WS_MODS + (size_t)4 * 9 * 9216 * 4);
constexpr size_t WS_ROPE_RT = al256(WS_ROPE_DA + (size_t)2048 * 32 * 8);
constexpr int RL_STRIDE = 4104, RC_STRIDE = 520;
constexpr size_t WS_HYRL = al256(WS_ROPE_RT + (size_t)2048 * 128 * 8);
constexpr size_t WS_HYRC = al256(WS_HYRL + (size_t)1024 * RL_STRIDE * 2);
constexpr size_t WS_X = al256(WS_HYRC + (size_t)1024 * RC_STRIDE * 2);
constexpr size_t WS_H = al256(WS_X + (size_t)MT * DM * 4);
constexpr size_t WS_BIG = al256(WS_H + (size_t)MT * DM * 2);
constexpr size_t SZ_TOK1K = (size_t)MT * 1024 * 2;
constexpr size_t BIG_BYTES = 6 * SZ_TOK1K;
constexpr size_t WS_XBUF = al256(WS_BIG + BIG_BYTES);
constexpr size_t WS_BAR = al256(WS_XBUF + (size_t)72 * 256 * 4 * 8);
constexpr size_t WS_CNT = WS_BAR + 16384;
constexpr size_t ZERO_BYTES = 16384 + (size_t)12 * 72 * 256;
constexpr size_t WS_CAT = WS_BAR + ZERO_BYTES;
constexpr size_t WS_END = WS_CAT + 256;

struct WJob { const float* src; bf16_t* dst; int K, N, srcN, kind, ustart, pad; };
struct Params {
  const float* in[35];
  float* out;
  unsigned char* ws;
  WJob jobs[24];
  int nconv_units, ph_lo, ph_hi, pad;
};

DI float bf2f(bf16_t h) { return __uint_as_float(((unsigned)h) << 16); }
typedef __bf16 bf16x2_t __attribute__((ext_vector_type(2)));
DI unsigned pk_bf16(float lo, float hi) { const f32x2 v = {lo, hi}; const bf16x2_t b = __builtin_convertvector(v, bf16x2_t); return __builtin_bit_cast(unsigned, b); }
DI bf16_t f2bf(float f) { return (bf16_t)(pk_bf16(f, 0.f) & 0xffffu); }
DI float fast_exp2(float x) { return __builtin_amdgcn_exp2f(x); }
DI float silu_f(float a) { return a * __builtin_amdgcn_rcpf(1.0f + __expf(-a)); }
DI float wave_sum(float v) {
#pragma unroll
  for (int o = 32; o >= 1; o >>= 1) v += __shfl_xor(v, o);
  return v;
}
DI f32x4 ld_bf4(const bf16_t* p) { u32x2 w = *(const u32x2*)p; return (f32x4){__uint_as_float(w.x << 16), __uint_as_float(w.x & 0xffff0000u), __uint_as_float(w.y << 16), __uint_as_float(w.y & 0xffff0000u)}; }
DI void ld_bf8(const bf16_t* p, f32x4& a, f32x4& b) { const u32x4 w = *(const u32x4*)p;
  a = (f32x4){__uint_as_float(w.x << 16), __uint_as_float(w.x & 0xffff0000u), __uint_as_float(w.y << 16), __uint_as_float(w.y & 0xffff0000u)};
  b = (f32x4){__uint_as_float(w.z << 16), __uint_as_float(w.z & 0xffff0000u), __uint_as_float(w.w << 16), __uint_as_float(w.w & 0xffff0000u)}; }
DI void st_bf8(bf16_t* p, f32x4 a, f32x4 b) { u32x4 w; w.x = pk_bf16(a[0], a[1]); w.y = pk_bf16(a[2], a[3]); w.z = pk_bf16(b[0], b[1]); w.w = pk_bf16(b[2], b[3]); *(u32x4*)p = w; }
DI void st_bf4(bf16_t* p, f32x4 v) { u32x2 w; w.x = pk_bf16(v[0], v[1]); w.y = pk_bf16(v[2], v[3]); *(u32x2*)p = w; }

namespace pg8 {
constexpr int BM = 256, BK = 64, HALF = 128, HTB = HALF * BK * 2, STAGE_BYTES = 8 * HTB, NXCD = 8, WGM = 8;
DI int lds_byte(int r, int c) { const int st = (r >> 4) * 2 + (c >> 5), rr = r & 15, cc = c & 31, ob = rr * 64 + cc * 2; return st * 1024 + (ob ^ (((ob >> 9) & 1) << 5)); }
DI void stage_rc(int b, int& R, int& C) { const int st = b / 1024, sb = b % 1024, swz = sb ^ (((sb >> 9) & 1) << 5); R = (st >> 1) * 16 + swz / 64; C = (st & 1) * 32 + (swz % 64) / 2; }
struct Unit { int pm, pn; };
struct Gemm { const bf16_t* A; const bf16_t* Bt; int M, N, K, ld, msplit, koff; };
struct StaticOrder {
  int nM, nN, nwg, G, c, panel;
  DI void init(int M, int N, int G_, int c_) { nM = M / BM; nN = N / BM; nwg = nM * nN; G = G_; c = c_; panel = -1; }
  DI bool next(int i, Unit& u) const {
    if (panel >= 0) { const int L = panel * G + c; if (i > 0 || L >= nwg) return false; u.pm = L >> 2; u.pn = L & 3; return true; }
    const long L = (long)i * G + c; if (L >= nwg) return false;
    int wgid = (int)L; { const int q = nwg / NXCD, r = nwg % NXCD, xcd = wgid % NXCD, off = wgid / NXCD; wgid = (xcd < r ? xcd * (q + 1) : r * (q + 1) + (xcd - r) * q) + off; }
    const int nig = WGM * nN, gid = wgid / nig, fm = gid * WGM, gsz = (nM - fm) < WGM ? (nM - fm) : WGM;
    u.pm = fm + ((wgid % nig) % gsz); u.pn = (wgid % nig) / gsz; return true;
  }
};

template <class Epi>
DI void gemm_phase(const Params& p, int tx, LAS unsigned char* lds, const Gemm g, const StaticOrder& S, const Epi& E) {
  const int tid = tx, wid = __builtin_amdgcn_readfirstlane(tid >> 6), lane = tid & 63, wr = wid >> 2, wc = wid & 3, fr = lane & 15, fq = lane >> 4;
  const int K = g.K, nt = K / BK;
  unsigned voffA[2];
#pragma unroll
  for (int i = 0; i < 2; ++i) { int R, C; stage_rc(tid * 16 + i * 8192, R, C); voffA[i] = (unsigned)(R * g.ld + C) * 2u; }
  const size_t kstep = (size_t)(BK * 2);
  const size_t hstep = (size_t)HALF * g.ld * 2;
  const size_t tstep = 2 * hstep;
  const unsigned ldsw = (unsigned)wid * 1024u;
  const int aoff = lds_byte(wr * 64 + fr, fq * 8), boff = lds_byte(wc * 32 + fr, fq * 8);
#define PG8_SA(b, h) (((b) * 2 + (h)) * HTB)
#define PG8_SB(b, h) ((4 + (b) * 2 + (h)) * HTB)
#define PG8_STAGE(bufoff, gbase) do { _Pragma("unroll") for (int _i = 0; _i < 2; ++_i) \
    __builtin_amdgcn_global_load_lds((const unsigned*)((const char*)(gbase) + voffA[_i]), (LAS unsigned*)(lds + (bufoff) + ldsw + _i * 8192), 16, 0, 0); } while (0)
#define PG8_LDA(dst, b, h) do { _Pragma("unroll") for (int m = 0; m < 4; ++m) _Pragma("unroll") for (int k = 0; k < 2; ++k) dst[m][k] = *(const LAS bf16x8*)(lds + PG8_SA(b, h) + aoff + m * 2048 + k * 1024); } while (0)
#define PG8_LDB(dst, b, h) do { _Pragma("unroll") for (int n = 0; n < 2; ++n) _Pragma("unroll") for (int k = 0; k < 2; ++k) dst[n][k] = *(const LAS bf16x8*)(lds + PG8_SB(b, h) + boff + n * 2048 + k * 1024); } while (0)
#define PG8_MMA(ai, bj, At, Bt) do { __builtin_amdgcn_s_setprio(1); _Pragma("unroll") for (int m = 0; m < 4; ++m) _Pragma("unroll") for (int n = 0; n < 2; ++n) _Pragma("unroll") for (int k = 0; k < 2; ++k) \
    acc[ai][bj][m][n] = __builtin_amdgcn_mfma_f32_16x16x32_bf16(Bt[n][k], At[m][k], acc[ai][bj][m][n], 0, 0, 0); __builtin_amdgcn_s_setprio(0); } while (0)
#define PG8_WAIT_V(n) asm volatile("s_waitcnt vmcnt(" #n ")" ::: "memory")
#define PG8_WAIT_L(n) asm volatile("s_waitcnt lgkmcnt(" #n ")" ::: "memory")
#define PG8_BAR __builtin_amdgcn_s_barrier()
#define PG8_SCHED __builtin_amdgcn_sched_barrier(0)
  Unit cur, nxt; int ui = 0;
  if (!S.next(0, cur)) return;
  f32x4 acc[2][2][4][2];
#pragma unroll
  for (int a = 0; a < 2; ++a)
#pragma unroll
    for (int b = 0; b < 2; ++b)
#pragma unroll
      for (int m = 0; m < 4; ++m)
#pragma unroll
        for (int n = 0; n < 2; ++n) acc[a][b][m][n] = (f32x4){0.f, 0.f, 0.f, 0.f};
  bf16x8 At[4][2], B0[2][2], B1[2][2];
#define PG8_APTR(u_) ((const char*)g.A + (size_t)((u_).pm % g.msplit) * tstep + (size_t)((u_).pm / g.msplit) * g.koff * 2)
#define PG8_BPTR(u_) ((const char*)g.Bt + (size_t)(u_).pn * tstep + (size_t)((u_).pm / g.msplit) * g.koff * 2)
  const char* cA = PG8_APTR(cur); const char* cB = PG8_BPTR(cur);
  PG8_STAGE(PG8_SB(0, 0), cB); PG8_STAGE(PG8_SA(0, 0), cA); PG8_STAGE(PG8_SB(0, 1), cB + hstep); PG8_STAGE(PG8_SA(0, 1), cA + hstep);
  if (wr == 1) PG8_BAR;
  PG8_WAIT_V(4); PG8_BAR;
  PG8_STAGE(PG8_SB(1, 0), cB + kstep); PG8_STAGE(PG8_SA(1, 0), cA + kstep); PG8_STAGE(PG8_SB(1, 1), cB + hstep + kstep);
  PG8_WAIT_V(6); PG8_BAR;
  for (;;) {
    const bool has_next = S.next(ui + 1, nxt);
    const char* nA = has_next ? PG8_APTR(nxt) : cA; const char* nB = has_next ? PG8_BPTR(nxt) : cB;
    for (int t = 0; t < nt; t += 2) {
      const bool last = (t == nt - 2);
      const char* a1 = cA + (size_t)(t + 1) * kstep;
      const char* a2 = last ? nA : cA + (size_t)(t + 2) * kstep; const char* b2 = last ? nB : cB + (size_t)(t + 2) * kstep;
      const char* a3 = a2 + kstep; const char* b3 = b2 + kstep;
      PG8_LDB(B0, 0, 0); PG8_SCHED; PG8_LDA(At, 0, 0); PG8_STAGE(PG8_SA(1, 1), a1 + hstep);
      PG8_WAIT_L(8); PG8_BAR; PG8_WAIT_L(0); PG8_MMA(0, 0, At, B0); PG8_BAR; PG8_SCHED;
      PG8_LDB(B1, 0, 1); PG8_STAGE(PG8_SB(0, 0), b2);
      PG8_BAR; PG8_WAIT_L(0); PG8_MMA(0, 1, At, B1); PG8_BAR;
      PG8_LDA(At, 0, 1); PG8_STAGE(PG8_SA(0, 0), a2);
      PG8_BAR; PG8_WAIT_L(0); PG8_MMA(1, 0, At, B0); PG8_BAR; PG8_SCHED;
      PG8_STAGE(PG8_SB(0, 1), b2 + hstep);
      PG8_WAIT_V(6); PG8_BAR; PG8_MMA(1, 1, At, B1); PG8_BAR;
      PG8_LDB(B0, 1, 0); PG8_SCHED; PG8_LDA(At, 1, 0); PG8_STAGE(PG8_SA(0, 1), a2 + hstep);
      PG8_WAIT_L(8); PG8_BAR; PG8_WAIT_L(0); PG8_MMA(0, 0, At, B0); PG8_BAR; PG8_SCHED;
      PG8_LDB(B1, 1, 1); PG8_STAGE(PG8_SB(1, 0), b3);
      PG8_BAR; PG8_WAIT_L(0); PG8_MMA(0, 1, At, B1); PG8_BAR;
      PG8_LDA(At, 1, 1); PG8_STAGE(PG8_SA(1, 0), a3);
      PG8_BAR; PG8_WAIT_L(0); PG8_MMA(1, 0, At, B0); PG8_BAR; PG8_SCHED;
      PG8_STAGE(PG8_SB(1, 1), b3 + hstep);
      PG8_WAIT_V(6); PG8_BAR; PG8_MMA(1, 1, At, B1); PG8_BAR;
    }
    E(acc, cur, wr, wc, fr, fq);
    if (!has_next) break;
#pragma unroll
    for (int a = 0; a < 2; ++a)
#pragma unroll
      for (int b = 0; b < 2; ++b)
#pragma unroll
        for (int m = 0; m < 4; ++m)
#pragma unroll
          for (int n = 0; n < 2; ++n) acc[a][b][m][n] = (f32x4){0.f, 0.f, 0.f, 0.f};
    cur = nxt; cA = nA; cB = nB; ++ui;
  }
  PG8_WAIT_V(0);
  if (wr == 0) PG8_BAR;
  PG8_BAR;
#undef PG8_APTR
#undef PG8_BPTR
#undef PG8_SA
#undef PG8_SB
#undef PG8_STAGE
#undef PG8_LDA
#undef PG8_LDB
#undef PG8_MMA
#undef PG8_WAIT_V
#undef PG8_WAIT_L
#undef PG8_BAR
#undef PG8_SCHED
}
}

enum { EPI_SWIGLU = 0, EPI_RES = 1, EPI_DA = 2, EPI_HY = 3, EPI_RT = 4, EPI_SC = 5, EPI_PART = 6 };
struct Epi {
  int mode, l, lnk, fusedln, final, zz; float coef; unsigned char* ws;
  DI const float* gatep() const { return (const float*)(ws + WS_MODS) + (size_t)l * 9 * 9216 + (lnk == 0 ? 2 : (lnk == 1 ? 5 : 8)) * 1024; }
  DI void store_t(bf16_t* T, int colbase, const f32x4 (&acc)[2][2][4][2], int rowbase, int wr, int wc, int fr, int fq) const {
#pragma unroll
    for (int ai = 0; ai < 2; ++ai)
#pragma unroll
      for (int m = 0; m < 4; ++m) {
        const int row = rowbase + ai * 128 + wr * 64 + m * 16 + fr;
#pragma unroll
        for (int bj = 0; bj < 2; ++bj)
#pragma unroll
          for (int n = 0; n < 2; ++n) {
            const int col = colbase + bj * 128 + wc * 32 + n * 16 + fq * 4;
            const unsigned w0 = pk_bf16(acc[ai][bj][m][n][0], acc[ai][bj][m][n][1]), w1 = pk_bf16(acc[ai][bj][m][n][2], acc[ai][bj][m][n][3]);
            T[(size_t)(col + 0) * MT + row] = (bf16_t)(w0 & 0xffffu); T[(size_t)(col + 1) * MT + row] = (bf16_t)(w0 >> 16);
            T[(size_t)(col + 2) * MT + row] = (bf16_t)(w1 & 0xffffu); T[(size_t)(col + 3) * MT + row] = (bf16_t)(w1 >> 16);
          }
      }
  }
  DI void operator()(const f32x4 (&acc)[2][2][4][2], const pg8::Unit& u, int wr, int wc, int fr, int fq) const {
    const int rowbase = u.pm * 256;
    unsigned char* const BIGp = ws + WS_BIG;
    void* const p0 = mode == EPI_RES ? (void*)(ws + WS_X) : (void*)BIGp; void* const p1 = BIGp + SZ_TOK1K; void* const p2 = BIGp + 2 * SZ_TOK1K; void* const p3 = BIGp + 4 * SZ_TOK1K;
    const float* const f0 = mode == EPI_RES ? gatep() : (const float*)(ws + (mode == EPI_DA ? WS_ROPE_DA : WS_ROPE_RT));
    if (mode == EPI_SWIGLU) {
      bf16_t* O = (bf16_t*)p0;
#pragma unroll
      for (int ai = 0; ai < 2; ++ai)
#pragma unroll
        for (int m = 0; m < 4; ++m) {
          bf16_t* rowp = O + (size_t)(rowbase + ai * 128 + wr * 64 + m * 16 + fr) * DFF + u.pn * 128 + wc * 32 + 8 * fq;
          f32x4 v[2];
#pragma unroll
          for (int n = 0; n < 2; ++n) { const f32x4 a = acc[ai][0][m][n], g = acc[ai][1][m][n];
#pragma unroll
            for (int j = 0; j < 4; ++j) v[n][j] = silu_f(a[j]) * g[j]; }
          u32x4 w; w.x = pk_bf16(v[0][0], v[0][1]); w.y = pk_bf16(v[0][2], v[0][3]); w.z = pk_bf16(v[1][0], v[1][1]); w.w = pk_bf16(v[1][2], v[1][3]);
          *(u32x4*)rowp = w;
        }
    } else if (mode == EPI_RES) {
      bf16_t* X = (bf16_t*)p0; const int mb = u.pm < 64 ? (u.pm >> 3) : 8;
      const int col0 = u.pn * 256 + wc * 32 + 8 * fq;
      f32x4 gv[2][2];
#pragma unroll
      for (int bj = 0; bj < 2; ++bj)
#pragma unroll
        for (int n = 0; n < 2; ++n) gv[bj][n] = *(const f32x4*)(f0 + (size_t)mb * 9216 + col0 + bj * 128 + n * 4) * coef;
#pragma unroll
      for (int ai = 0; ai < 2; ++ai)
#pragma unroll
        for (int m = 0; m < 4; ++m) {
          bf16_t* rowp = X + (size_t)(rowbase + ai * 128 + wr * 64 + m * 16 + fr) * DM + col0;
#pragma unroll
          for (int bj = 0; bj < 2; ++bj) { f32x4 x0, x1; ld_bf8(rowp + bj * 128, x0, x1);
            st_bf8(rowp + bj * 128, x0 * ALPHA + gv[bj][0] * acc[ai][bj][m][0], x1 * ALPHA + gv[bj][1] * acc[ai][bj][m][1]); }
        }
    } else if (mode == EPI_DA) {
      if (u.pn < 8) {
        bf16_t* base = (bf16_t*)(u.pn < 4 ? p0 : p1); const float sc = u.pn < 4 ? 0.125f * LOG2E : 1.0f; const int tcol = (u.pn & 3) * 256 + wc * 64;
        const bool lat = u.pm < 64; const f32x2* rope = (const f32x2*)f0;
#pragma unroll
        for (int ai = 0; ai < 2; ++ai)
#pragma unroll
          for (int m = 0; m < 4; ++m) {
            const int row = rowbase + ai * 128 + wr * 64 + m * 16 + fr, t = row & 2047;
            f32x4 o1[2], o2[2];
#pragma unroll
            for (int n = 0; n < 2; ++n) {
              const int dd = 8 * fq + 4 * n; const f32x4 x1 = acc[ai][0][m][n], x2 = acc[ai][1][m][n];
              if (lat) {
#pragma unroll
                for (int j = 0; j < 4; ++j) { const f32x2 cs = rope[t * 32 + dd + j]; o1[n][j] = (x1[j] * cs.x - x2[j] * cs.y) * sc; o2[n][j] = (x1[j] * cs.y + x2[j] * cs.x) * sc; }
              } else { o1[n] = x1 * sc; o2[n] = x2 * sc; }
            }
            { bf16_t* q = base + (size_t)row * 1024 + tcol + 8 * fq; st_bf8(q, o1[0], o1[1]); st_bf8(q + 32, o2[0], o2[1]); }
          }
      } else store_t((bf16_t*)p2, (u.pn - 8) * 256, acc, rowbase, wr, wc, fr, fq);
    } else if (mode == EPI_HY) {
      store_t((bf16_t*)p0, u.pn * 256, acc, rowbase, wr, wc, fr, fq);
    } else if (mode == EPI_RT) {
      if (u.pn < 8) {
        bf16_t* base = (bf16_t*)(u.pn < 4 ? p0 : p1); const float sc = u.pn < 4 ? 1.0f : 0.0625f; const int tcol = (u.pn & 3) * 256 + wc * 32;
        const bool lat = u.pm < 64; const f32x2* rope = (const f32x2*)f0;
#pragma unroll
        for (int ai = 0; ai < 2; ++ai)
#pragma unroll
          for (int m = 0; m < 4; ++m) {
            const int row = rowbase + ai * 128 + wr * 64 + m * 16 + fr, t = row & 2047;
            f32x4 o1[2], o2[2];
#pragma unroll
            for (int n = 0; n < 2; ++n) {
              const int dd = wc * 32 + 8 * fq + 4 * n; const f32x4 x1 = acc[ai][0][m][n], x2 = acc[ai][1][m][n];
              if (lat) {
#pragma unroll
                for (int j = 0; j < 4; ++j) { const f32x2 cs = rope[t * 128 + dd + j]; o1[n][j] = (x1[j] * cs.x - x2[j] * cs.y) * sc; o2[n][j] = (x1[j] * cs.y + x2[j] * cs.x) * sc; }
              } else { o1[n] = x1 * sc; o2[n] = x2 * sc; }
            }
            { bf16_t* q = base + (size_t)row * 1024 + tcol + 8 * fq; st_bf8(q, o1[0], o1[1]); st_bf8(q + 128, o2[0], o2[1]); }
          }
        (void)tcol;
      } else if (u.pn < 16) store_t((bf16_t*)p2, (u.pn - 8) * 256, acc, rowbase, wr, wc, fr, fq);
      else {
        bf16_t* G = (bf16_t*)p3;
#pragma unroll
        for (int ai = 0; ai < 2; ++ai)
#pragma unroll
          for (int m = 0; m < 4; ++m) {
            bf16_t* rowp = G + (size_t)(rowbase + ai * 128 + wr * 64 + m * 16 + fr) * 2048 + (u.pn - 16) * 256 + wc * 32 + 8 * fq;
#pragma unroll
            for (int bj = 0; bj < 2; ++bj) { f32x4 v[2];
#pragma unroll
              for (int n = 0; n < 2; ++n)
#pragma unroll
                for (int j = 0; j < 4; ++j) v[n][j] = silu_f(acc[ai][bj][m][n][j]);
              st_bf8(rowp + bj * 128, v[0], v[1]); }
          }
      }
    } else if (mode == EPI_PART) {
      float* P = (float*)(BIGp + 5 * SZ_TOK1K); const int col0 = u.pn * 256 + wc * 32 + 8 * fq;
#pragma unroll
      for (int ai = 0; ai < 2; ++ai)
#pragma unroll
        for (int m = 0; m < 4; ++m) { float* rowp = P + (size_t)(rowbase + ai * 128 + wr * 64 + m * 16 + fr) * DM + col0;
#pragma unroll
          for (int bj = 0; bj < 2; ++bj)
#pragma unroll
            for (int n = 0; n < 2; ++n) *(f32x4*)(rowp + bj * 128 + n * 4) = acc[ai][bj][m][n]; }
    } else {
      if (u.pn < 4) {
        bf16_t* BG = (bf16_t*)p0;
#pragma unroll
        for (int ai = 0; ai < 2; ++ai)
#pragma unroll
          for (int m = 0; m < 4; ++m) {
            bf16_t* rowp = BG + (size_t)(rowbase + ai * 128 + wr * 64 + m * 16 + fr) * 1024 + u.pn * 256 + wc * 32 + 8 * fq;
#pragma unroll
            for (int bj = 0; bj < 2; ++bj) st_bf8(rowp + bj * 128, acc[ai][bj][m][0], acc[ai][bj][m][1]);
          }
      } else {
        bf16_t* CU = (bf16_t*)p1;
#pragma unroll
        for (int ai = 0; ai < 2; ++ai)
#pragma unroll
          for (int m = 0; m < 4; ++m) {
            bf16_t* rowp = CU + (size_t)(rowbase + ai * 128 + wr * 64 + m * 16 + fr) * 1024 + (u.pn - 4) * 128 + wc * 32 + 8 * fq;
            st_bf8(rowp, acc[ai][0][m][0] * acc[ai][1][m][0], acc[ai][0][m][1] * acc[ai][1][m][1]);
          }
      }
    }
  }
};

DI int map_col(int kind, int rho) {
  if (kind == 1) { const int t = rho >> 8, r = rho & 255; return r < 128 ? 128 * t + r : DFF + 128 * t + (r - 128); }
  if (kind == 2) { if (rho >= 2048) return rho; const int base = rho & ~255, r = rho & 255; const int bj = r >> 7, hm = (r & 127) >> 5, dd = r & 31; return base + hm * 64 + bj * 32 + dd; }
  if (kind == 3) { if (rho < 1024) return rho; const int t = (rho - 1024) >> 8, r = (rho - 1024) & 255; return r < 128 ? 1024 + 128 * t + r : 2048 + 128 * t + (r - 128); }
  return rho;
}

DI void conv_units(const Params& p, int zz, int tx, int ulo, int uhi, int wgi, int nwgs) {
  const int wid = tx >> 6, lane = tx & 63, cg = lane & 7, kb8 = lane >> 3;
  const int nw = nwgs * 8;
  for (int u = ulo + wgi * 8 + wid; u < uhi; u += nw) {
    int j = 0;
#pragma unroll 1
    for (int k = 1; k < 24; ++k) if (u >= p.jobs[k + zz].ustart) j = k;
    const WJob jb = p.jobs[j + zz];
    const int lu = u - jb.ustart, nkb = jb.K >> 8, rb = lu / nkb, kb = lu - rb * nkb;
    const int rho0 = rb * 32, k0 = kb * 256 + 8 * kb8, scol = map_col(jb.kind, rho0) + ((jb.kind == 1 || jb.kind == 4 || jb.kind == 3 || (jb.kind == 2 && rho0 < 2048) || (jb.kind == 5 && (rho0 < 2048 || rho0 >= 4096))) ? 8 * (cg & 3) + 4 * (cg >> 2) : 4 * cg);
    const float* src = jb.src + (size_t)k0 * jb.srcN + scol;
    bf16_t* dst = jb.dst + (size_t)(rho0 + 4 * cg) * jb.K + k0;
    const size_t rs = (size_t)jb.srcN;
#pragma unroll 2
    for (int it = 0; it < 4; ++it) {
      f32x4 v[8];
#pragma unroll
      for (int q = 0; q < 8; ++q) v[q] = __builtin_nontemporal_load((const f32x4*)(src + (size_t)(it * 64 + q) * rs));
#pragma unroll
      for (int e = 0; e < 4; ++e) { u32x4 w; w.x = pk_bf16(v[0][e], v[1][e]); w.y = pk_bf16(v[2][e], v[3][e]); w.z = pk_bf16(v[4][e], v[5][e]); w.w = pk_bf16(v[6][e], v[7][e]);
        *(u32x4*)(dst + (size_t)e * jb.K + it * 64) = w; }
    }
  }
}

DI void mods_prepare(const Params& p, int zz, int tx, LAS unsigned char* lds) {
  LAS float* sc = (LAS float*)lds;
  for (int idx = tx; idx < 9216; idx += NTHR) { const int r = idx >> 10, k = idx & 1023; const float v = r < 8 ? p.in[zz + 1][r * 1024 + k] : p.in[zz + 3][k]; sc[idx] = v / (1.0f + __expf(-v)); }
  __syncthreads();
}
DI void mods_unit(const Params& p, int zz, int tx, LAS unsigned char* lds, int u) {
  LAS float* sc = (LAS float*)lds; LAS float* part = (LAS float*)(lds + 36864);
  const int l = u / 36, cb = u - l * 36, wid = tx >> 6, lane = tx & 63, col = cb * 256 + lane * 4;
  const float* W = p.in[zz + 4] + (size_t)l * 1024 * 9216 + col;
  f32x4 acc[9];
#pragma unroll
  for (int r = 0; r < 9; ++r) acc[r] = (f32x4){0.f, 0.f, 0.f, 0.f};
#pragma unroll 8
  for (int k = wid * 128; k < wid * 128 + 128; ++k) {
    const f32x4 w = __builtin_nontemporal_load((const f32x4*)(W + (size_t)k * 9216));
#pragma unroll
    for (int r = 0; r < 9; ++r) acc[r] += w * sc[r * 1024 + k];
  }
#pragma unroll
  for (int r = 0; r < 9; ++r) *(LAS f32x4*)(part + (wid * 9 + r) * 256 + lane * 4) = acc[r];
  __syncthreads();
  float* mods = (float*)((p.ws + zz) + WS_MODS);
  for (int idx = tx; idx < 9 * 256; idx += NTHR) {
    const int r = idx >> 8, cl = idx & 255; float s = p.in[zz + 5][l * 9216 + cb * 256 + cl];
#pragma unroll
    for (int w = 0; w < 8; ++w) s += part[(w * 9 + r) * 256 + cl];
    mods[(size_t)(l * 9 + r) * 9216 + cb * 256 + cl] = s;
  }
  __syncthreads();
}

DI void filter_unit(const Params& p, int zz, int tx, LAS unsigned char* lds, int u) {
  const bool lat = u < 256; const int n = lat ? 2048 : 256, p0 = lat ? u * 8 : (u - 256) * 8, tid = tx;
  LAS float* z = (LAS float*)lds;
  LAS float* h1 = z + 8 * 33;
  LAS float* h2 = h1 + 8 * 64;
  const float* w1 = p.in[zz + 19]; const float* b1 = p.in[zz + 20]; const float* f1 = p.in[zz + 21]; const float* w2 = p.in[zz + 22]; const float* b2 = p.in[zz + 23]; const float* f2 = p.in[zz + 24];
  const float* w3 = p.in[zz + 25]; const float* dsk = p.in[zz + 26];
  if (tid < 8 * 33) { const int pos = tid / 33, f = tid - pos * 33; const int pp = p0 + pos; const float t = (float)pp / (float)(n - 1), w = 6.283185307179586f * (float)pp / (float)n;
    float v; if (f == 0) v = t; else { const int k = (f - 1) & 15; const float fr = 1e-4f + (float)k * ((15.0f - 1e-4f) / 15.0f); v = f <= 16 ? __cosf(fr * w) : -__sinf(fr * w); }
    z[tid] = v; }
  __syncthreads();
  { const int pos = tid >> 6, o = tid & 63; float s = b1[o];
#pragma unroll 3
    for (int f = 0; f < 33; ++f) s += z[pos * 33 + f] * w1[f * 64 + o];
    h1[tid] = __sinf(f1[o] * s); }
  __syncthreads();
  { const int pos = tid >> 6, o = tid & 63; float s = b2[o];
#pragma unroll 4
    for (int k = 0; k < 64; ++k) s += h1[pos * 64 + k] * w2[k * 64 + o];
    h2[tid] = __sinf(f2[o] * s); }
  __syncthreads();
  { const int cc = tid * 4; f32x4 a[8];
#pragma unroll
    for (int q = 0; q < 8; ++q) a[q] = (f32x4){0.f, 0.f, 0.f, 0.f};
#pragma unroll 16
    for (int k = 0; k < 64; ++k) { const f32x4 w = *(const f32x4*)(w3 + (size_t)k * 2048 + cc);
#pragma unroll
      for (int q = 0; q < 8; ++q) a[q] += w * h2[q * 64 + k]; }
    const bool bwd = cc >= 1024; const int c0 = cc & 1023;
    const float mind = -3.0701134573253944f, maxd = -15.350567286626972f;
    bf16_t* R = (bf16_t*)((p.ws + zz) + (lat ? WS_HYRL : WS_HYRC)); const int rs = lat ? RL_STRIDE : RC_STRIDE;
#pragma unroll
    for (int q = 0; q < 8; ++q) { const int pp = p0 + q; const float t = (float)pp / (float)(n - 1);
#pragma unroll
      for (int e = 0; e < 4; ++e) { const int c = c0 + e; const float dl = fabsf(mind + (maxd - mind) * ((float)c / 1023.0f));
        float v = a[q][e] * __expf(-t * dl);
        if (!bwd) { if (pp == 0) v += dsk[c]; R[(size_t)c * rs + (n - pp)] = f2bf(v); }
        else if (pp > 0) R[(size_t)c * rs + (n + pp)] = f2bf(v); } }
    if (p0 == 0) { for (int idx = tid; idx < 1024 * 9; idx += NTHR) { const int c = idx / 9, e = idx - c * 9; R[(size_t)c * rs + (e == 0 ? 0 : 2 * n + e - 1)] = 0; } }
  }
  __syncthreads();
}

DI void rope_tables(const Params& p, int zz, int tx) {
  f32x2* rd = (f32x2*)((p.ws + zz) + WS_ROPE_DA); f32x2* rr = (f32x2*)((p.ws + zz) + WS_ROPE_RT);
  const int gsz = gridDim.x * NTHR, gid = blockIdx.x * NTHR + tx;
  for (int idx = gid; idx < 2048 * 32; idx += gsz) { const int t = idx >> 5, d = idx & 31; const int k = d & 15; const float inv = exp2f(-(float)k / 16.0f * 13.287712379549449f);
    const float ang = (float)(d < 16 ? (t >> 6) : (t & 63)) * inv; rd[idx] = (f32x2){__cosf(ang), __sinf(ang)}; }
  for (int idx = gid; idx < 2048 * 128; idx += gsz) { const int t = idx >> 7, d = idx & 127; const int k = d & 63; const float inv = exp2f(-(float)k / 64.0f * 13.287712379549449f);
    const float ang = (float)(d < 64 ? (t >> 6) : (t & 63)) * inv; rr[idx] = (f32x2){__cosf(ang), __sinf(ang)}; }
}

DI void init_phase(const Params& p, int zz, int tx) {
  bf16_t* X = (bf16_t*)((p.ws + zz) + WS_X); bf16_t* H = (bf16_t*)((p.ws + zz) + WS_H); const float* mods = (const float*)((p.ws + zz) + WS_MODS);
  const int wid = tx >> 6, lane = tx & 63;
  for (int row = blockIdx.x * 8 + wid; row < MT; row += gridDim.x * 8) {
    const float* src = row < ML ? p.in[zz + 0] + (size_t)row * DM : p.in[zz + 2] + (size_t)(row - ML) * DM; const int mb = row < ML ? row >> 11 : 8;
#pragma unroll
    for (int k = 0; k < 2; ++k) { const int col = k * 512 + lane * 8; const f32x4 va = __builtin_nontemporal_load((const f32x4*)(src + col)), vb = __builtin_nontemporal_load((const f32x4*)(src + col + 4));
      st_bf8(X + (size_t)row * DM + col, va, vb);
      const float* mr = mods + (size_t)mb * 9216 + col;
      const f32x4 sha = *(const f32x4*)(mr), shb = *(const f32x4*)(mr + 4), sca = *(const f32x4*)(mr + 1024), scb = *(const f32x4*)(mr + 1024 + 4);
      st_bf8(H + (size_t)row * DM + col, va * (sca + 1.0f) + sha, vb * (scb + 1.0f) + shb); }
  }
}

DI void ln_phase(const Params& p, int zz, int tx, int M, const float* g, const float* bta, const float* shift, const float* scale, bool final, const float* part, const float* pgate) {
  bf16_t* X = (bf16_t*)((p.ws + zz) + WS_X); bf16_t* H = (bf16_t*)((p.ws + zz) + WS_H);
  const int wid = tx >> 6, lane = tx & 63, stride = gridDim.x * 8;
  f32x4 g4[4], b4[4];
#pragma unroll
  for (int q = 0; q < 4; ++q) { const int col = (q >> 1) * 512 + lane * 8 + (q & 1) * 4; g4[q] = *(const f32x4*)(g + col); b4[q] = *(const f32x4*)(bta + col); }
  for (int row0 = blockIdx.x * 8 + wid; row0 < M; row0 += 2 * stride) {
    const int row1 = row0 + stride; const bool has1 = row1 < M;
    bf16_t* xr0 = X + (size_t)row0 * DM + lane * 8; bf16_t* xr1 = X + (size_t)(has1 ? row1 : row0) * DM + lane * 8;
    f32x4 v0[4], v1[4]; float s0 = 0.f, s1 = 0.f;
    ld_bf8(xr0, v0[0], v0[1]); ld_bf8(xr0 + 512, v0[2], v0[3]); ld_bf8(xr1, v1[0], v1[1]); ld_bf8(xr1 + 512, v1[2], v1[3]);
    if (part != nullptr && row0 >= ML) {
      const float* q0 = part + (size_t)(row0 - ML) * DM; const float* q1 = part + (size_t)((has1 ? row1 : row0) - ML) * DM;
#pragma unroll
      for (int q = 0; q < 4; ++q) { const int col = (q >> 1) * 512 + lane * 8 + (q & 1) * 4; const f32x4 gt = *(const f32x4*)(pgate + col) * 0.5f;
        v0[q] = v0[q] * ALPHA + gt * (*(const f32x4*)(q0 + col) + *(const f32x4*)(q0 + (size_t)2048 * DM + col));
        v1[q] = v1[q] * ALPHA + gt * (*(const f32x4*)(q1 + col) + *(const f32x4*)(q1 + (size_t)2048 * DM + col)); }
    }
#pragma unroll
    for (int k = 0; k < 4; ++k) { s0 += (v0[k][0] + v0[k][1]) + (v0[k][2] + v0[k][3]); s1 += (v1[k][0] + v1[k][1]) + (v1[k][2] + v1[k][3]); }
#pragma unroll
    for (int o = 32; o >= 1; o >>= 1) { s0 += __shfl_xor(s0, o); s1 += __shfl_xor(s1, o); }
    const float mean0 = s0 * (1.0f / 1024.0f), mean1 = s1 * (1.0f / 1024.0f); float q0s = 0.f, q1s = 0.f;
#pragma unroll
    for (int k = 0; k < 4; ++k) { const f32x4 d0 = v0[k] - mean0, d1 = v1[k] - mean1; q0s += (d0[0] * d0[0] + d0[1] * d0[1]) + (d0[2] * d0[2] + d0[3] * d0[3]); q1s += (d1[0] * d1[0] + d1[1] * d1[1]) + (d1[2] * d1[2] + d1[3] * d1[3]); }
#pragma unroll
    for (int o = 32; o >= 1; o >>= 1) { q0s += __shfl_xor(q0s, o); q1s += __shfl_xor(q1s, o); }
    const float rstd0 = rsqrtf(q0s * (1.0f / 1024.0f) + LN_EPS), rstd1 = rsqrtf(q1s * (1.0f / 1024.0f) + LN_EPS);
#pragma unroll
    for (int rr = 0; rr < 2; ++rr) {
      if (rr == 1 && !has1) break;
      const int row = rr ? row1 : row0; const int mb = row < ML ? row >> 11 : 8; bf16_t* xr = rr ? xr1 : xr0; const float mean = rr ? mean1 : mean0, rstd = rr ? rstd1 : rstd0;
      f32x4 y[4];
#pragma unroll
      for (int q = 0; q < 4; ++q) y[q] = ((rr ? v1[q] : v0[q]) - mean) * rstd * g4[q] + b4[q];
      if (final) {
#pragma unroll
        for (int q = 0; q < 4; ++q) *(f32x4*)((p.out + zz) + (size_t)row * DM + (q >> 1) * 512 + lane * 8 + (q & 1) * 4) = y[q];
      } else {
        st_bf8(xr, y[0], y[1]); st_bf8(xr + 512, y[2], y[3]);
        f32x4 h[4];
#pragma unroll
        for (int q = 0; q < 4; ++q) { const int col = (q >> 1) * 512 + lane * 8 + (q & 1) * 4; const f32x4 sh = *(const f32x4*)(shift + (size_t)mb * 9216 + col), sc = *(const f32x4*)(scale + (size_t)mb * 9216 + col); h[q] = y[q] * (sc + 1.0f) + sh; }
        bf16_t* hp = H + (size_t)row * DM + lane * 8; st_bf8(hp, h[0], h[1]); st_bf8(hp + 512, h[2], h[3]);
      }
    }
  }
}

DI void sc_core_phase(const Params& p, int zz, int tx) {
  const bf16_t* BG = (const bf16_t*)((p.ws + zz) + WS_BIG); const bf16_t* CU = (const bf16_t*)((p.ws + zz) + WS_BIG + SZ_TOK1K); bf16_t* H = (bf16_t*)((p.ws + zz) + WS_H); const float* cw = p.in[zz + 33];
  for (int idx = blockIdx.x * NTHR + tx; idx < ML * 128; idx += gridDim.x * NTHR) {
    const int row = idx >> 7, c8 = (idx & 127) * 8, t = row & 2047; const size_t o = (size_t)row * 1024 + c8;
    f32x4 c0a, c0b, cma, cmb, cpa, cpb, bga, bgb;
    const f32x4 z4 = (f32x4){0.f, 0.f, 0.f, 0.f};
    ld_bf8(CU + o, c0a, c0b); ld_bf8(BG + o, bga, bgb);
    if (t > 0) ld_bf8(CU + o - 1024, cma, cmb); else { cma = z4; cmb = z4; }
    if (t < 2047) ld_bf8(CU + o + 1024, cpa, cpb); else { cpa = z4; cpb = z4; }
    const f32x4 w0a = *(const f32x4*)(cw + c8), w0b = *(const f32x4*)(cw + c8 + 4), w1a = *(const f32x4*)(cw + 1024 + c8), w1b = *(const f32x4*)(cw + 1024 + c8 + 4), w2a = *(const f32x4*)(cw + 2048 + c8), w2b = *(const f32x4*)(cw + 2048 + c8 + 4);
    st_bf8(H + o, bga * (w0a * cma + w1a * c0a + w2a * cpa), bgb * (w0b * cmb + w1b * c0b + w2b * cpb));
  }
}

DI void hy_transpose_phase(const Params& p, int zz, int tx, LAS unsigned char* lds) {
  const bf16_t* ZT = (const bf16_t*)((p.ws + zz) + WS_BIG + 3 * SZ_TOK1K); bf16_t* H = (bf16_t*)((p.ws + zz) + WS_H); LAS bf16_t* T = (LAS bf16_t*)lds;
  const int tid = tx;
  for (int u = blockIdx.x; u < 16 * 288; u += gridDim.x) {
    const int ct = u & 15, tt = u >> 4, c0 = ct * 64, tok0 = tt * 64;
    { const int r = tid >> 3, ch = tid & 7; *(LAS u32x4*)(T + r * 72 + ch * 8) = __builtin_nontemporal_load((const u32x4*)(ZT + (size_t)(c0 + r) * MT + tok0 + ch * 8)); }
    __syncthreads();
    { const int tok = tid >> 3, cc = (tid & 7) * 8; unsigned w[4];
#pragma unroll
      for (int k = 0; k < 4; ++k) w[k] = (unsigned)T[(cc + 2 * k) * 72 + tok] | ((unsigned)T[(cc + 2 * k + 1) * 72 + tok] << 16);
      *(u32x4*)(H + (size_t)(tok0 + tok) * 1024 + c0 + cc) = (u32x4){w[0], w[1], w[2], w[3]}; }
    __syncthreads();
  }
}

DI void da_attn_phase(const Params& p, int zz, int tx, LAS unsigned char* lds) {
  const bf16_t* Q = (const bf16_t*)((p.ws + zz) + WS_BIG); const bf16_t* Kb = (const bf16_t*)((p.ws + zz) + WS_BIG + SZ_TOK1K); const bf16_t* VT = (const bf16_t*)((p.ws + zz) + WS_BIG + 2 * SZ_TOK1K);
  bf16_t* AO = (bf16_t*)((p.ws + zz) + WS_H);
  const int tid = tx, wid = tid >> 6, lane = tid & 63, fr = lane & 15, fq = lane >> 4;
  const float* lam = p.in[zz + 14]; const float* subln = p.in[zz + 15];
  const float lam_init = 0.2f;
  const float lam_full = __expf(wave_sum(lam[lane] * lam[64 + lane])) - __expf(wave_sum(lam[128 + lane] * lam[192 + lane])) + lam_init;
  const int vcu = (gridDim.x % 8 == 0) ? (int)((blockIdx.x % 8) * (gridDim.x / 8) + blockIdx.x / 8) : (int)blockIdx.x;
  if (__builtin_amdgcn_readfirstlane(tx) >= 256) __builtin_amdgcn_s_setprio(1);
  for (int it = vcu; it < 1024 + 128; it += gridDim.x) {
    const bool isctx = it >= 1024; int b, h, qrow0, nkt;
    if (!isctx) { b = it >> 7; h = (it >> 4) & 7; qrow0 = b * 2048 + (it & 15) * 128; nkt = 36; }
    else { const int j = it - 1024; b = j >> 4; h = (j >> 1) & 7; qrow0 = ML + b * 256 + (j & 1) * 128; nkt = 4; }
    bf16x8 qf[2][2];
    { const bf16_t* qp = Q + (size_t)(qrow0 + wid * 16 + fr) * 1024 + h * 128 + fq * 8;
#pragma unroll
      for (int m = 0; m < 2; ++m)
#pragma unroll
        for (int ks = 0; ks < 2; ++ks) qf[m][ks] = *(const bf16x8*)(qp + m * 64 + ks * 32); }
    f32x4 O[2][8]; float mrun[2] = {-1e30f, -1e30f}, lsum[2] = {0.f, 0.f};
#pragma unroll
    for (int m = 0; m < 2; ++m)
#pragma unroll
      for (int et = 0; et < 8; ++et) O[m][et] = (f32x4){0.f, 0.f, 0.f, 0.f};
    u32x4 kreg[2], vreg[2];
#define DA_TOK(kt_) (((isctx) || (kt_) < 4) ? ML + b * 256 + (kt_) * 64 : b * 2048 + ((kt_) - 4) * 64)
#define DA_FETCH(kt_) do { const int tok0_ = DA_TOK(kt_); _Pragma("unroll") for (int i = 0; i < 2; ++i) { const int id = tid + NTHR * i; \
      kreg[i] = *(const u32x4*)(Kb + (size_t)(tok0_ + (id >> 4)) * 1024 + h * 128 + (id & 15) * 8); \
      vreg[i] = *(const u32x4*)(VT + (size_t)(h * 128 + (id >> 3)) * MT + tok0_ + (id & 7) * 8); } } while (0)
#define DA_PUT(buf_) do { LAS bf16_t* Kw = (LAS bf16_t*)(lds + (buf_) * 38912); LAS bf16_t* Vw = (LAS bf16_t*)(lds + (buf_) * 38912 + 18432); \
      _Pragma("unroll") for (int i = 0; i < 2; ++i) { const int id = tid + NTHR * i; \
        *(LAS u32x4*)(Kw + (id >> 4) * 144 + (id & 15) * 8) = kreg[i]; \
        const int cc = id & 7; LAS bf16_t* vp = Vw + (id >> 3) * 80 + 32 * (cc >> 2) + 16 * (cc & 1) + 4 * ((cc >> 1) & 1);     \
        *(LAS u32x2*)vp = (u32x2){vreg[i].x, vreg[i].y}; *(LAS u32x2*)(vp + 8) = (u32x2){vreg[i].z, vreg[i].w}; } } while (0)
    DA_FETCH(0);
    __syncthreads();
    DA_PUT(0);
    if (nkt > 1) DA_FETCH(1);
    __syncthreads();
    for (int kt = 0; kt < nkt; ++kt) {
      const LAS bf16_t* Ks = (const LAS bf16_t*)(lds + (kt & 1) * 38912); const LAS bf16_t* Vs = (const LAS bf16_t*)(lds + (kt & 1) * 38912 + 18432);
      f32x4 s[2][4];
#pragma unroll
      for (int m = 0; m < 2; ++m)
#pragma unroll
        for (int kk = 0; kk < 4; ++kk) { f32x4 a4 = (f32x4){0.f, 0.f, 0.f, 0.f};
#pragma unroll
          for (int ks = 0; ks < 2; ++ks) { const bf16x8 kf = *(const LAS bf16x8*)(Ks + (kk * 16 + fr) * 144 + m * 64 + ks * 32 + fq * 8); a4 = __builtin_amdgcn_mfma_f32_16x16x32_bf16(kf, qf[m][ks], a4, 0, 0, 0); }
          s[m][kk] = a4; }
      float mxl[2];
#pragma unroll
      for (int m = 0; m < 2; ++m) {
        float mx = fmaxf(fmaxf(s[m][0][0], s[m][0][1]), s[m][0][2]);
        mx = fmaxf(fmaxf(mx, s[m][0][3]), s[m][1][0]);
#pragma unroll
        for (int kk = 1; kk < 4; ++kk) {
          if (kk > 1) mx = fmaxf(fmaxf(mx, s[m][kk][0]), s[m][kk][1]); else mx = fmaxf(mx, s[m][kk][1]);
          mx = fmaxf(fmaxf(mx, s[m][kk][2]), s[m][kk][3]); }
        mxl[m] = mx; }
      if (__builtin_amdgcn_ballot_w64((mxl[0] > mrun[0] + 8.0f) || (mxl[1] > mrun[1] + 8.0f)) != 0ull) {
#pragma unroll
        for (int m = 0; m < 2; ++m) {
          float mx = mxl[m]; mx = fmaxf(mx, __shfl_xor(mx, 16)); mx = fmaxf(mx, __shfl_xor(mx, 32));
          const float mnew = fmaxf(mrun[m], mx), corr = fast_exp2(mrun[m] - mnew); mrun[m] = mnew; lsum[m] *= corr;
#pragma unroll
          for (int et = 0; et < 8; ++et) O[m][et] *= corr;
        }
      }
#pragma unroll
      for (int m = 0; m < 2; ++m) { float ps = 0.f;
#pragma unroll
        for (int kk = 0; kk < 4; ++kk)
#pragma unroll
          for (int j = 0; j < 4; ++j) { const float e = fast_exp2(s[m][kk][j] - mrun[m]); s[m][kk][j] = e; ps += e; }
        lsum[m] += ps; }
#pragma unroll
      for (int s2 = 0; s2 < 2; ++s2) {
        bf16x8 pf[2];
#pragma unroll
        for (int m = 0; m < 2; ++m) { u32x4 w; w.x = pk_bf16(s[m][2 * s2][0], s[m][2 * s2][1]); w.y = pk_bf16(s[m][2 * s2][2], s[m][2 * s2][3]); w.z = pk_bf16(s[m][2 * s2 + 1][0], s[m][2 * s2 + 1][1]); w.w = pk_bf16(s[m][2 * s2 + 1][2], s[m][2 * s2 + 1][3]); pf[m] = __builtin_bit_cast(bf16x8, w); }
#pragma unroll
        for (int et = 0; et < 8; ++et) {
          const bf16x8 vf = *(const LAS bf16x8*)(Vs + (et * 16 + fr) * 80 + 32 * s2 + 8 * fq);
          O[0][et] = __builtin_amdgcn_mfma_f32_16x16x32_bf16(vf, pf[0], O[0][et], 0, 0, 0);
          O[1][et] = __builtin_amdgcn_mfma_f32_16x16x32_bf16(vf, pf[1], O[1][et], 0, 0, 0);
        }
      }
      if (kt + 1 < nkt) { DA_PUT((kt + 1) & 1); if (kt + 2 < nkt) DA_FETCH(kt + 2); }
      __syncthreads();
    }
#undef DA_PUT
    float inv[2];
#pragma unroll
    for (int m = 0; m < 2; ++m) { float l = lsum[m]; l += __shfl_xor(l, 16); l += __shfl_xor(l, 32); inv[m] = 1.0f / l; }
    float ss = 0.f;
#pragma unroll
    for (int et = 0; et < 8; ++et)
#pragma unroll
      for (int j = 0; j < 4; ++j) { const float o = O[0][et][j] * inv[0] - lam_full * (O[1][et][j] * inv[1]); O[0][et][j] = o; ss += o * o; }
    ss += __shfl_xor(ss, 16); ss += __shfl_xor(ss, 32);
    const float rn = rsqrtf(ss * (1.0f / 128.0f) + LN_EPS) * (1.0f - lam_init);
    bf16_t* op = AO + (size_t)(qrow0 + wid * 16 + fr) * 1024 + h * 128 + 4 * fq;
#pragma unroll
    for (int et = 0; et < 8; ++et) { const f32x4 g = *(const f32x4*)(subln + et * 16 + 4 * fq); st_bf4(op + et * 16, O[0][et] * g * rn); }
  }
  __builtin_amdgcn_s_setprio(0);
}

#ifndef PVD
#define PVD 2
#endif
DI void rt_attn_phase(const Params& p, int zz, int tx, LAS unsigned char* lds) {
  const bf16_t* Q = (const bf16_t*)((p.ws + zz) + WS_BIG); const bf16_t* Kb = (const bf16_t*)((p.ws + zz) + WS_BIG + SZ_TOK1K); const bf16_t* VT = (const bf16_t*)((p.ws + zz) + WS_BIG + 2 * SZ_TOK1K);
  bf16_t* G = (bf16_t*)((p.ws + zz) + WS_BIG + 4 * SZ_TOK1K);
  const int tid = tx, wid = tid >> 6, lane = tid & 63, fr = lane & 15, fq = lane >> 4;
  const float* dl = p.in[zz + 29]; const float* gn = p.in[zz + 30];
  LAS bf16_t* Ks = (LAS bf16_t*)lds;
  LAS bf16_t* Vs = (LAS bf16_t*)(lds + 17408);
  const int vcu = (gridDim.x % 8 == 0) ? (int)((blockIdx.x % 8) * (gridDim.x / 8) + blockIdx.x / 8) : (int)blockIdx.x;
  if (__builtin_amdgcn_readfirstlane(tx) >= 256) __builtin_amdgcn_s_setprio(1);
  for (int it = vcu; it < 512; it += gridDim.x) {
    const int b = it >> 6, h = (it >> 4) & 3, qb = it & 15, qrow0 = b * 2048 + qb * 128;
    const float lgf = log2f(1.0f / (1.0f + expf(-dl[h]))), lgb = log2f(1.0f / (1.0f + expf(-dl[4 + h])));
    const int tq = qb * 128 + wid * 16 + fr;
    LAS bf16_t* Qs = (LAS bf16_t*)(lds + 66560);
    __syncthreads();
#pragma unroll
    for (int i = 0; i < 8; ++i) { const int id = tid + NTHR * i, r = id >> 5, cc = id & 31; *(LAS u32x4*)(Qs + r * 272 + cc * 8) = *(const u32x4*)(Q + (size_t)(qrow0 + r) * 1024 + h * 256 + cc * 8); }
    const LAS bf16_t* qsp = Qs + (wid * 16 + fr) * 272 + fq * 8;
    f32x4 O[32];
#pragma unroll
    for (int et = 0; et < 32; ++et) O[et] = (f32x4){0.f, 0.f, 0.f, 0.f};
    u32x4 kreg[2], vreg[4];
#define RT_TOK(kt_) ((kt_) < 8 ? ML + b * 256 + (kt_) * 32 : b * 2048 + ((kt_) - 8) * 32)
#define RT_FETCH(kt_) do { const int tok0_ = RT_TOK(kt_); _Pragma("unroll") for (int i = 0; i < 2; ++i) { const int id = tidl + NTHR * i; \
      kreg[i] = *(const u32x4*)(Kb + (size_t)(tok0_ + (id >> 5)) * 1024 + h * 256 + (id & 31) * 8); } \
    _Pragma("unroll") for (int i = 0; i < 4; ++i) { const int id = tidl + NTHR * i; \
      vreg[i] = *(const u32x4*)(VT + (size_t)(h * 512 + (id >> 2)) * MT + tok0_ + (id & 3) * 8); } } while (0)
    { int tidl = tid; RT_FETCH(0); }
    for (int kt = 0; kt < 72; ++kt) {
      int tidl = tid; asm volatile("" : "+v"(tidl));
      const bool kctx = kt < 8; const int spos = kctx ? kt * 32 : (kt - 8) * 32;
      __syncthreads();
#pragma unroll
      for (int i = 0; i < 2; ++i) { const int id = tidl + NTHR * i; *(LAS u32x4*)(Ks + (id >> 5) * 272 + (id & 31) * 8) = kreg[i]; }
#pragma unroll
      for (int i = 0; i < 4; ++i) { const int id = tidl + NTHR * i, cc = id & 3; LAS bf16_t* vp = Vs + (id >> 2) * 48 + 16 * (cc & 1) + 4 * (cc >> 1);
        *(LAS u32x2*)vp = (u32x2){vreg[i].x, vreg[i].y}; *(LAS u32x2*)(vp + 8) = (u32x2){vreg[i].z, vreg[i].w}; }
      __syncthreads();
      if (kt + 1 < 72) RT_FETCH(kt + 1);
      f32x4 s[2];
#pragma unroll
      for (int kk = 0; kk < 2; ++kk) { f32x4 a4 = (f32x4){0.f, 0.f, 0.f, 0.f};
#pragma unroll
        for (int ks = 0; ks < 8; ++ks) { const bf16x8 kf = *(const LAS bf16x8*)(Ks + (kk * 16 + fr) * 272 + ks * 32 + fq * 8); a4 = __builtin_amdgcn_mfma_f32_16x16x32_bf16(kf, *(const LAS bf16x8*)(qsp + ks * 32), a4, 0, 0, 0); }
        s[kk] = a4; }
#pragma unroll
      for (int kk = 0; kk < 2; ++kk)
#pragma unroll
        for (int j = 0; j < 4; ++j) { const int si = spos + kk * 16 + 4 * fq + j; float D;
          const int d = tq - si;
          if (kctx) D = fast_exp2((float)(256 + d) * lgf) + fast_exp2((float)(2048 - d) * lgb);
          else { const float e = fast_exp2((float)(d < 0 ? -d : d) * (d > 0 ? lgf : lgb)); D = d == 0 ? 2.0f : e; }
          s[kk][j] *= D; }
      u32x4 w; w.x = pk_bf16(s[0][0], s[0][1]); w.y = pk_bf16(s[0][2], s[0][3]); w.z = pk_bf16(s[1][0], s[1][1]); w.w = pk_bf16(s[1][2], s[1][3]);
      const bf16x8 pf = __builtin_bit_cast(bf16x8, w);
      { const LAS bf16_t* vb = Vs + fr * 48 + 8 * fq;
        bf16x8 va = *(const LAS bf16x8*)(vb), vc = *(const LAS bf16x8*)(vb + 16 * 48);
#pragma unroll
        for (int et = 0; et < 32; et += 2) {
          O[et] = __builtin_amdgcn_mfma_f32_16x16x32_bf16(va, pf, O[et], 0, 0, 0);
          if (et + 2 < 32) va = *(const LAS bf16x8*)(vb + (et + 2) * 16 * 48);
          O[et + 1] = __builtin_amdgcn_mfma_f32_16x16x32_bf16(vc, pf, O[et + 1], 0, 0, 0);
          if (et + 3 < 32) vc = *(const LAS bf16x8*)(vb + (et + 3) * 16 * 48);
        } }
    }
    float sm = 0.f;
#pragma unroll
    for (int et = 0; et < 32; ++et) sm += (O[et][0] + O[et][1]) + (O[et][2] + O[et][3]);
    sm += __shfl_xor(sm, 16); sm += __shfl_xor(sm, 32);
    const float mean = sm * (1.0f / 512.0f); float q = 0.f;
#pragma unroll
    for (int et = 0; et < 32; ++et) { const f32x4 d = O[et] - mean; q += (d[0] * d[0] + d[1] * d[1]) + (d[2] * d[2] + d[3] * d[3]); }
    q += __shfl_xor(q, 16); q += __shfl_xor(q, 32);
    const float rstd = rsqrtf(q * (1.0f / 512.0f) + LN_EPS);
    bf16_t* gp = G + (size_t)(qrow0 + wid * 16 + fr) * 2048 + h * 512 + 4 * fq;
#pragma unroll
    for (int et = 0; et < 32; ++et) { const f32x4 gg = ld_bf4(gp + et * 16); const f32x4 gw = *(const f32x4*)(gn + h * 512 + et * 16 + 4 * fq); st_bf4(gp + et * 16, (O[et] - mean) * rstd * gw * gg); }
  }
  __builtin_amdgcn_s_setprio(0);
}

template <int SEQ>
DI void hy_conv_channel(const Params& p, int zz, int tx, LAS unsigned char* lds, int c, int tokbase, const bf16_t* Rrow) {
  constexpr int WROW = ((SEQ + 448 + 127) / 128) * 128, NB = SEQ / 32, NG = SEQ / 128, CAW = 2 * SEQ, CAS = CAW + 16;
#define WOFF(b_) ((b_) * WROW + ((b_) & 3) * 8)
  const bf16_t* UT = (const bf16_t*)((p.ws + zz) + WS_BIG); bf16_t* ZT = (bf16_t*)((p.ws + zz) + WS_BIG + 3 * SZ_TOK1K);
  LAS bf16_t* CA = (LAS bf16_t*)lds;
  LAS bf16_t* WT = (LAS bf16_t*)(lds + 65792);
  LAS bf16_t* X0 = (LAS bf16_t*)(lds + 107008);
  const int tid = tx, wid = tid >> 6, lane = tid & 63;
  __syncthreads();
  for (int ch = tid; ch < CAW / 8; ch += NTHR) {
    const u32x4 d0 = *(const u32x4*)(Rrow + ch * 8), d1 = *(const u32x4*)(Rrow + ch * 8 + 8);
    const unsigned D[8] = {d0.x, d0.y, d0.z, d0.w, d1.x, d1.y, d1.z, d1.w};
#pragma unroll
    for (int a = 0; a < 8; ++a) { u32x4 w;
      if ((a & 1) == 0) { w.x = D[a / 2]; w.y = D[a / 2 + 1]; w.z = D[a / 2 + 2]; w.w = D[a / 2 + 3]; }
      else { const int j = a / 2; w.x = __builtin_amdgcn_alignbit(D[j + 1], D[j], 16); w.y = __builtin_amdgcn_alignbit(D[j + 2], D[j + 1], 16); w.z = __builtin_amdgcn_alignbit(D[j + 3], D[j + 2], 16); w.w = __builtin_amdgcn_alignbit(D[j + 4], D[j + 3], 16); }
      *(LAS u32x4*)(CA + a * CAS + ch * 8) = w; }
  }
  for (int idx = tid; idx < 8 * 448; idx += NTHR) { const int b = idx / 448, e = idx - b * 448; WT[WOFF(b) + (e < 224 ? e : SEQ + e)] = 0; }
  const float* cw = p.in[zz + 17]; const float* cb = p.in[zz + 18];
  float w0[3], w1[3], w2[3], bs[3];
#pragma unroll
  for (int pt = 0; pt < 3; ++pt) { const int cc = pt * 1024 + c; w0[pt] = cw[cc]; w1[pt] = cw[3072 + cc]; w2[pt] = cw[6144 + cc]; bs[pt] = cb[cc]; }
  for (int idx = tid; idx < SEQ; idx += NTHR) {
    const int b = idx / (SEQ / 8), ch = idx - b * (SEQ / 8), t0 = ch * 8; const size_t tok = (size_t)tokbase + (size_t)b * SEQ + t0;
    float r[3][8];
#pragma unroll
    for (int pt = 0; pt < 3; ++pt) { const bf16_t* src = UT + (size_t)(pt * 1024 + c) * MT + tok; const u32x4 v = *(const u32x4*)src;
      float in[10]; in[0] = t0 > 0 ? bf2f(src[-1]) : 0.f; in[9] = t0 + 8 < SEQ ? bf2f(src[8]) : 0.f;
      in[1] = __uint_as_float(v.x << 16); in[2] = __uint_as_float(v.x & 0xffff0000u); in[3] = __uint_as_float(v.y << 16); in[4] = __uint_as_float(v.y & 0xffff0000u);
      in[5] = __uint_as_float(v.z << 16); in[6] = __uint_as_float(v.z & 0xffff0000u); in[7] = __uint_as_float(v.w << 16); in[8] = __uint_as_float(v.w & 0xffff0000u);
#pragma unroll
      for (int k = 0; k < 8; ++k) r[pt][k] = w0[pt] * in[k] + w1[pt] * in[k + 1] + w2[pt] * in[k + 2] + bs[pt]; }
    u32x4 wv, xv;
    wv.x = pk_bf16(r[1][0] * r[2][0], r[1][1] * r[2][1]); wv.y = pk_bf16(r[1][2] * r[2][2], r[1][3] * r[2][3]); wv.z = pk_bf16(r[1][4] * r[2][4], r[1][5] * r[2][5]); wv.w = pk_bf16(r[1][6] * r[2][6], r[1][7] * r[2][7]);
    xv.x = pk_bf16(r[0][0], r[0][1]); xv.y = pk_bf16(r[0][2], r[0][3]); xv.z = pk_bf16(r[0][4], r[0][5]); xv.w = pk_bf16(r[0][6], r[0][7]);
    *(LAS u32x4*)(WT + WOFF(b) + 224 + t0) = wv; *(LAS u32x4*)(X0 + b * SEQ + t0) = xv;
  }
  __syncthreads();
  if (2 * wid < NG) {
    const int i = lane & 31, hh = lane >> 5, Iq = i >> 3, bb = i & 7;
    f32x16 acc0, acc1;
#pragma unroll
    for (int r = 0; r < 16; ++r) { acc0[r] = 0.f; acc1[r] = 0.f; }
    for (int d = 8 * wid - (NB - 1); d <= 8 * wid + 7; ++d) {
#pragma unroll
      for (int ks = 0; ks < 2; ++ks) {
        const int x0i = SEQ - (32 * d + i - 16 * ks - 8 * hh), a = x0i & 7;
        const bf16x8 A = *(const LAS bf16x8*)(CA + a * CAS + (x0i - a));
        const int jtok = 224 + (8 * wid + Iq - d) * 32 + 16 * ks + 8 * hh;
        const bf16x8 B0 = *(const LAS bf16x8*)(WT + WOFF(bb) + jtok), B1 = *(const LAS bf16x8*)(WT + WOFF(bb) + jtok + 128);
        acc0 = __builtin_amdgcn_mfma_f32_32x32x16_bf16(A, B0, acc0, 0, 0, 0);
        acc1 = __builtin_amdgcn_mfma_f32_32x32x16_bf16(A, B1, acc1, 0, 0, 0);
      }
    }
#pragma unroll
    for (int g = 0; g < 2; ++g)
#pragma unroll
      for (int rg = 0; rg < 4; ++rg) {
        const int t0 = (8 * wid + 4 * g + Iq) * 32 + 8 * rg + 4 * hh;
        const u32x2 xw = *(const LAS u32x2*)(X0 + bb * SEQ + t0);
        const f32x4 xf = (f32x4){__uint_as_float(xw.x << 16), __uint_as_float(xw.x & 0xffff0000u), __uint_as_float(xw.y << 16), __uint_as_float(xw.y & 0xffff0000u)};
        f32x4 y; if (g == 0) y = (f32x4){acc0[4 * rg], acc0[4 * rg + 1], acc0[4 * rg + 2], acc0[4 * rg + 3]}; else y = (f32x4){acc1[4 * rg], acc1[4 * rg + 1], acc1[4 * rg + 2], acc1[4 * rg + 3]};
        st_bf4(ZT + (size_t)c * MT + tokbase + bb * SEQ + t0, y * xf);
      }
  }
}
#undef WOFF

DI void hy_conv_phase(const Params& p, int zz, int tx, LAS unsigned char* lds) {
  const bf16_t* RL = (const bf16_t*)((p.ws + zz) + WS_HYRL); const bf16_t* RC = (const bf16_t*)((p.ws + zz) + WS_HYRC);
  for (int c = blockIdx.x; c < 1024; c += gridDim.x) {
    hy_conv_channel<2048>(p, zz, tx, lds, c, 0, RL + (size_t)c * RL_STRIDE);
    hy_conv_channel<256>(p, zz, tx, lds, c, ML, RC + (size_t)c * RC_STRIDE);
  }
}


DI void post_ln(const Params& p, int zz, int tx, LAS unsigned char* lds, int pm, int pn, int l, int lnk, bool final) {
  unsigned char* ws = p.ws + zz;
  float* X = (float*)(ws + WS_X); bf16_t* H = (bf16_t*)(ws + WS_H);
  const float* lmods = (const float*)(ws + WS_MODS) + (size_t)l * 9 * 9216;
  const float* lg = p.in[zz + 6] + (l * 3 + lnk) * 1024; const float* lb = p.in[zz + 7] + (l * 3 + lnk) * 1024;
  const float* sh = lnk == 0 ? lmods + 3 * 1024 : (lnk == 1 ? lmods + 6 * 1024 : lmods + 9 * 9216); const float* sc = sh + 1024;
  unsigned long long* xbuf = (unsigned long long*)(ws + WS_XBUF); unsigned* cnt = (unsigned*)(ws + WS_CNT) + (size_t)((l * 3 + lnk) * 72 + pm) * 64;
  LAS f32x2* S = (LAS f32x2*)lds;
  const int wid = tx >> 6, lane = tx & 63, lgp = lane >> 4, li = lane & 15, mb = pm < 64 ? (pm >> 3) : 8;
  asm volatile("s_waitcnt vmcnt(0)" ::: "memory");
  __syncthreads();
  const size_t tile0 = (size_t)(pm * 256) * DM + pn * 256 + li * 4;
#pragma unroll 1
  for (int hb = 0; hb < 2; ++hb) {
    f32x4 v[4][4];
#pragma unroll
    for (int i4 = 0; i4 < 4; ++i4) { const float* zr = X + tile0 + (size_t)(wid * 32 + (hb * 4 + i4) * 4 + lgp) * DM;
#pragma unroll
      for (int k = 0; k < 4; ++k) v[i4][k] = *(const f32x4*)(zr + k * 64); }
#pragma unroll
    for (int i4 = 0; i4 < 4; ++i4) {
      const int r = wid * 32 + (hb * 4 + i4) * 4 + lgp; float s = 0.f;
#pragma unroll
      for (int k = 0; k < 4; ++k) s += (v[i4][k][0] + v[i4][k][1]) + (v[i4][k][2] + v[i4][k][3]);
      s += __shfl_xor(s, 1); s += __shfl_xor(s, 2); s += __shfl_xor(s, 4); s += __shfl_xor(s, 8);
      const float mt = s * (1.0f / 256.0f); float q = 0.f;
#pragma unroll
      for (int k = 0; k < 4; ++k) { const f32x4 d = v[i4][k] - mt; q += (d[0] * d[0] + d[1] * d[1]) + (d[2] * d[2] + d[3] * d[3]); }
      q += __shfl_xor(q, 1); q += __shfl_xor(q, 2); q += __shfl_xor(q, 4); q += __shfl_xor(q, 8);
      if (li == 0) __hip_atomic_store(xbuf + ((size_t)(pm * 256 + r) * 4 + pn), ((unsigned long long)__float_as_uint(q) << 32) | __float_as_uint(mt), __ATOMIC_RELAXED, __HIP_MEMORY_SCOPE_AGENT);
    }
  }
  asm volatile("s_waitcnt vmcnt(0)" ::: "memory");
  if (lane == 0) __hip_atomic_fetch_add(cnt, 1u, __ATOMIC_RELAXED, __HIP_MEMORY_SCOPE_AGENT);
  if (wid == 0) {
    const unsigned long long t0 = __builtin_amdgcn_s_memrealtime();
    for (;;) {
      if ((unsigned)__builtin_amdgcn_readfirstlane(__hip_atomic_load(cnt, __ATOMIC_RELAXED, __HIP_MEMORY_SCOPE_AGENT)) >= 32u) break;
      if (__builtin_amdgcn_s_memrealtime() - t0 > 2000000ull) break;
      __builtin_amdgcn_s_sleep(2);
    }
  }
  __syncthreads();
  if (tx < 256) {
    const unsigned long long* slot = xbuf + (size_t)(pm * 256 + tx) * 4; float mt[4], m2[4]; float ms = 0.f;
#pragma unroll
    for (int t = 0; t < 4; ++t) { const unsigned long long w = __hip_atomic_load(slot + t, __ATOMIC_RELAXED, __HIP_MEMORY_SCOPE_AGENT); mt[t] = __uint_as_float((unsigned)w); m2[t] = __uint_as_float((unsigned)(w >> 32)); ms += mt[t]; }
    const float mean = ms * 0.25f; float q = 0.f;
#pragma unroll
    for (int t = 0; t < 4; ++t) { const float dm = mt[t] - mean; q += m2[t] + 256.0f * dm * dm; }
    S[tx] = (f32x2){mean, rsqrtf(q * (1.0f / 1024.0f) + LN_EPS)};
  }
  __syncthreads();
  f32x4 g4[4], b4[4], sc4[4], sh4[4];
#pragma unroll
  for (int k = 0; k < 4; ++k) { const int col = pn * 256 + li * 4 + k * 64; g4[k] = *(const f32x4*)(lg + col); b4[k] = *(const f32x4*)(lb + col);
    if (!final) { sc4[k] = *(const f32x4*)(sc + (size_t)mb * 9216 + col) + 1.0f; sh4[k] = *(const f32x4*)(sh + (size_t)mb * 9216 + col); } else { sc4[k] = g4[k]; sh4[k] = g4[k]; } }
#pragma unroll 1
  for (int hb = 0; hb < 2; ++hb) {
    f32x4 v[4][4];
#pragma unroll
    for (int i4 = 0; i4 < 4; ++i4) { const float* zr = X + tile0 + (size_t)(wid * 32 + (hb * 4 + i4) * 4 + lgp) * DM;
#pragma unroll
      for (int k = 0; k < 4; ++k) v[i4][k] = *(const f32x4*)(zr + k * 64); }
#pragma unroll
    for (int i4 = 0; i4 < 4; ++i4) {
      const int r = wid * 32 + (hb * 4 + i4) * 4 + lgp; const size_t off = tile0 + (size_t)r * DM; const f32x2 sr = S[r];
#pragma unroll
      for (int k = 0; k < 4; ++k) { const f32x4 y = (v[i4][k] - sr.x) * sr.y * g4[k] + b4[k];
        if (final) *(f32x4*)(p.out + zz + off + k * 64) = y;
        else { *(f32x4*)(X + off + k * 64) = y; st_bf4(H + off + k * 64, y * sc4[k] + sh4[k]); } }
    }
  }
  __syncthreads();
}

#define XB_TMO      128
#define XB_XCNT(j)  (256  + 64 * (j))
#define XB_XSUB(j)  (1280 + 64 * (j))
#define XB_XGEN(j)  (2304 + 64 * (j))
#define XB_TOP      3328
#define XB_TOPGEN   3392
#define XCD_BAR_WORDS 3456
#define XB_SPIN_CAP (1u << 18)
DI unsigned xb_ld(unsigned* p)              { return __hip_atomic_load(p, __ATOMIC_RELAXED, __HIP_MEMORY_SCOPE_AGENT); }
DI unsigned xb_add(unsigned* p, unsigned v) { return __hip_atomic_fetch_add(p, v, __ATOMIC_RELAXED, __HIP_MEMORY_SCOPE_AGENT); }
DI unsigned xb_xcc_id() { return (unsigned)__builtin_amdgcn_s_getreg((3 << 11) | 20) & 0xFu; }
#define XB_SPIN(cond, bar) do { unsigned _sp = 0; while (cond) { __builtin_amdgcn_s_sleep(1); \
    if ((++_sp & 255u) == 0u) { if (xb_ld(&(bar)[XB_TMO])) break; if (_sp > XB_SPIN_CAP) { atomicAdd(&(bar)[XB_TMO], 1u); break; } } } } while (0)
struct XcdBarrier { unsigned* bar; unsigned x; volatile LAS unsigned* st; };
DI XcdBarrier xcd_barrier_post(unsigned* bar, volatile LAS unsigned* st) {
  XcdBarrier b; b.bar = bar; b.x = xb_xcc_id(); b.st = st;
  if (threadIdx.x == 0) (void)xb_add(&bar[XB_XCNT(b.x)], 1u);
  return b;
}
DI void xcd_barrier_complete(unsigned* bar, unsigned x, unsigned& nloc, unsigned& nx) {
  const unsigned G = gridDim.x * gridDim.y * gridDim.z;
  unsigned sum, cnt, mine, sp = 0u;
  for (;;) {
    sum = 0u; cnt = 0u; mine = 0u;
#pragma unroll
    for (unsigned j = 0; j < 16; ++j) { const unsigned c = xb_ld(&bar[XB_XCNT(j)]); sum += c; cnt += (c > 0u) ? 1u : 0u; mine = (j == x) ? c : mine; }
    if (sum == G) break;
    __builtin_amdgcn_s_sleep(1);
    if ((++sp & 255u) == 0u) { if (xb_ld(&bar[XB_TMO])) break; if (sp > XB_SPIN_CAP) { atomicAdd(&bar[XB_TMO], 1u); break; } }
  }
  nloc = mine > 0u ? mine : 1u; nx = cnt > 0u ? cnt : 1u;
}
DI void xcd_barrier(const XcdBarrier& b) {
  asm volatile("s_waitcnt vmcnt(0)" ::: "memory");
  __syncthreads();
  if (threadIdx.x == 0) {
    unsigned* bar = b.bar;
    __builtin_amdgcn_s_waitcnt(0);
    unsigned nloc = b.st[0], nx = b.st[1];
    if (nloc == 0u) { xcd_barrier_complete(bar, b.x, nloc, nx); b.st[0] = nloc; b.st[1] = nx; }
    const unsigned old = xb_add(&bar[XB_XSUB(b.x)], 1u);
    const unsigned gen = old / nloc;
    if (old + 1u == (gen + 1u) * nloc) {
      __builtin_amdgcn_fence(__ATOMIC_RELEASE, "agent");
      asm volatile("s_waitcnt vmcnt(0)" ::: "memory");
      const unsigned og = xb_add(&bar[XB_TOP], 1u);
      const unsigned tg = og / nx;
      if (og + 1u == (tg + 1u) * nx) xb_add(&bar[XB_TOPGEN], 1u);
      else XB_SPIN(xb_ld(&bar[XB_TOPGEN]) == tg, bar);
      __builtin_amdgcn_fence(__ATOMIC_ACQUIRE, "agent");
      xb_add(&bar[XB_XGEN(b.x)], 1u);
      asm volatile("s_waitcnt vmcnt(0)" ::: "memory");
    } else {
      XB_SPIN(xb_ld(&bar[XB_XGEN(b.x)]) == gen, bar);
      __builtin_amdgcn_fence(__ATOMIC_ACQUIRE, "agent");
      asm volatile("s_waitcnt vmcnt(0)" ::: "memory");
    }
  }
  __syncthreads();
}

#ifndef PHMASK
#define PHMASK 0xffff
#endif
#define HAS(x) (((PHMASK) >> (x)) & 1)
#ifndef FUSE_LN
#define FUSE_LN 0
#endif
__global__ void __launch_bounds__(NTHR) fwd_kernel(Params p) {
  extern __shared__ __attribute__((aligned(16))) unsigned char lds_raw[];
  LAS unsigned char* lds = (LAS unsigned char*)lds_raw;
  cg::grid_group grid = cg::this_grid();
  if (threadIdx.x < 4) ((LAS unsigned*)(lds + LDS_BYTES - 16))[threadIdx.x] = 0u;
  __syncthreads();
  const XcdBarrier xb = xcd_barrier_post((unsigned*)(p.ws + WS_BAR), (volatile LAS unsigned*)(lds + LDS_BYTES - 16));
  const int G = (int)gridDim.x;
  const bool fuse = FUSE_LN && (G % 4 == 0);
  int nbar = 0; bool started = false;
  for (int ph = p.ph_lo; ph < p.ph_hi; ++ph) {
    const int l = ph >= 2 ? (ph - 2) / 11 : 0, sub = ph >= 2 ? (ph - 2) % 11 : -1;
    if (sub == 5 && l != 1) continue;
    if (fuse && (sub == 2 || sub == 7 || sub == 10)) continue;
    if (started) { if (p.ph_lo < 0) grid.sync();
      xcd_barrier(xb); ++nbar; }
    started = true;
#ifdef TPROBE
    if (blockIdx.x == 0 && threadIdx.x == 0) {
      const unsigned tnow = (unsigned)__builtin_amdgcn_s_memrealtime();
      volatile unsigned* cat = (volatile unsigned*)(p.ws + WS_CAT);
      const unsigned pc = cat[33];
      if (pc != 0u) cat[pc - 1u] += tnow - cat[32];
      cat[32] = tnow;
      cat[33] = 1u + (unsigned)(ph == 0 ? 0 : (ph == 1 ? 1 : (sub == 0 || sub == 8 ? 2 : (sub == 1 || sub == 9 ? 3 : (sub == 2 || sub == 7 || sub == 10 ? 4 : (sub == 3 ? 5 : (sub == 4 ? 6 + l : (sub == 5 ? 10 : 11))))))));
    }
#endif
    int zz = 0; asm volatile("" : "+s"(zz));
    int tx = threadIdx.x; asm volatile("" : "+v"(tx));
    unsigned char* ws = p.ws + zz;
    const float* mods = (const float*)(ws + WS_MODS);
    if (HAS(0) && ph == 0) {
      if (G - 1 - (int)blockIdx.x < 144) mods_prepare(p, zz, tx, lds);
      for (int u = G - 1 - (int)blockIdx.x; u < 144; u += G) mods_unit(p, zz, tx, lds, u);
      for (int u = blockIdx.x; u < 256; u += G) filter_unit(p, zz, tx, lds, u);
      { const int w2 = (G >= 256) ? (int)blockIdx.x - 80 : (int)blockIdx.x; for (int u = 256 + w2; w2 >= 0 && u < 288; u += G) filter_unit(p, zz, tx, lds, u); }
      conv_units(p, zz, tx, 0, G > 64 ? p.jobs[6 + zz].ustart : p.nconv_units, (int)blockIdx.x, G);
      rope_tables(p, zz, tx);
      continue;
    }
    if (HAS(1) && ph == 1) { init_phase(p, zz, tx); continue; }
    const int Mfull = l < 2 ? MT : ML, Mpre = l < 3 ? MT : ML;
    const float* lmods = mods + (size_t)l * 9 * 9216;
    const bf16_t* wl = (const bf16_t*)(ws + (size_t)l * LAYER_W);
    bool is_gemm = false; pg8::Gemm g{nullptr, nullptr, 0, 0, 0, 0, 1 << 20, 0}; int e_mode = 0, e_lnk = -1, e_fused = 0, e_final = 0; float e_coef = 0.f;
    bf16_t* Hb = (bf16_t*)(ws + WS_H); bf16_t* BIG = (bf16_t*)(ws + WS_BIG); float* X = (float*)(ws + WS_X);
    switch (sub) {
      case 0: is_gemm = true; g = {Hb, wl, Mpre, 2 * DFF, DM, DM, 1 << 20, 0}; e_mode = EPI_SWIGLU; break;
      case 1: is_gemm = true; g = {BIG, wl + (size_t)2 * DFF * DM, Mpre, DM, DFF, DFF, 1 << 20, 0}; e_mode = EPI_RES; e_coef = 0.5f; e_lnk = 0; break;
      case 2: if (HAS(2)) ln_phase(p, zz, tx, Mpre, p.in[zz + 6] + (l * 3 + 0) * 1024, p.in[zz + 7] + (l * 3 + 0) * 1024, lmods + 3 * 1024, lmods + 4 * 1024, false, Mpre == MT ? (const float*)((unsigned char*)BIG + 5 * SZ_TOK1K) : nullptr, lmods + 8 * 9216 + 2 * 1024); break;
      case 3: is_gemm = true;
        if (l == 0) { g = {Hb, (const bf16_t*)(ws + W_DA_QKV), Mpre, 3072, DM, DM, 1 << 20, 0}; e_mode = EPI_DA; }
        else if (l == 1) { g = {Hb, (const bf16_t*)(ws + W_HY_IN), Mpre, 3072, DM, DM, 1 << 20, 0}; e_mode = EPI_HY; }
        else if (l == 2) { g = {Hb, (const bf16_t*)(ws + W_RT_IN), Mpre, 6144, DM, DM, 1 << 20, 0}; e_mode = EPI_RT; }
        else { g = {Hb, (const bf16_t*)(ws + W_SC_IN), Mpre, 3072, DM, DM, 1 << 20, 0}; e_mode = EPI_SC; }
        break;
      case 4:
        if (HAS(4) && l == 0) da_attn_phase(p, zz, tx, lds); else if (HAS(5) && l == 1) hy_conv_phase(p, zz, tx, lds); else if (HAS(6) && l == 2) rt_attn_phase(p, zz, tx, lds); else if (HAS(7) && l == 3) sc_core_phase(p, zz, tx);
        break;
      case 5: if (HAS(8) && l == 1) hy_transpose_phase(p, zz, tx, lds); break;
      case 6: is_gemm = true; e_mode = EPI_RES; e_coef = 1.0f; e_lnk = 1;
        if (l == 0) g = {Hb, (const bf16_t*)(ws + W_DA_O), Mfull, DM, DM, DM, 1 << 20, 0};
        else if (l == 1) g = {Hb, (const bf16_t*)(ws + W_HY_O), Mfull, DM, DM, DM, 1 << 20, 0};
        else if (l == 2) g = {(const bf16_t*)((unsigned char*)BIG + 4 * SZ_TOK1K), (const bf16_t*)(ws + W_RT_O), Mfull, DM, 2048, 2048, 1 << 20, 0};
        else g = {Hb, (const bf16_t*)(ws + W_SC_O), Mfull, DM, DM, DM, 1 << 20, 0};
        break;
      case 7: if (HAS(2)) ln_phase(p, zz, tx, Mfull, p.in[zz + 6] + (l * 3 + 1) * 1024, p.in[zz + 7] + (l * 3 + 1) * 1024, lmods + 6 * 1024, lmods + 7 * 1024, false, nullptr, nullptr); break;
      case 8: is_gemm = true; g = {Hb, wl + (size_t)(2 * DFF * DM + DM * DFF), Mfull, 2 * DFF, DM, DM, 1 << 20, 0}; e_mode = EPI_SWIGLU; break;
      case 9: is_gemm = true; g = {BIG, wl + (size_t)(2 * DFF * DM + DM * DFF + 2 * DFF * DM), Mfull, DM, DFF, DFF, 1 << 20, 0}; e_mode = EPI_RES; e_coef = 0.5f; e_lnk = 2; break;
      default:
        if (HAS(2)) ln_phase(p, zz, tx, Mfull, p.in[zz + 6] + (l * 3 + 2) * 1024, p.in[zz + 7] + (l * 3 + 2) * 1024, lmods + 9 * 9216, lmods + 9 * 9216 + 1024, l == 3, Mfull == MT ? (const float*)((unsigned char*)BIG + 5 * SZ_TOK1K) : nullptr, lmods + 8 * 9216 + 8 * 1024); break;
    }
    if (HAS(3) && is_gemm) {
      int c = (int)blockIdx.x, nr = 1;
      if (fuse && e_lnk >= 0) {
        e_fused = 1; e_final = (l == 3 && e_lnk == 2) ? 1 : 0;
        if (G % 8 == 0) c = (c % 8) * (G / 8) + c / 8;
        nr = (g.M / 64 + G - 1) / G;
      }
      const bool ksplit = !e_fused && e_mode == EPI_RES && g.K == DFF && g.M == MT;
      if (ksplit) { nr = 2; g.M = ML; }
      for (int r = 0; r < nr; ++r) {
        if (ksplit && r == 1 && (int)blockIdx.x >= 64 && G > 64) {
          const int w = 2 * l + (sub == 9 ? 1 : 0);
          int ja = 0, jb = 0, jc = 0, jd = 0;
          if (w == 0) { ja = 6; jb = 9; } else if (w == 1) { ja = 9; jb = 12; } else if (w == 2) { ja = 12; jb = 15; } else if (w == 3) { ja = 15; jb = 18; jc = 21; jd = 24; } else if (w == 4) { ja = 18; jb = 21; }
          if (jb > ja) conv_units(p, zz, tx, p.jobs[ja + zz].ustart, p.jobs[jb + zz].ustart, (int)blockIdx.x - 64, G - 64);
          if (jd > jc) conv_units(p, zz, tx, p.jobs[jc + zz].ustart, p.nconv_units, (int)blockIdx.x - 64, G - 64);
        }
        if (ksplit && r == 1) { g.A = g.A + (size_t)ML * DFF; g.M = 2 * MC; g.K = DFF / 2; g.msplit = MC / 256; g.koff = DFF / 2; e_mode = EPI_PART; }
        pg8::StaticOrder S; S.init(g.M, g.N, G, c); S.panel = e_fused ? r : -1; const Epi E{e_mode, l, e_lnk, e_fused, e_final, zz, e_coef, ws}; pg8::gemm_phase<Epi>(p, tx, lds, g, S, E);
        if (e_fused) { const int L = r * G + c; if (L < (g.M / 64)) post_ln(p, zz, tx, lds, L >> 2, L & 3, l, e_lnk, e_final != 0); }
      }
    }
  }
#ifdef TPROBE
  if (blockIdx.x == 0 && threadIdx.x == 0) {
    const unsigned long long t0 = __builtin_amdgcn_s_memrealtime(); const unsigned long long w = ((const unsigned*)(p.ws + WS_CAT))[TPROBE_A];
    while (__builtin_amdgcn_s_memrealtime() - t0 < w) __builtin_amdgcn_s_sleep(8);
  }
#endif
}

extern "C" void kernel_launch(void* const* d_in, const int* in_sizes, int n_in, void* d_out, int out_size, void* d_ws, size_t ws_size, hipStream_t stream) {
  static int grid = 0;
  if (grid == 0) {
    if (n_in != 35 || ws_size < WS_END) { fprintf(stderr, "kernel_launch: need 35 inputs and %zu bytes of workspace; got %d, %zu\n", (size_t)WS_END, n_in, ws_size); grid = -1; return; }
    int dev = 0, cus = 0, per_cu = 0;
    hipGetDevice(&dev); hipDeviceGetAttribute(&cus, hipDeviceAttributeMultiprocessorCount, dev);
    if (hipFuncSetAttribute((const void*)fwd_kernel, hipFuncAttributeMaxDynamicSharedMemorySize, LDS_BYTES) != hipSuccess) { fprintf(stderr, "kernel_launch: hipFuncSetAttribute failed\n"); grid = -1; return; }
    if (hipOccupancyMaxActiveBlocksPerMultiprocessor(&per_cu, (const void*)fwd_kernel, NTHR, LDS_BYTES) != hipSuccess || per_cu < 1) { fprintf(stderr, "kernel_launch: occupancy query gave %d\n", per_cu); per_cu = 1; }
    (void)hipGetLastError();
    grid = cus * per_cu;
    fprintf(stderr, "kernel_launch: grid %d (%d CUs x %d)\n", grid, cus, per_cu);
  }
  if (grid < 0) return;
  Params p{};
  for (int i = 0; i < 35; ++i) p.in[i] = (const float*)d_in[i];
  p.out = (float*)d_out; p.ws = (unsigned char*)d_ws;
  unsigned char* ws = (unsigned char*)d_ws;
  int nj = 0, ustart = 0;
  auto add = [&](const float* src, size_t dst_off, int K, int N, int kind) { WJob& j = p.jobs[nj++]; j.src = src; j.dst = (bf16_t*)(ws + dst_off); j.K = K; j.N = N; j.srcN = N; j.kind = kind; j.ustart = ustart; j.pad = 0; ustart += (N / 32) * (K / 256); };
  const int mix_in_idx[4] = {12, 16, 28, 32}, mix_o_idx[4] = {13, 27, 31, 34};
  const size_t mix_in_off[4] = {W_DA_QKV, W_HY_IN, W_RT_IN, W_SC_IN}, mix_o_off[4] = {W_DA_O, W_HY_O, W_RT_O, W_SC_O};
  const int mix_in_n[4] = {3072, 3072, 6144, 3072}, mix_in_kind[4] = {2, 0, 5, 3}, mix_o_k[4] = {DM, DM, 2048, DM};
  for (int l = 0; l < 4; ++l) {
    const size_t base = (size_t)l * LAYER_W;
    add(p.in[8] + (size_t)l * DM * 2 * DFF, base, DM, 2 * DFF, 1);
    add(p.in[9] + (size_t)l * DFF * DM, base + SZ_WI, DFF, DM, 4);
    add(p.in[10] + (size_t)l * DM * 2 * DFF, base + SZ_WI + SZ_WO, DM, 2 * DFF, 1);
    add(p.in[11] + (size_t)l * DFF * DM, base + 2 * SZ_WI + SZ_WO, DFF, DM, 4);
    add(p.in[mix_in_idx[l]], mix_in_off[l], DM, mix_in_n[l], mix_in_kind[l]);
    add(p.in[mix_o_idx[l]], mix_o_off[l], mix_o_k[l], DM, 4);
  }
  p.nconv_units = ustart; p.ph_lo = 0; p.ph_hi = 2 + 4 * 11; p.pad = 0;
  if (hipMemsetAsync(ws + WS_BAR, 0, ZERO_BYTES + 256, stream) != hipSuccess) { fprintf(stderr, "kernel_launch: memset failed\n"); return; }
  void* args[] = {&p};
  hipError_t e = hipLaunchCooperativeKernel((const void*)fwd_kernel, dim3(grid), dim3(NTHR), args, LDS_BYTES, stream);
  if (e != hipSuccess) fprintf(stderr, "kernel_launch: cooperative launch failed: %s (grid %d)\n", hipGetErrorString(e), grid);
}
```
